# Optimizing an MI355X kernel written in HIP

```python
import jax, jax.numpy as jnp
from jax import lax
import numpy as np

D_MODEL = 1024
BATCH = 1
SEQ = 16384
DEPTH = 1
DEC_BATCH = 16
DEC_SEQ = 16
PAST_LEN = 2048

CHUNK = 64
D_MIX = D_MODEL
D_A = D_MIX // 2
D_B = D_MIX - D_A
A_HEAD = 64
A_HEADS = D_A // A_HEAD
A_W_RANK = 32
A_A_RANK = 32
A_G_RANK = 64
B_HEADS = 4
B_DK = D_B // (2 * B_HEADS)
B_DV = D_B // B_HEADS
B_GATE_RANK = 16
B_TAU = 16.0
D_FF = 2816
EPS = 1e-6
LNX_EPS = 64e-5

A_COLS = 3 * D_A + A_W_RANK + A_A_RANK + A_G_RANK
B_COLS = 2 * B_HEADS * B_DK + D_B + B_GATE_RANK + D_B
IN_COLS = A_COLS + B_COLS

kernel_name = "rwkv7_gla_parallel_macaron_stream_step"


def _rmsnorm(x, g):
    xf = x.astype(jnp.float32)
    y = xf * lax.rsqrt(jnp.mean(xf * xf, axis=-1, keepdims=True) + EPS)
    return (y * g.astype(jnp.float32)).astype(x.dtype)


def _swiglu(h, wg, wu, wd):
    return (jax.nn.silu(h @ wg) * (h @ wu)) @ wd


def _rwkv7_step(S, inp):
    r_t, w_t, k_t, v_t, kk_t, kka_t = inp
    sa = jnp.einsum('bhvk,bhk->bhv', S, kk_t)
    S = S * w_t[:, :, None, :] - sa[..., None] * kka_t[:, :, None, :] + v_t[..., None] * k_t[:, :, None, :]
    o = jnp.einsum('bhvk,bhk->bhv', S, r_t)
    return S, o


def _rwkv7(p_a, prev_row, S0, mu, w0, w_up, a0, a_up, g_up, k_k, k_a, r_k, lnx_w, lnx_b):
    B, T, _ = p_a.shape
    f32 = jnp.float32
    shifted = jnp.concatenate([prev_row.astype(p_a.dtype), p_a[:, :-1]], axis=1)
    xs = p_a + (shifted - p_a) * mu
    idx = [D_A, 2 * D_A, 3 * D_A, 3 * D_A + A_W_RANK, 3 * D_A + A_W_RANK + A_A_RANK]
    r, k, v, xw, xa, xg = jnp.split(xs, idx, axis=-1)
    w_log = -jax.nn.softplus(-(w0 + jnp.tanh(xw) @ w_up).astype(f32)) - 0.5
    decay = jnp.exp(-jnp.exp(w_log))
    a = jax.nn.sigmoid((a0 + xa @ a_up).astype(f32))
    g = (jax.nn.sigmoid(xg) @ g_up).astype(f32)
    hd = lambda t: t.reshape(B, T, A_HEADS, A_HEAD)
    kf = hd(k.astype(f32))
    kk = hd((k * k_k).astype(f32))
    kk = kk / jnp.maximum(jnp.sqrt(jnp.sum(kk * kk, axis=-1, keepdims=True)), 1e-12)
    a_h = hd(a)
    kmod = kf * (1.0 + (a_h - 1.0) * k_a.astype(f32).reshape(A_HEADS, A_HEAD))
    rf = hd(r.astype(f32))
    vf = hd(v.astype(f32))
    seq = tuple(t.transpose(1, 0, 2, 3) for t in (rf, hd(decay), kmod, vf, kk, kk * a_h))
    S, o = lax.scan(_rwkv7_step, S0.astype(f32), seq)
    o = o.transpose(1, 0, 2, 3)
    mean = jnp.mean(o, axis=-1, keepdims=True)
    var = jnp.mean((o - mean) ** 2, axis=-1, keepdims=True)
    on = ((o - mean) * lax.rsqrt(var + LNX_EPS)).reshape(B, T, D_A) * lnx_w.astype(f32) + lnx_b.astype(f32)
    bonus = jnp.sum(rf * kmod * r_k.astype(f32), axis=-1, keepdims=True) * vf
    out = (on + bonus.reshape(B, T, D_A)) * g
    return out.astype(p_a.dtype), p_a[:, -1:], S


def _gla_chunked(q, k, v, log_a, S0):
    B, T, H, DK = q.shape
    DV = v.shape[-1]
    blk = CHUNK if T % CHUNK == 0 else T
    n = T // blk
    to_c = lambda t: t.reshape(B, n, blk, H, t.shape[-1]).transpose(1, 0, 3, 2, 4)
    mask = jnp.tril(jnp.ones((blk, blk), dtype=bool))[:, :, None]

    def step(S, inp):
        qc, kc, vc, gc = inp
        b = jnp.cumsum(gc, axis=-2)
        o_inter = jnp.einsum('bhtk,bhkv->bhtv', qc * jnp.exp(b), S)
        diff = b[:, :, :, None, :] - b[:, :, None, :, :]
        dec = jnp.exp(jnp.where(mask, diff, -jnp.inf))
        A = jnp.einsum('bhtk,bhsk,bhtsk->bhts', qc, kc, dec)
        o_intra = jnp.einsum('bhts,bhsv->bhtv', A, vc)
        b_last = b[:, :, -1:, :]
        S = jnp.exp(b_last[:, :, 0, :])[..., None] * S + jnp.einsum('bhsk,bhsv->bhkv', kc * jnp.exp(b_last - b), vc)
        return S, o_inter + o_intra

    S, o = lax.scan(step, S0.astype(jnp.float32), (to_c(q), to_c(k), to_c(v), to_c(log_a)))
    o = o.transpose(1, 0, 3, 2, 4).reshape(B, T, H, DV)
    return o, S


def _gla(p_b, S0, gk_up, gk_b, norm_g):
    B, T, _ = p_b.shape
    f32 = jnp.float32
    nk = B_HEADS * B_DK
    idx = [nk, 2 * nk, 2 * nk + D_B, 2 * nk + D_B + B_GATE_RANK]
    q, k, v, xgk, og = jnp.split(p_b, idx, axis=-1)
    log_a = jax.nn.log_sigmoid((xgk @ gk_up + gk_b).astype(f32)) / B_TAU
    q = q.astype(f32) * (B_DK ** -0.5)
    hk = lambda t: t.reshape(B, T, B_HEADS, B_DK)
    o, S = _gla_chunked(hk(q), hk(k.astype(f32)), v.astype(f32).reshape(B, T, B_HEADS, B_DV), hk(log_a), S0)
    o = o * lax.rsqrt(jnp.mean(o * o, axis=-1, keepdims=True) + EPS) * norm_g.astype(f32)
    out = o.reshape(B, T, D_B) * jax.nn.silu(og.astype(f32))
    return out.astype(p_b.dtype), S


def _trunk(x, shift, wkv, gla, params):
    (ln1_g, ffn1_wg, ffn1_wu, ffn1_wd, ln_mix_g, w_in, mu_shift, w0, w_lora_up, a0, a_lora_up,
     g_lora_up, k_k, k_a, r_k, lnx_w, lnx_b, gk_up, gk_b, gla_norm_g, w_out,
     ln2_g, ffn2_wg, ffn2_wu, ffn2_wd) = params
    new_shift, new_wkv, new_gla = [], [], []
    for l in range(DEPTH):
        h = _rmsnorm(x, ln1_g[l])
        x = x + 0.5 * _swiglu(h, ffn1_wg[l], ffn1_wu[l], ffn1_wd[l])
        h = _rmsnorm(x, ln_mix_g[l])
        p = h @ w_in[l]
        p_a, p_b = p[..., :A_COLS], p[..., A_COLS:]
        o_a, row_a, S_a = _rwkv7(p_a, shift[l], wkv[l], mu_shift[l], w0[l], w_lora_up[l], a0[l],
                                 a_lora_up[l], g_lora_up[l], k_k[l], k_a[l], r_k[l], lnx_w[l], lnx_b[l])
        o_b, S_b = _gla(p_b, gla[l], gk_up[l], gk_b[l], gla_norm_g[l])
        x = x + jnp.concatenate([o_a, o_b], axis=-1) @ w_out[l]
        h = _rmsnorm(x, ln2_g[l])
        x = x + 0.5 * _swiglu(h, ffn2_wg[l], ffn2_wu[l], ffn2_wd[l])
        new_shift.append(row_a)
        new_wkv.append(S_a)
        new_gla.append(S_b)
    return x, jnp.stack(new_shift), jnp.stack(new_wkv), jnp.stack(new_gla)


def setup_inputs(seed: int = 0) -> dict:
    key = jax.random.key(seed)
    ks = jax.random.split(key, 40)
    nrm = lambda k, shape, s: jax.random.normal(k, shape, jnp.float32) * s
    L = DEPTH
    d = {}
    d["x_prompt"] = nrm(ks[0], (BATCH, SEQ, D_MODEL), 1.0)
    d["x_sample"] = nrm(ks[1], (DEC_BATCH, DEC_SEQ, D_MODEL), 1.0)
    d["state_shift"] = nrm(ks[2], (L, DEC_BATCH, 1, A_COLS), 1.0)
    d["state_wkv"] = nrm(ks[3], (L, DEC_BATCH, A_HEADS, A_HEAD, A_HEAD), 0.5)
    d["state_gla"] = nrm(ks[4], (L, DEC_BATCH, B_HEADS, B_DK, B_DV), 0.5)
    d["ln1_g"] = 1.0 + nrm(ks[5], (L, D_MODEL), 0.02)
    d["ffn1_wg"] = nrm(ks[6], (L, D_MODEL, D_FF), D_MODEL ** -0.5)
    d["ffn1_wu"] = nrm(ks[7], (L, D_MODEL, D_FF), D_MODEL ** -0.5)
    d["ffn1_wd"] = nrm(ks[8], (L, D_FF, D_MODEL), D_FF ** -0.5)
    d["ln_mix_g"] = 1.0 + nrm(ks[9], (L, D_MODEL), 0.02)
    d["w_in"] = nrm(ks[10], (L, D_MODEL, IN_COLS), D_MODEL ** -0.5)
    d["mu_shift"] = jax.random.uniform(ks[11], (L, A_COLS), jnp.float32)
    d["w0"] = jax.random.uniform(ks[12], (L, D_A), jnp.float32, -3.0, 1.0)
    d["w_lora_up"] = nrm(ks[13], (L, A_W_RANK, D_A), 0.5 * A_W_RANK ** -0.5)
    d["a0"] = nrm(ks[14], (L, D_A), 0.1)
    d["a_lora_up"] = nrm(ks[15], (L, A_A_RANK, D_A), 0.5 * A_A_RANK ** -0.5)
    d["g_lora_up"] = nrm(ks[16], (L, A_G_RANK, D_A), A_G_RANK ** -0.5)
    d["k_k"] = 0.85 + nrm(ks[17], (L, D_A), 0.05)
    d["k_a"] = 1.0 + nrm(ks[18], (L, D_A), 0.05)
    d["r_k"] = nrm(ks[19], (L, A_HEADS, A_HEAD), 0.1)
    d["lnx_w"] = 1.0 + nrm(ks[20], (L, D_A), 0.02)
    d["lnx_b"] = nrm(ks[21], (L, D_A), 0.02)
    d["gk_up"] = nrm(ks[22], (L, B_GATE_RANK, B_HEADS * B_DK), B_GATE_RANK ** -0.5)
    d["gk_b"] = nrm(ks[23], (L, B_HEADS * B_DK), 0.1)
    d["gla_norm_g"] = 1.0 + nrm(ks[24], (L, B_DV), 0.02)
    d["w_out"] = nrm(ks[25], (L, D_MIX, D_MODEL), D_MIX ** -0.5)
    d["ln2_g"] = 1.0 + nrm(ks[26], (L, D_MODEL), 0.02)
    d["ffn2_wg"] = nrm(ks[27], (L, D_MODEL, D_FF), D_MODEL ** -0.5)
    d["ffn2_wu"] = nrm(ks[28], (L, D_MODEL, D_FF), D_MODEL ** -0.5)
    d["ffn2_wd"] = nrm(ks[29], (L, D_FF, D_MODEL), D_FF ** -0.5)
    d["ln_f_g"] = 1.0 + nrm(ks[30], (D_MODEL,), 0.02)
    return d


def reference(x_prompt, x_sample, state_shift, state_wkv, state_gla, ln1_g, ffn1_wg, ffn1_wu, ffn1_wd,
              ln_mix_g, w_in, mu_shift, w0, w_lora_up, a0, a_lora_up, g_lora_up, k_k, k_a, r_k,
              lnx_w, lnx_b, gk_up, gk_b, gla_norm_g, w_out, ln2_g, ffn2_wg, ffn2_wu, ffn2_wd, ln_f_g):
    params = (ln1_g, ffn1_wg, ffn1_wu, ffn1_wd, ln_mix_g, w_in, mu_shift, w0, w_lora_up, a0, a_lora_up,
              g_lora_up, k_k, k_a, r_k, lnx_w, lnx_b, gk_up, gk_b, gla_norm_g, w_out,
              ln2_g, ffn2_wg, ffn2_wu, ffn2_wd)
    B = x_prompt.shape[0]
    shift0 = jnp.zeros((DEPTH, B, 1, A_COLS), x_prompt.dtype)
    wkv0 = jnp.zeros((DEPTH, B, A_HEADS, A_HEAD, A_HEAD), jnp.float32)
    gla0 = jnp.zeros((DEPTH, B, B_HEADS, B_DK, B_DV), jnp.float32)
    xp, shift_p, wkv_p, gla_p = _trunk(x_prompt, shift0, wkv0, gla0, params)
    y_prompt = _rmsnorm(xp, ln_f_g)
    xs, shift_s, wkv_s, gla_s = _trunk(x_sample, state_shift, state_wkv, state_gla, params)
    y_sample = _rmsnorm(xs, ln_f_g)
    return (y_prompt, y_sample, shift_p, wkv_p, gla_p, shift_s, wkv_s, gla_s)
```

```cpp
#include <hip/hip_runtime.h>
#include <hip/hip_cooperative_groups.h>
#include <cstdio>
namespace cg = cooperative_groups;
namespace pg8 {
#define PG8_LAS __attribute__((address_space(3)))
typedef unsigned short bf16_t;
typedef short bf16x8 __attribute__((ext_vector_type(8)));
typedef float f32x4 __attribute__((ext_vector_type(4)));
typedef unsigned u32x4 __attribute__((ext_vector_type(4)));
constexpr int BM = 256, BK = 64, HALF = 128, HTB = HALF * BK * 2  , STAGE_BYTES = 8 * HTB, NXCD = 8, WGM = 8;

__host__ __device__ __forceinline__ int lds_byte(int r, int c) { const int st = (r >> 4) * 2 + (c >> 5), rr = r & 15, cc = c & 31, ob = rr * 64 + cc * 2; return st * 1024 + (ob ^ (((ob >> 9) & 1) << 5)); }
__host__ __device__ __forceinline__ void stage_rc(int b, int& R, int& C) { const int st = b / 1024, sb = b % 1024, swz = sb ^ (((sb >> 9) & 1) << 5); R = (st >> 1) * 16 + swz / 64; C = (st & 1) * 32 + (swz % 64) / 2; }
__host__ __device__ __forceinline__ int perm32(int rho) { const int n = rho >> 4, i = rho & 15; return 8 * (i >> 2) + 4 * n + (i & 3); }

struct Unit { int pm, pn; };
struct Gemm { const bf16_t* A; const bf16_t* Bt; int M, N, K; };

struct StaticOrder {
    int nM, nN, nwg, G, c;
    __host__ __device__ void init(int M, int N, int G_, int c_) { nM = M / BM; nN = N / BM; nwg = nM * nN; G = G_; c = c_; }
    __host__ __device__ bool next(int i, Unit& u) const {
        const long L = (long)i * G + c; if (L >= nwg) return false;
        int wgid = (int)L; { const int q = nwg / NXCD, r = nwg % NXCD, xcd = wgid % NXCD, off = wgid / NXCD; wgid = (xcd < r ? xcd * (q + 1) : r * (q + 1) + (xcd - r) * q) + off; }
        const int nig = WGM * nN, gid = wgid / nig, fm = gid * WGM, gsz = (nM - fm) < WGM ? (nM - fm) : WGM;
        u.pm = fm + ((wgid % nig) % gsz); u.pn = (wgid % nig) / gsz; return true;
    }
    __device__ __forceinline__ void a_ready(const Unit&) const {}
    __device__ __forceinline__ void done(const Unit&) const {}
};
__device__ __forceinline__ unsigned cvt_pk_bf16(float lo, float hi) { unsigned r; asm volatile("v_cvt_pk_bf16_f32 %0, %1, %2" : "=v"(r) : "v"(lo), "v"(hi)); return r; }

template <class Epi, class Sched, bool STAMP = false>
__device__ __forceinline__ void gemm_phase(PG8_LAS unsigned char* lds, const Gemm g, const Sched& S, const Epi& E, unsigned long long* stamps) {
    int tid_ = threadIdx.x; asm volatile("" : "+v"(tid_)); const int tid = tid_, wid = __builtin_amdgcn_readfirstlane(tid >> 6), lane = tid & 63, wr = wid >> 2, wc = wid & 3, fr = lane & 15, fq = lane >> 4;
    const int K = g.K, nt = K / BK;
    int ts_lo = 0, ts_hi = 0, nts = 0; const unsigned long long rt_entry = STAMP ? (unsigned long long)wall_clock64() : 0ull;
#define PG8_STAMP() do { if (STAMP && wid == 0 && nts < 64) { const unsigned long long _c = (unsigned long long)clock64(); \
        ts_lo = (lane == nts) ? (int)(unsigned)_c : ts_lo; ts_hi = (lane == nts) ? (int)(unsigned)(_c >> 32) : ts_hi; ++nts; } } while (0)
    PG8_STAMP();
    unsigned voffA[2], voffB[2];
#pragma unroll
    for (int i = 0; i < 2; ++i) { int R, C; stage_rc(tid * 16 + i * 8192, R, C); const int Rb = Epi::PERM ? ((R & ~31) + perm32(R & 31)) : R;
        voffA[i] = (unsigned)(R * K + C) * 2u; voffB[i] = (unsigned)(Rb * K + C) * 2u; }
    const size_t kstep = (size_t)(BK * 2);
    const size_t hstep = (size_t)HALF * K * 2;
    const size_t tstep = 2 * hstep;
    const unsigned ldsw = (unsigned)wid * 1024u;
    const int aoff = lds_byte(wr * 64 + fr, fq * 8), boff = lds_byte(wc * 32 + fr, fq * 8);
#define PG8_SA(b, h) (((b) * 2 + (h)) * HTB)
#define PG8_SB(b, h) ((4 + (b) * 2 + (h)) * HTB)
#define PG8_STAGE(bufoff, gbase, voff) do { _Pragma("unroll") for (int _i = 0; _i < 2; ++_i) \
        __builtin_amdgcn_global_load_lds((const unsigned*)((const char*)(gbase) + (voff)[_i]), (PG8_LAS unsigned*)(lds + (bufoff) + ldsw + _i * 8192), 16, 0, 0); } while (0)
#define PG8_LDA(dst, b, h) do { _Pragma("unroll") for (int m = 0; m < 4; ++m) _Pragma("unroll") for (int k = 0; k < 2; ++k) dst[m][k] = *(const PG8_LAS bf16x8*)(lds + PG8_SA(b, h) + aoff + m * 2048 + k * 1024); } while (0)
#define PG8_LDB(dst, b, h) do { _Pragma("unroll") for (int n = 0; n < 2; ++n) _Pragma("unroll") for (int k = 0; k < 2; ++k) dst[n][k] = *(const PG8_LAS bf16x8*)(lds + PG8_SB(b, h) + boff + n * 2048 + k * 1024); } while (0)
#define PG8_MMA(ai, bj, At, Bt) do { __builtin_amdgcn_s_setprio(1); _Pragma("unroll") for (int m = 0; m < 4; ++m) _Pragma("unroll") for (int n = 0; n < 2; ++n) _Pragma("unroll") for (int k = 0; k < 2; ++k) \
        acc[ai][bj][m][n] = __builtin_amdgcn_mfma_f32_16x16x32_bf16(Bt[n][k], At[m][k], acc[ai][bj][m][n], 0, 0, 0); __builtin_amdgcn_s_setprio(0); } while (0)
#define PG8_WAIT_V(n) asm volatile("s_waitcnt vmcnt(" #n ")" ::: "memory")
#define PG8_WAIT_L(n) asm volatile("s_waitcnt lgkmcnt(" #n ")" ::: "memory")
#define PG8_BAR __builtin_amdgcn_s_barrier()
#define PG8_SCHED __builtin_amdgcn_sched_barrier(0)
    Unit cur, nxt; int ui = 0;
    if (!S.next(0, cur)) return;
    f32x4 acc[2][2][4][2];
#pragma unroll
    for (int a = 0; a < 2; ++a)
#pragma unroll
        for (int b = 0; b < 2; ++b)
#pragma unroll
            for (int m = 0; m < 4; ++m)
#pragma unroll
                for (int n = 0; n < 2; ++n) acc[a][b][m][n] = (f32x4){0.f, 0.f, 0.f, 0.f};
    bf16x8 At[4][2], B0[2][2], B1[2][2];
    const char* cA = (const char*)g.A + (size_t)cur.pm * tstep; const char* cB = (const char*)g.Bt + (size_t)cur.pn * tstep;
    S.a_ready(cur);
    PG8_STAGE(PG8_SB(0, 0), cB, voffB); PG8_STAGE(PG8_SA(0, 0), cA, voffA); PG8_STAGE(PG8_SB(0, 1), cB + hstep, voffB); PG8_STAGE(PG8_SA(0, 1), cA + hstep, voffA);
    if (wr == 1) PG8_BAR;
    PG8_WAIT_V(4); PG8_BAR;
    PG8_STAGE(PG8_SB(1, 0), cB + kstep, voffB); PG8_STAGE(PG8_SA(1, 0), cA + kstep, voffA); PG8_STAGE(PG8_SB(1, 1), cB + hstep + kstep, voffB);
    PG8_WAIT_V(6); PG8_BAR;
    PG8_STAMP();
    for (;;) {
        const bool has_next = S.next(ui + 1, nxt);
        const char* nA = has_next ? (const char*)g.A + (size_t)nxt.pm * tstep : cA; const char* nB = has_next ? (const char*)g.Bt + (size_t)nxt.pn * tstep : cB;
        for (int t = 0; t < nt; t += 2) {
            const bool last = (t == nt - 2);
            const char* a1 = cA + (size_t)(t + 1) * kstep;
            const char* a2 = last ? nA : cA + (size_t)(t + 2) * kstep; const char* b2 = last ? nB : cB + (size_t)(t + 2) * kstep;
            const char* a3 = a2 + kstep; const char* b3 = b2 + kstep;
            if (last && has_next) S.a_ready(nxt);
            PG8_LDB(B0, 0, 0); PG8_SCHED; PG8_LDA(At, 0, 0); PG8_STAGE(PG8_SA(1, 1), a1 + hstep, voffA);
            PG8_WAIT_L(8); PG8_BAR; PG8_WAIT_L(0); PG8_MMA(0, 0, At, B0); PG8_BAR; PG8_SCHED;
            PG8_LDB(B1, 0, 1); PG8_STAGE(PG8_SB(0, 0), b2, voffB);
            PG8_BAR; PG8_WAIT_L(0); PG8_MMA(0, 1, At, B1); PG8_BAR;
            PG8_LDA(At, 0, 1); PG8_STAGE(PG8_SA(0, 0), a2, voffA);
            PG8_BAR; PG8_WAIT_L(0); PG8_MMA(1, 0, At, B0); PG8_BAR; PG8_SCHED;
            PG8_STAGE(PG8_SB(0, 1), b2 + hstep, voffB);
            PG8_WAIT_V(6); PG8_BAR; PG8_MMA(1, 1, At, B1); PG8_BAR;
            PG8_LDB(B0, 1, 0); PG8_SCHED; PG8_LDA(At, 1, 0); PG8_STAGE(PG8_SA(0, 1), a2 + hstep, voffA);
            PG8_WAIT_L(8); PG8_BAR; PG8_WAIT_L(0); PG8_MMA(0, 0, At, B0); PG8_BAR; PG8_SCHED;
            PG8_LDB(B1, 1, 1); PG8_STAGE(PG8_SB(1, 0), b3, voffB);
            PG8_BAR; PG8_WAIT_L(0); PG8_MMA(0, 1, At, B1); PG8_BAR;
            PG8_LDA(At, 1, 1); PG8_STAGE(PG8_SA(1, 0), a3, voffA);
            PG8_BAR; PG8_WAIT_L(0); PG8_MMA(1, 0, At, B0); PG8_BAR; PG8_SCHED;
            PG8_STAGE(PG8_SB(1, 1), b3 + hstep, voffB);
            PG8_WAIT_V(6); PG8_BAR; PG8_MMA(1, 1, At, B1); PG8_BAR;
        }
        PG8_STAMP();
        if constexpr (!Epi::AFTER_DRAIN) { E(acc, cur, wr, wc, fr, fq); S.done(cur); }
        PG8_STAMP();
        if (!has_next) break;
#pragma unroll
        for (int a = 0; a < 2; ++a)
#pragma unroll
            for (int b = 0; b < 2; ++b)
#pragma unroll
                for (int m = 0; m < 4; ++m)
#pragma unroll
                    for (int n = 0; n < 2; ++n) acc[a][b][m][n] = (f32x4){0.f, 0.f, 0.f, 0.f};
        cur = nxt; cA = nA; cB = nB; ++ui;
    }
    PG8_WAIT_V(0);
    if (wr == 0) PG8_BAR;
    PG8_BAR;
    if constexpr (Epi::AFTER_DRAIN) { E.fused(acc, cur, wr, wc, fr, fq, lds, wid, lane); S.done(cur); }
    PG8_STAMP();
    if (STAMP && wid == 0) { stamps[lane] = lane < nts ? (((unsigned long long)(unsigned)ts_hi << 32) | (unsigned)ts_lo) : 0ull;
        if (lane == 62) stamps[62] = rt_entry; if (lane == 63) stamps[63] = (unsigned long long)wall_clock64(); }
#undef PG8_STAMP
#undef PG8_SA
#undef PG8_SB
#undef PG8_STAGE
#undef PG8_LDA
#undef PG8_LDB
#undef PG8_MMA
#undef PG8_WAIT_V
#undef PG8_WAIT_L
#undef PG8_BAR
#undef PG8_SCHED
}
}
using pg8::bf16_t; using pg8::bf16x8; using pg8::f32x4; using pg8::u32x4; using pg8::Unit; using pg8::cvt_pk_bf16;
#define LAS PG8_LAS
typedef float f32x2 __attribute__((ext_vector_type(2)));
typedef unsigned u32x2 __attribute__((ext_vector_type(2)));

constexpr int MROWS = 16640, MPROMPT = 16384, DM = 1024, FF = 2816, NIN = 3216, NINP = 3328, ACOLS = 1664, BOFF = 1664;
constexpr int NSAMP = 16, SAMP_T = 16;
constexpr size_t O_Y = 0, O_SHIFT_P = 17039360, O_WKV_P = 17041024, O_GLA_P = 17073792, O_SHIFT_S = 17106560, O_WKV_S = 17133184, O_GLA_S = 17657472, O_END = 18181760;
constexpr size_t al256(size_t x) { return (x + 255) & ~(size_t)255; }
constexpr size_t WS_W1GU = 0;
constexpr size_t WS_W1D  = WS_W1GU + (size_t)5632 * 1024 * 2;
constexpr size_t WS_WIN  = WS_W1D + (size_t)1024 * 2816 * 2;
constexpr size_t WS_WOUT = WS_WIN + (size_t)NINP * 1024 * 2;
constexpr size_t WS_W2GU = WS_WOUT + (size_t)1024 * 1024 * 2;
constexpr size_t WS_W2D  = WS_W2GU + (size_t)5632 * 1024 * 2;
constexpr size_t WS_SSQ  = WS_W2D + (size_t)1024 * 2816 * 2;
constexpr size_t SSQ_BYTES = (size_t)16 * MROWS * 4;
constexpr size_t WS_HB   = WS_SSQ + 4 * SSQ_BYTES;
constexpr size_t WS_PACT = WS_HB + (size_t)MROWS * 1024 * 2;
constexpr size_t WS_G    = WS_PACT + (size_t)MROWS * NIN * 2;
constexpr size_t WS_HSR  = WS_G + (size_t)144 * 8 * 8192;
constexpr size_t WS_HSG  = WS_HSR + (size_t)144 * 8 * 16384;
constexpr size_t WS_DECG = WS_HSG + (size_t)272 * 4 * 32768;
constexpr size_t WS_BONUS= WS_DECG + (size_t)272 * 4 * 64 * 4;
constexpr size_t WS_END  = WS_BONUS + (size_t)MROWS * 8 * 4;
constexpr size_t WS_Y    = WS_W1GU;
constexpr size_t WS_HB2  = WS_HSG;
static_assert((size_t)MROWS * 512 * 2 <= WS_WOUT, "Y overlay");
static_assert((size_t)MROWS * 1024 * 2 <= (size_t)272 * 4 * 32768, "HB2 overlay");
constexpr int LDS_BYTES = 131072;

struct Params { const float* in[31]; float* out; unsigned char* ws; };

__device__ __forceinline__ float rstd_of(const float* ssq, int nparts, int row) {
    float s = 0.f;
    for (int p = 0; p < nparts; ++p) s += ssq[(size_t)p * MROWS + row];
    return rsqrtf(s * (1.0f / 1024.0f) + 1e-6f);
}
__device__ __forceinline__ float sigmoidf_(float x) { return __builtin_amdgcn_rcpf(1.0f + __expf(-x)); }

struct EpiSwiglu {
    static constexpr bool PERM = true, AFTER_DRAIN = false;
    bf16_t* O; const float* ssq; int nparts;
    __device__ __forceinline__ void operator()(const f32x4 (&acc)[2][2][4][2], const Unit& u, int wr, int wc, int fr, int fq) const {
        const int row0 = u.pm * 256 + wr * 64 + fr, col0 = u.pn * 128 + wc * 32 + 8 * fq;
#pragma unroll
        for (int ai = 0; ai < 2; ++ai)
#pragma unroll
            for (int m = 0; m < 4; ++m) {
                const int row = row0 + ai * 128 + m * 16; const float rs = rstd_of(ssq, nparts, row);
                float a[8];
#pragma unroll
                for (int n = 0; n < 2; ++n)
#pragma unroll
                    for (int j = 0; j < 4; ++j) { const float g = acc[ai][0][m][n][j] * rs, up = acc[ai][1][m][n][j] * rs; a[n * 4 + j] = g * sigmoidf_(g) * up; }
                u32x4 w; w.x = cvt_pk_bf16(a[0], a[1]); w.y = cvt_pk_bf16(a[2], a[3]); w.z = cvt_pk_bf16(a[4], a[5]); w.w = cvt_pk_bf16(a[6], a[7]);
                *(u32x4*)(O + (size_t)row * FF + col0) = w;
            }
    }
};
struct EpiResid {
    static constexpr bool PERM = true, AFTER_DRAIN = false;
    const float* xoldA; const float* xoldB; float* xnew; bf16_t* xb; float* ssq; float scale;
    __device__ __forceinline__ void operator()(const f32x4 (&acc)[2][2][4][2], const Unit& u, int wr, int wc, int fr, int fq) const {
        const int row0 = u.pm * 256 + wr * 64 + fr, col0 = u.pn * 256 + wc * 32 + 8 * fq;
#pragma unroll
        for (int ai = 0; ai < 2; ++ai)
#pragma unroll
            for (int m = 0; m < 4; ++m) {
                const int row = row0 + ai * 128 + m * 16;
                const float* xo = row < MPROMPT ? xoldA + (size_t)row * DM : xoldB + (size_t)(row - MPROMPT) * DM;
                float sq = 0.f;
#pragma unroll
                for (int bj = 0; bj < 2; ++bj) {
                    const int col = col0 + bj * 128;
                    f32x4 v0 = *(const f32x4*)(xo + col) + acc[ai][bj][m][0] * scale, v1 = *(const f32x4*)(xo + col + 4) + acc[ai][bj][m][1] * scale;
                    *(f32x4*)(xnew + (size_t)row * DM + col) = v0; *(f32x4*)(xnew + (size_t)row * DM + col + 4) = v1;
                    if (xb) { u32x4 w; w.x = cvt_pk_bf16(v0[0], v0[1]); w.y = cvt_pk_bf16(v0[2], v0[3]); w.z = cvt_pk_bf16(v1[0], v1[1]); w.w = cvt_pk_bf16(v1[2], v1[3]);
                        *(u32x4*)(xb + (size_t)row * DM + col) = w; }
                    sq += (v0[0] * v0[0] + v0[1] * v0[1]) + (v0[2] * v0[2] + v0[3] * v0[3]) + (v1[0] * v1[0] + v1[1] * v1[1]) + (v1[2] * v1[2] + v1[3] * v1[3]);
                }
                sq += __shfl_xor(sq, 16); sq += __shfl_xor(sq, 32);
                if (fq == 0) ssq[(size_t)(u.pn * 4 + wc) * MROWS + row] = sq;
            }
    }
};
struct EpiP {
    static constexpr bool PERM = true, AFTER_DRAIN = false;
    bf16_t* P; const float* ssq; float* out;
    __device__ __forceinline__ void operator()(const f32x4 (&acc)[2][2][4][2], const Unit& u, int wr, int wc, int fr, int fq) const {
        const int row0 = u.pm * 256 + wr * 64 + fr, col0 = u.pn * 256 + wc * 32 + 8 * fq;
#pragma unroll
        for (int ai = 0; ai < 2; ++ai)
#pragma unroll
            for (int m = 0; m < 4; ++m) {
                const int row = row0 + ai * 128 + m * 16; const float rs = rstd_of(ssq, 16, row);
                float* dst = nullptr;
                if (row == MPROMPT - 1) dst = out + O_SHIFT_P;
                else if (row >= MPROMPT && ((row - MPROMPT) & 15) == 15) dst = out + O_SHIFT_S + (size_t)((row - MPROMPT) >> 4) * ACOLS;
#pragma unroll
                for (int bj = 0; bj < 2; ++bj) {
                    const int col = col0 + bj * 128;
                    if (col < NIN) {
                        const f32x4 v0 = acc[ai][bj][m][0] * rs, v1 = acc[ai][bj][m][1] * rs;
                        u32x4 w; w.x = cvt_pk_bf16(v0[0], v0[1]); w.y = cvt_pk_bf16(v0[2], v0[3]); w.z = cvt_pk_bf16(v1[0], v1[1]); w.w = cvt_pk_bf16(v1[2], v1[3]);
                        *(u32x4*)(P + (size_t)row * NIN + col) = w;
                        if (dst && col < ACOLS) { *(f32x4*)(dst + col) = v0; *(f32x4*)(dst + col + 4) = v1; }
                    }
                }
            }
    }
};
template <class Epi>
__device__ __forceinline__ void run_gemm(LAS unsigned char* lds, const bf16_t* A, const bf16_t* Bt, int N, int K, const Epi& E) {
    pg8::Gemm g; g.A = A; g.Bt = Bt; g.M = MROWS; g.N = N; g.K = K;
    pg8::StaticOrder S; S.init(MROWS, N, (int)gridDim.x, (int)blockIdx.x);
    pg8::gemm_phase<Epi, pg8::StaticOrder, false>(lds, g, S, E, nullptr);
}

__device__ __forceinline__ void cvt_tile(LAS float* tile, const float* src, int ldsrc, int nvalid, int k0, int ns0, bf16_t* dst, int K, int nd0, const float* gain) {
    const int t = threadIdx.x;
#pragma unroll
    for (int h = 0; h < 2; ++h) {
        const int i = (t >> 4) + h * 32, j4 = (t & 15) * 4;
        f32x4 v = (f32x4){0.f, 0.f, 0.f, 0.f};
        if (ns0 + j4 < nvalid) v = *(const f32x4*)(src + (size_t)(k0 + i) * ldsrc + ns0 + j4);
        const float gq = gain ? gain[k0 + i] : 1.0f;
#pragma unroll
        for (int e = 0; e < 4; ++e) tile[i * 65 + j4 + e] = v[e] * gq;
    }
    __syncthreads();
    {
        const int j = t >> 3, ks = (t & 7) * 8;
        float a[8];
#pragma unroll
        for (int e = 0; e < 8; ++e) a[e] = tile[(ks + e) * 65 + j];
        u32x4 w; w.x = cvt_pk_bf16(a[0], a[1]); w.y = cvt_pk_bf16(a[2], a[3]); w.z = cvt_pk_bf16(a[4], a[5]); w.w = cvt_pk_bf16(a[6], a[7]);
        *(u32x4*)(dst + (size_t)(nd0 + j) * K + k0 + ks) = w;
    }
    __syncthreads();
}
__device__ void phase_convert(const Params& p, LAS unsigned char* lds) {
    LAS float* tile = (LAS float*)lds;
    bf16_t* ws16 = (bf16_t*)p.ws;
    for (int tidx = blockIdx.x; tidx < 5312; tidx += gridDim.x) {
        if (tidx < 2816) {
            const int f = tidx / 1408, r = tidx % 1408, nb = r / 16, kb = r % 16, pn = nb >> 2, bj = (nb >> 1) & 1, h = nb & 1;
            const float* src = f == 0 ? (bj ? p.in[7] : p.in[6]) : (bj ? p.in[28] : p.in[27]);
            cvt_tile(tile, src, FF, FF, kb * 64, pn * 128 + h * 64, (bf16_t*)(p.ws + (f == 0 ? WS_W1GU : WS_W2GU)), 1024, nb * 64, f == 0 ? p.in[5] : p.in[26]);
        } else if (tidx < 4224) {
            const int f = (tidx - 2816) / 704, r = (tidx - 2816) % 704, nb = r / 44, kb = r % 44;
            cvt_tile(tile, f == 0 ? p.in[8] : p.in[29], 1024, 1024, kb * 64, nb * 64, (bf16_t*)(p.ws + (f == 0 ? WS_W1D : WS_W2D)), FF, nb * 64, nullptr);
        } else if (tidx < 5056) {
            const int r = tidx - 4224, nb = r / 16, kb = r % 16;
            cvt_tile(tile, p.in[10], NIN, NIN, kb * 64, nb * 64, (bf16_t*)(p.ws + WS_WIN), 1024, nb * 64, p.in[9]);
        } else {
            const int r = tidx - 5056, nb = r / 16, kb = r % 16;
            cvt_tile(tile, p.in[25], 1024, 1024, kb * 64, nb * 64, (bf16_t*)(p.ws + WS_WOUT), 1024, nb * 64, nullptr);
        }
    }
    (void)ws16;
    const int wave = threadIdx.x >> 6, lane = threadIdx.x & 63;
    float* ssq0 = (float*)(p.ws + WS_SSQ);
    bf16_t* hb = (bf16_t*)(p.ws + WS_HB);
    for (int row = blockIdx.x * 8 + wave; row < MROWS; row += gridDim.x * 8) {
        const float* x = row < MPROMPT ? p.in[0] + (size_t)row * DM : p.in[1] + (size_t)(row - MPROMPT) * DM;
        float sq = 0.f;
#pragma unroll
        for (int i = 0; i < 4; ++i) {
            const f32x4 v = *(const f32x4*)(x + i * 256 + lane * 4);
            sq += (v[0] * v[0] + v[1] * v[1]) + (v[2] * v[2] + v[3] * v[3]);
            u32x2 w; w.x = cvt_pk_bf16(v[0], v[1]); w.y = cvt_pk_bf16(v[2], v[3]);
            *(u32x2*)(hb + (size_t)row * DM + i * 256 + lane * 4) = w;
        }
#pragma unroll
        for (int o = 32; o > 0; o >>= 1) sq += __shfl_xor(sq, o);
        if (lane == 0) ssq0[row] = sq;
    }
}
__device__ void phase_final_norm(const Params& p) {
    const int wave = threadIdx.x >> 6, lane = threadIdx.x & 63;
    const float* ssq3 = (const float*)(p.ws + WS_SSQ + 3 * SSQ_BYTES);
    const float* g = p.in[30];
    for (int row = blockIdx.x * 8 + wave; row < MROWS; row += gridDim.x * 8) {
        const float rs = rstd_of(ssq3, 16, row);
        float* x = p.out + (size_t)row * DM;
#pragma unroll
        for (int i = 0; i < 4; ++i) {
            const f32x4 v = *(const f32x4*)(x + i * 256 + lane * 4), gg = *(const f32x4*)(g + i * 256 + lane * 4);
            *(f32x4*)(x + i * 256 + lane * 4) = v * rs * gg;
        }
    }
}
__device__ __forceinline__ float bf2f(bf16_t b) { return __uint_as_float(((unsigned)b) << 16); }
__device__ __forceinline__ float quad_sum(float x) {
    x += __int_as_float(__builtin_amdgcn_update_dpp(0, __float_as_int(x), 0xB1, 0xF, 0xF, true));
    x += __int_as_float(__builtin_amdgcn_update_dpp(0, __float_as_int(x), 0x4E, 0xF, 0xF, true));
    return x;
}
__device__ __forceinline__ float wave_sum(float x) {
#pragma unroll
    for (int o = 32; o > 0; o >>= 1) x += __shfl_xor(x, o);
    return x;
}
__device__ __forceinline__ float softplusf_(float x) { return fmaxf(x, 0.f) + __logf(1.0f + __expf(-fabsf(x))); }
__device__ __forceinline__ float tanhf_(float x) { return 1.0f - 2.0f * __builtin_amdgcn_rcpf(1.0f + __expf(2.0f * x)); }
__device__ __forceinline__ f32x2 lo2(f32x4 v) { return __builtin_shufflevector(v, v, 0, 1); }
__device__ __forceinline__ f32x2 hi2(f32x4 v) { return __builtin_shufflevector(v, v, 2, 3); }
__device__ __forceinline__ f32x2 bc2(float x) { return (f32x2){x, x}; }

struct Seg { int row0, nsteps, prevkind; const float* prevptr; };
__device__ __forceinline__ float xs_lerp(const bf16_t* P, const Seg& sg, int i, int col, float mu) {
    const float cur = bf2f(P[(size_t)(sg.row0 + i) * NIN + col]);
    float prev = 0.f;
    if (i > 0 || sg.prevkind == 1) prev = bf2f(P[(size_t)(sg.row0 + i - 1) * NIN + col]);
    else if (sg.prevkind == 2) prev = sg.prevptr[col];
    return cur + (prev - cur) * mu;
}
__device__ __forceinline__ void load16(const LAS float* src, f32x2 (&d)[8]) {
    const LAS f32x4* s4 = (const LAS f32x4*)src;
#pragma unroll
    for (int i = 0; i < 4; ++i) { const f32x4 v = s4[i]; d[2 * i] = lo2(v); d[2 * i + 1] = hi2(v); }
}

constexpr int RST = 384;
__device__ void rwkv_a_task(const Params& p, LAS unsigned char* lds, int tk) {
    const int tid = threadIdx.x, wave = tid >> 6, lane = tid & 63;
    const bf16_t* P = (const bf16_t*)(p.ws + WS_PACT);
    Seg sg; int ci, g;
    if (tk < 256) { const int c = tk >> 1; g = tk & 1; sg.row0 = c * 128; sg.nsteps = 128; sg.prevkind = c == 0 ? 0 : 1; sg.prevptr = nullptr; ci = c; }
    else { const int b = (tk - 256) >> 1; g = (tk - 256) & 1; sg.row0 = MPROMPT + b * 16; sg.nsteps = 16; sg.prevkind = 2; sg.prevptr = p.in[2] + (size_t)b * ACOLS; ci = 128 + b; }
    LAS float* stage = (LAS float*)lds;
    LAS float* bcs = (LAS float*)(lds + 98304) + wave * 512;
    const float* mu = p.in[11];
    const int phl = wave & 3, ptb = (wave >> 2) * 8, hd = g * 4 + phl, C = hd * 64 + lane;
    const float mu_r = mu[C], mu_k = mu[512 + C], mu_v = mu[1024 + C], mu_x = mu[1536 + lane];
    const float w0c = p.in[12][C], a0c = p.in[14][C], kkc = p.in[17][C], kac = p.in[18][C], rkc = p.in[19][C];
    const float* wup = p.in[13] + C; const float* aup = p.in[15] + C;
    float* bonus = (float*)(p.ws + WS_BONUS);
    const bool isH = wave >= 4; const int rhd = g * 4 + (wave & 3), rg = lane >> 2, ks = lane & 3;
    f32x2 s[4][8];
#pragma unroll
    for (int r = 0; r < 4; ++r)
#pragma unroll
        for (int j = 0; j < 8; ++j) { s[r][j].x = (!isH && (rg * 4 + r == ks * 16 + 2 * j)) ? 1.f : 0.f; s[r][j].y = (!isH && (rg * 4 + r == ks * 16 + 2 * j + 1)) ? 1.f : 0.f; }
    bf16_t* Yb = (bf16_t*)(p.ws + WS_Y); bf16_t* HB = (bf16_t*)(p.ws + WS_HB);
    for (int sb = 0; sb < sg.nsteps / 16; ++sb) {
        {
#pragma unroll
            for (int i = 0; i < 8; ++i) { float xv = xs_lerp(P, sg, sb * 16 + ptb + i, 1536 + lane, mu_x); if (lane < 32) xv = tanhf_(xv); bcs[i * 64 + lane] = xv; }
            float wl[8], al[8];
#pragma unroll
            for (int i = 0; i < 8; ++i) { wl[i] = w0c; al[i] = a0c; }
#pragma unroll 2
            for (int j4 = 0; j4 < 8; ++j4) {
                float wu[4], au[4];
#pragma unroll
                for (int e = 0; e < 4; ++e) { wu[e] = wup[(size_t)(j4 * 4 + e) * 512]; au[e] = aup[(size_t)(j4 * 4 + e) * 512]; }
#pragma unroll
                for (int i = 0; i < 8; ++i) {
                    const f32x4 t4 = *(const LAS f32x4*)(bcs + i * 64 + j4 * 4), x4 = *(const LAS f32x4*)(bcs + i * 64 + 32 + j4 * 4);
#pragma unroll
                    for (int e = 0; e < 4; ++e) { wl[i] += t4[e] * wu[e]; al[i] += x4[e] * au[e]; }
                }
            }
#pragma unroll
            for (int i = 0; i < 8; ++i) {
                const int ti = sb * 16 + ptb + i, row = sg.row0 + ti;
                const float r = xs_lerp(P, sg, ti, C, mu_r), k = xs_lerp(P, sg, ti, 512 + C, mu_k), v = xs_lerp(P, sg, ti, 1024 + C, mu_v);
                const float wlog = -softplusf_(-wl[i]) - 0.5f, dec = __expf(-__expf(wlog));
                const float a = sigmoidf_(al[i]);
                float kk = k * kkc; const float n2 = wave_sum(kk * kk); kk = kk / fmaxf(sqrtf(n2), 1e-12f);
                const float kmod = k * (1.0f + (a - 1.0f) * kac), kka = kk * a;
                const float bs = wave_sum(r * kmod * rkc);
                if (lane == 0) bonus[(size_t)row * 8 + hd] = bs;
                LAS float* st = stage + ((ptb + i) * 4 + phl) * RST;
                st[lane] = dec; st[64 + lane] = kk; st[128 + lane] = kka; st[192 + lane] = kmod; st[256 + lane] = r; st[320 + lane] = v;
            }
        }
        __syncthreads();
        for (int tl = 0; tl < 16; ++tl) {
            const LAS float* st = stage + (tl * 4 + (wave & 3)) * RST;
            const int row = sg.row0 + sb * 16 + tl;
            f32x2 w2[8], kk2[8], ka2[8], r2[8];
            load16(st + ks * 16, w2); load16(st + 64 + ks * 16, kk2); load16(st + 128 + ks * 16, ka2); load16(st + 256 + ks * 16, r2);
            float sa[4];
#pragma unroll
            for (int r = 0; r < 4; ++r) { f32x2 acc = s[r][0] * kk2[0];
#pragma unroll
                for (int j = 1; j < 8; ++j) acc = s[r][j] * kk2[j] + acc;
                sa[r] = quad_sum(acc.x + acc.y); }
            float yo[4];
            if (!isH) {
#pragma unroll
                for (int r = 0; r < 4; ++r) { const f32x2 nsa = bc2(-sa[r]);
#pragma unroll
                    for (int j = 0; j < 8; ++j) s[r][j] = s[r][j] * w2[j] + nsa * ka2[j]; }
            } else {
                f32x2 km2[8]; load16(st + 192 + ks * 16, km2);
                const f32x4 v4 = *(const LAS f32x4*)(st + 320 + rg * 4);
#pragma unroll
                for (int r = 0; r < 4; ++r) { const f32x2 nsa = bc2(-sa[r]), vv = bc2(v4[r]);
#pragma unroll
                    for (int j = 0; j < 8; ++j) s[r][j] = (s[r][j] * w2[j] + nsa * ka2[j]) + vv * km2[j]; }
            }
#pragma unroll
            for (int r = 0; r < 4; ++r) { f32x2 acc = s[r][0] * r2[0];
#pragma unroll
                for (int j = 1; j < 8; ++j) acc = s[r][j] * r2[j] + acc;
                yo[r] = quad_sum(acc.x + acc.y); }
            if (ks == 0) {
                u32x2 w; w.x = cvt_pk_bf16(yo[0], yo[1]); w.y = cvt_pk_bf16(yo[2], yo[3]);
                if (!isH) *(u32x2*)(Yb + (size_t)row * 512 + rhd * 64 + rg * 4) = w;
                else *(u32x2*)(HB + (size_t)row * 1024 + rhd * 64 + rg * 4) = w;
            }
        }
        __syncthreads();
    }
    if (!isH) {
        bf16_t* Gf = (bf16_t*)(p.ws + WS_G) + (size_t)(ci * 8 + rhd) * 4096;
#pragma unroll
        for (int j = 0; j < 8; ++j)
#pragma unroll
            for (int h = 0; h < 2; ++h) {
                const int jj = 2 * j + h;
                u32x2 w; w.x = cvt_pk_bf16(h ? s[0][j].y : s[0][j].x, h ? s[1][j].y : s[1][j].x); w.y = cvt_pk_bf16(h ? s[2][j].y : s[2][j].x, h ? s[3][j].y : s[3][j].x);
                *(u32x2*)(Gf + (size_t)((ks * 2 + (rg >> 3)) * 64 + (rg & 3) * 16 + jj) * 8 + ((rg >> 2) & 1) * 4) = w;
            }
    } else {
        float* Hs = (float*)(p.ws + WS_HSR) + (size_t)(ci * 8 + rhd) * 4096;
#pragma unroll
        for (int r = 0; r < 4; ++r)
#pragma unroll
            for (int q = 0; q < 4; ++q) *(f32x4*)(Hs + (rg * 4 + r) * 64 + ks * 16 + q * 4) = (f32x4){s[r][2 * q].x, s[r][2 * q].y, s[r][2 * q + 1].x, s[r][2 * q + 1].y};
    }
}

constexpr int GST = 320;
__device__ void gla_a_task(const Params& p, LAS unsigned char* lds, int tk) {
    const int tid = threadIdx.x, wave = tid >> 6, lane = tid & 63;
    const bf16_t* P = (const bf16_t*)(p.ws + WS_PACT) + BOFF;
    int row0, nsteps, ci;
    if (tk < 256) { row0 = tk * 64; nsteps = 64; ci = tk; } else { row0 = MPROMPT + (tk - 256) * 16; nsteps = 16; ci = tk; }
    LAS float* stage = (LAS float*)lds;
    LAS float* red = (LAS float*)(lds + 98304);
    const int hd = wave >> 1, half = wave & 1, rg = lane >> 2, ks = lane & 3;
    const int kc = hd * 64 + lane;
    float gku[16];
#pragma unroll
    for (int j = 0; j < 16; ++j) gku[j] = p.in[22][j * 256 + kc];
    const float gkb = p.in[23][kc];
    float lsum = 0.f;
    f32x2 s[4][8];
#pragma unroll
    for (int r = 0; r < 4; ++r)
#pragma unroll
        for (int j = 0; j < 8; ++j) s[r][j] = (f32x2){0.f, 0.f};
    bf16_t* HB = (bf16_t*)(p.ws + WS_HB);
    for (int sb = 0; sb < nsteps / 16; ++sb) {
#pragma unroll 2
        for (int i = 0; i < 8; ++i) {
            const int tl = half * 8 + i; const bf16_t* pr = P + (size_t)(row0 + sb * 16 + tl) * NIN;
            float gl = gkb;
#pragma unroll
            for (int j = 0; j < 16; ++j) gl += bf2f(pr[1024 + j]) * gku[j];
            const float la = -softplusf_(-gl) * (1.0f / 16.0f);
            lsum += la;
            LAS float* st = stage + (tl * 4 + hd) * GST;
            st[lane] = __expf(la); st[64 + lane] = bf2f(pr[256 + kc]); st[128 + lane] = bf2f(pr[kc]) * 0.125f;
            st[192 + lane] = bf2f(pr[512 + hd * 128 + lane]); st[256 + lane] = bf2f(pr[512 + hd * 128 + 64 + lane]);
        }
        __syncthreads();
        for (int tl = 0; tl < 16; ++tl) {
            const LAS float* st = stage + (tl * 4 + hd) * GST;
            const int row = row0 + sb * 16 + tl;
            f32x2 a2[8], k2[8], q2[8];
            load16(st + ks * 16, a2); load16(st + 64 + ks * 16, k2); load16(st + 128 + ks * 16, q2);
            const f32x4 v4 = *(const LAS f32x4*)(st + 192 + half * 64 + rg * 4);
            float zo[4];
#pragma unroll
            for (int r = 0; r < 4; ++r) { const f32x2 vv = bc2(v4[r]); f32x2 acc = (f32x2){0.f, 0.f};
#pragma unroll
                for (int j = 0; j < 8; ++j) { s[r][j] = s[r][j] * a2[j] + vv * k2[j]; acc = s[r][j] * q2[j] + acc; }
                zo[r] = quad_sum(acc.x + acc.y); }
            if (ks == 0) { u32x2 w; w.x = cvt_pk_bf16(zo[0], zo[1]); w.y = cvt_pk_bf16(zo[2], zo[3]);
                *(u32x2*)(HB + (size_t)row * 1024 + 512 + hd * 128 + half * 64 + rg * 4) = w; }
        }
        __syncthreads();
    }
    float* Hs = (float*)(p.ws + WS_HSG) + (size_t)(ci * 4 + hd) * 8192;
#pragma unroll
    for (int j = 0; j < 8; ++j) {
        *(f32x4*)(Hs + (ks * 16 + 2 * j) * 128 + half * 64 + rg * 4) = (f32x4){s[0][j].x, s[1][j].x, s[2][j].x, s[3][j].x};
        *(f32x4*)(Hs + (ks * 16 + 2 * j + 1) * 128 + half * 64 + rg * 4) = (f32x4){s[0][j].y, s[1][j].y, s[2][j].y, s[3][j].y};
    }
    red[wave * 64 + lane] = lsum;
    __syncthreads();
    if (half == 0) ((float*)(p.ws + WS_DECG))[(size_t)(ci * 4 + hd) * 64 + lane] = __expf(red[wave * 64 + lane] + red[(wave + 1) * 64 + lane]);
    __syncthreads();
}
__device__ void phase_mix_a(const Params& p, LAS unsigned char* lds) {
    for (int t = blockIdx.x; t < 288; t += gridDim.x) rwkv_a_task(p, lds, t);
    for (int t = blockIdx.x; t < 272; t += gridDim.x) gla_a_task(p, lds, t);
}

__device__ void rwkv_scan_job(const Params& p, int head, int vt, int ci0, int nchunks, const float* S0, float* Sout) {
    const int lane = threadIdx.x & 63, n = lane & 15, q = lane >> 4, v = vt * 16 + n;
    f32x4 D[4];
#pragma unroll
    for (int jt = 0; jt < 4; ++jt) D[jt] = S0 ? *(const f32x4*)(S0 + v * 64 + jt * 16 + q * 4) : (f32x4){0.f, 0.f, 0.f, 0.f};
    for (int c = 0; c < nchunks; ++c) {
        const int ci = ci0 + c;
        float* HS = (float*)(p.ws + WS_HSR) + (size_t)(ci * 8 + head) * 4096;
        const bf16x8* Gf = (const bf16x8*)(p.ws + WS_G + (size_t)(ci * 8 + head) * 8192);
        f32x4 Hc[4]; bf16x8 A[4][2];
#pragma unroll
        for (int jt = 0; jt < 4; ++jt) { Hc[jt] = *(const f32x4*)(HS + v * 64 + jt * 16 + q * 4); A[jt][0] = Gf[(jt * 2 + 0) * 64 + lane]; A[jt][1] = Gf[(jt * 2 + 1) * 64 + lane]; }
#pragma unroll
        for (int jt = 0; jt < 4; ++jt) *(f32x4*)(HS + v * 64 + jt * 16 + q * 4) = D[jt];
        bf16x8 B[2];
#pragma unroll
        for (int kh = 0; kh < 2; ++kh) { u32x4 w; w.x = cvt_pk_bf16(D[2 * kh][0], D[2 * kh][1]); w.y = cvt_pk_bf16(D[2 * kh][2], D[2 * kh][3]);
            w.z = cvt_pk_bf16(D[2 * kh + 1][0], D[2 * kh + 1][1]); w.w = cvt_pk_bf16(D[2 * kh + 1][2], D[2 * kh + 1][3]); B[kh] = __builtin_bit_cast(bf16x8, w); }
#pragma unroll
        for (int jt = 0; jt < 4; ++jt) { f32x4 d = __builtin_amdgcn_mfma_f32_16x16x32_bf16(A[jt][0], B[0], Hc[jt], 0, 0, 0); D[jt] = __builtin_amdgcn_mfma_f32_16x16x32_bf16(A[jt][1], B[1], d, 0, 0, 0); }
    }
#pragma unroll
    for (int jt = 0; jt < 4; ++jt) *(f32x4*)(Sout + v * 64 + jt * 16 + q * 4) = D[jt];
}
__device__ void phase_scan(const Params& p) {
    const int tid = threadIdx.x, wave = tid >> 6, b = blockIdx.x;
    float* HSG = (float*)(p.ws + WS_HSG); const float* DEC = (const float*)(p.ws + WS_DECG);
    if (b < 16) {
        const int e = (b * 512 + tid) * 4, hd = e >> 13, k = (e >> 7) & 63;
        f32x4 S = (f32x4){0.f, 0.f, 0.f, 0.f};
        for (int c = 0; c < 256; c += 4) {
            f32x4 t[4]; float d[4];
#pragma unroll
            for (int u = 0; u < 4; ++u) { t[u] = *(const f32x4*)(HSG + (size_t)(c + u) * 32768 + e); d[u] = DEC[(size_t)((c + u) * 4 + hd) * 64 + k]; }
#pragma unroll
            for (int u = 0; u < 4; ++u) { *(f32x4*)(HSG + (size_t)(c + u) * 32768 + e) = S; S = S * d[u] + t[u]; }
        }
        *(f32x4*)(p.out + O_GLA_P + e) = S;
    } else if (b < 24) {
        if (wave < 4) rwkv_scan_job(p, b - 16, wave, 0, 128, nullptr, p.out + O_WKV_P + (size_t)(b - 16) * 4096);
    } else {
        const int nb = gridDim.x - 24, bb = b - 24;
        for (int j = bb * 8 + wave; j < 512; j += nb * 8) { const int sb = j >> 5, hd = (j >> 2) & 7, vt = j & 3;
            rwkv_scan_job(p, hd, vt, 128 + sb, 1, p.in[3] + (size_t)(sb * 8 + hd) * 4096, p.out + O_WKV_S + (size_t)(sb * 8 + hd) * 4096); }
        for (int i = bb * 512 + tid; i < 16 * 8192; i += nb * 512) { const int sb = i >> 13, e = (i & 8191) * 4, hd = e >> 13, k = (e >> 7) & 63;
            const f32x4 S0 = *(const f32x4*)(p.in[4] + (size_t)sb * 32768 + e); float* hp = HSG + (size_t)(256 + sb) * 32768 + e;
            const f32x4 t = *(const f32x4*)hp; const float d = DEC[(size_t)((256 + sb) * 4 + hd) * 64 + k];
            *(f32x4*)hp = S0; *(f32x4*)(p.out + O_GLA_S + (size_t)sb * 32768 + e) = S0 * d + t; }
    }
}

__device__ void rwkv_c_task(const Params& p, LAS float* wl, int ci, int tok0, int ntok, int hd, const Seg& sg) {
    const int lane = threadIdx.x & 63, C = hd * 64 + lane;
    const bf16_t* P = (const bf16_t*)(p.ws + WS_PACT);
    const bf16_t* Yb = (const bf16_t*)(p.ws + WS_Y); bf16_t* HB = (bf16_t*)(p.ws + WS_HB);
    const float* Ss = (const float*)(p.ws + WS_HSR) + (size_t)(ci * 8 + hd) * 4096 + lane * 64;
    const float* bonus = (const float*)(p.ws + WS_BONUS);
    LAS float* Yf = wl; LAS float* SG = wl + 2048;
    const float* mu = p.in[11];
    const float mu_g = mu[1600 + lane], mu_v = mu[1024 + C], lw = p.in[20][C], lb = p.in[21][C];
    for (int i = 0; i < ntok; ++i) {
        Yf[i * 64 + lane] = bf2f(Yb[(size_t)(sg.row0 + tok0 + i) * 512 + C]);
        SG[i * 64 + lane] = sigmoidf_(xs_lerp(P, sg, tok0 + i, 1600 + lane, mu_g));
    }
    {
        f32x4 G4[16];
#pragma unroll
        for (int j = 0; j < 16; ++j) G4[j] = (f32x4){p.in[16][(size_t)(4 * j) * 512 + C], p.in[16][(size_t)(4 * j + 1) * 512 + C], p.in[16][(size_t)(4 * j + 2) * 512 + C], p.in[16][(size_t)(4 * j + 3) * 512 + C]};
        for (int i = 0; i < ntok; ++i) {
            f32x4 ag = (f32x4){0.f, 0.f, 0.f, 0.f};
#pragma unroll
            for (int j = 0; j < 16; ++j) ag += *(const LAS f32x4*)(SG + i * 64 + j * 4) * G4[j];
            SG[i * 64 + lane] = (ag[0] + ag[1]) + (ag[2] + ag[3]);
        }
    }
    f32x4 S4[16];
#pragma unroll
    for (int j = 0; j < 16; ++j) S4[j] = *(const f32x4*)(Ss + j * 4);
    for (int i = 0; i < ntok; ++i) {
        const int row = sg.row0 + tok0 + i;
        f32x4 ao = (f32x4){0.f, 0.f, 0.f, 0.f};
#pragma unroll
        for (int j = 0; j < 16; ++j) ao += *(const LAS f32x4*)(Yf + i * 64 + j * 4) * S4[j];
        const float o = (ao[0] + ao[1]) + (ao[2] + ao[3]) + bf2f(HB[(size_t)row * 1024 + C]);
        const float gate = SG[i * 64 + lane];
        const float mean = wave_sum(o) * (1.0f / 64.0f), d = o - mean, var = wave_sum(d * d) * (1.0f / 64.0f);
        const float on = d * rsqrtf(var + 64e-5f) * lw + lb;
        const float v = xs_lerp(P, sg, tok0 + i, 1024 + C, mu_v);
        const float res = (on + bonus[(size_t)row * 8 + hd] * v) * gate;
        HB[(size_t)row * 1024 + C] = (bf16_t)(cvt_pk_bf16(res, 0.f) & 0xffffu);
    }
}
__device__ void gla_c_task(const Params& p, LAS float* wl, int ci, int row0, int ntok, int hd) {
    const int lane = threadIdx.x & 63, kc = hd * 64 + lane;
    const bf16_t* P = (const bf16_t*)(p.ws + WS_PACT) + BOFF; bf16_t* HB = (bf16_t*)(p.ws + WS_HB);
    const float* Ss = (const float*)(p.ws + WS_HSG) + (size_t)(ci * 4 + hd) * 8192;
    LAS float* QT = wl;
    float gku[16];
#pragma unroll
    for (int j = 0; j < 16; ++j) gku[j] = p.in[22][j * 256 + kc];
    const float gkb = p.in[23][kc];
    float bsum = 0.f;
    for (int i = 0; i < ntok; ++i) {
        const bf16_t* pr = P + (size_t)(row0 + i) * NIN;
        float gl = gkb;
#pragma unroll
        for (int j = 0; j < 16; ++j) gl += bf2f(pr[1024 + j]) * gku[j];
        bsum += -softplusf_(-gl) * (1.0f / 16.0f);
        QT[i * 64 + lane] = bf2f(pr[kc]) * 0.125f * __expf(bsum);
    }
    f32x2 S2[64];
#pragma unroll
    for (int k = 0; k < 64; ++k) S2[k] = (f32x2){Ss[k * 128 + lane], Ss[k * 128 + 64 + lane]};
    const float ng0 = p.in[24][lane], ng1 = p.in[24][64 + lane];
    for (int i = 0; i < ntok; ++i) {
        const int row = row0 + i;
        f32x2 acc = (f32x2){0.f, 0.f};
#pragma unroll
        for (int j = 0; j < 16; ++j) { const f32x4 q4 = *(const LAS f32x4*)(QT + i * 64 + j * 4);
            acc = S2[4 * j] * bc2(q4[0]) + acc; acc = S2[4 * j + 1] * bc2(q4[1]) + acc; acc = S2[4 * j + 2] * bc2(q4[2]) + acc; acc = S2[4 * j + 3] * bc2(q4[3]) + acc; }
        bf16_t* ob = HB + (size_t)row * 1024 + 512 + hd * 128;
        const float o0 = acc.x + bf2f(ob[lane]), o1 = acc.y + bf2f(ob[64 + lane]);
        const float ms = wave_sum(o0 * o0 + o1 * o1) * (1.0f / 128.0f), rs = rsqrtf(ms + 1e-6f);
        const bf16_t* pr = P + (size_t)row * NIN + 1040 + hd * 128;
        const float g0 = bf2f(pr[lane]), g1 = bf2f(pr[64 + lane]);
        ob[lane] = (bf16_t)(cvt_pk_bf16(o0 * rs * ng0 * g0 * sigmoidf_(g0), 0.f) & 0xffffu);
        ob[64 + lane] = (bf16_t)(cvt_pk_bf16(o1 * rs * ng1 * g1 * sigmoidf_(g1), 0.f) & 0xffffu);
    }
}
__device__ void phase_mix_c(const Params& p, LAS unsigned char* lds) {
    const int wave = threadIdx.x >> 6, gw = blockIdx.x * 8 + wave, nw = gridDim.x * 8;
    LAS float* wl = (LAS float*)(lds + wave * 16384);
    for (int j = gw; j < 1088; j += nw) {
        int ci, row0, ntok, hd;
        if (j < 1024) { ci = j >> 2; row0 = ci * 64; ntok = 64; hd = j & 3; }
        else { const int r = j - 1024, sb = r >> 2; ci = 256 + sb; row0 = MPROMPT + sb * 16; ntok = 16; hd = r & 3; }
        gla_c_task(p, wl, ci, row0, ntok, hd);
    }
    for (int j = nw - 1 - gw; j < 4224; j += nw) {
        Seg sg; int ci, tok0, ntok, hd;
        if (j < 4096) { const int c = j >> 5; ci = c; tok0 = ((j >> 3) & 3) * 32; ntok = 32; hd = j & 7; sg.row0 = c * 128; sg.nsteps = 128; sg.prevkind = c == 0 ? 0 : 1; sg.prevptr = nullptr; }
        else { const int r = j - 4096, sb = r >> 3; ci = 128 + sb; tok0 = 0; ntok = 16; hd = r & 7; sg.row0 = MPROMPT + sb * 16; sg.nsteps = 16; sg.prevkind = 2; sg.prevptr = p.in[2] + (size_t)sb * ACOLS; }
        rwkv_c_task(p, wl, ci, tok0, ntok, hd, sg);
    }
}
#define MIXER_PHASES phase_mix_a(p, lds); grid.sync(); phase_scan(p); grid.sync(); phase_mix_c(p, lds); grid.sync();
__global__ void __launch_bounds__(512, 2) fwd_megakernel(Params p) {
    extern __shared__ __attribute__((aligned(16))) unsigned char shm[];
    LAS unsigned char* lds = (LAS unsigned char*)shm;
    cg::grid_group grid = cg::this_grid();
    float* ssq = (float*)(p.ws + WS_SSQ);
    bf16_t* HB = (bf16_t*)(p.ws + WS_HB); bf16_t* HB2 = (bf16_t*)(p.ws + WS_HB2); bf16_t* PACT = (bf16_t*)(p.ws + WS_PACT);
    float* XRES = p.out;

    phase_convert(p, lds);
    grid.sync();
    { EpiSwiglu E; E.O = PACT; E.ssq = ssq; E.nparts = 1; run_gemm(lds, HB, (const bf16_t*)(p.ws + WS_W1GU), 5632, 1024, E); }
    grid.sync();
    { EpiResid E; E.xoldA = p.in[0]; E.xoldB = p.in[1]; E.xnew = XRES; E.xb = HB; E.ssq = ssq + 16 * MROWS; E.scale = 0.5f; run_gemm(lds, PACT, (const bf16_t*)(p.ws + WS_W1D), 1024, FF, E); }
    grid.sync();
    { EpiP E; E.P = PACT; E.ssq = ssq + 16 * MROWS; E.out = p.out; run_gemm(lds, HB, (const bf16_t*)(p.ws + WS_WIN), NINP, 1024, E); }
    grid.sync();
    MIXER_PHASES
    { EpiResid E; E.xoldA = XRES; E.xoldB = XRES + (size_t)MPROMPT * DM; E.xnew = XRES; E.xb = HB2; E.ssq = ssq + 32 * MROWS; E.scale = 1.0f; run_gemm(lds, HB, (const bf16_t*)(p.ws + WS_WOUT), 1024, 1024, E); }
    grid.sync();
    { EpiSwiglu E; E.O = PACT; E.ssq = ssq + 32 * MROWS; E.nparts = 16; run_gemm(lds, HB2, (const bf16_t*)(p.ws + WS_W2GU), 5632, 1024, E); }
    grid.sync();
    { EpiResid E; E.xoldA = XRES; E.xoldB = XRES + (size_t)MPROMPT * DM; E.xnew = XRES; E.xb = nullptr; E.ssq = ssq + 48 * MROWS; E.scale = 0.5f; run_gemm(lds, PACT, (const bf16_t*)(p.ws + WS_W2D), 1024, FF, E); }
    grid.sync();
    phase_final_norm(p);
}

extern "C" void kernel_launch(void* const* d_in, const int* in_sizes, int n_in, void* d_out, int out_size, void* d_ws, size_t ws_size, hipStream_t stream) {
    static int grid = 0;
    if (grid == 0) {
        if (n_in != 31 || (size_t)out_size != O_END || ws_size < WS_END) { fprintf(stderr, "kernel_launch: unexpected sizes n_in %d out %d ws %zu (need %zu)\n", n_in, out_size, ws_size, (size_t)WS_END); grid = -1; return; }
        int dev = 0, cus = 0, per_cu = 0;
        hipGetDevice(&dev); hipDeviceGetAttribute(&cus, hipDeviceAttributeMultiprocessorCount, dev);
        if (hipFuncSetAttribute((const void*)fwd_megakernel, hipFuncAttributeMaxDynamicSharedMemorySize, LDS_BYTES) != hipSuccess) { fprintf(stderr, "kernel_launch: hipFuncSetAttribute failed\n"); grid = -1; return; }
        if (hipOccupancyMaxActiveBlocksPerMultiprocessor(&per_cu, (const void*)fwd_megakernel, 512, LDS_BYTES) != hipSuccess || per_cu < 1) { fprintf(stderr, "kernel_launch: occupancy query says %d\n", per_cu); per_cu = 1; }
        (void)hipGetLastError();
        grid = cus;
    }
    if (grid < 0) return;
    Params p{};
    for (int i = 0; i < 31; ++i) p.in[i] = (const float*)d_in[i];
    p.out = (float*)d_out; p.ws = (unsigned char*)d_ws;
    void* args[] = {&p};
    hipError_t e = hipLaunchCooperativeKernel((const void*)fwd_megakernel, dim3(grid), dim3(512), args, LDS_BYTES, stream);
    if (e != hipSuccess) fprintf(stderr, "cooperative launch failed: %s (grid %d)\n", hipGetErrorString(e), grid);
}
```

```cpp
#include <hip/hip_runtime.h>
#include <hip/hip_cooperative_groups.h>
#include <cstdio>
namespace cg = cooperative_groups;
#define BARRIER_KIND 2
#define GLA2_SEL -1
#ifndef DUP_PHASE
#define DUP_PHASE -1
#define DUP_N 1
#define DUP_MASK 3
#endif
namespace pg8 {
#define PG8_LAS __attribute__((address_space(3)))
typedef unsigned short bf16_t;
typedef short bf16x8 __attribute__((ext_vector_type(8)));
typedef float f32x4 __attribute__((ext_vector_type(4)));
typedef unsigned u32x4 __attribute__((ext_vector_type(4)));
constexpr int BM = 256, BK = 64, HALF = 128, HTB = HALF * BK * 2  , STAGE_BYTES = 8 * HTB, NXCD = 8, WGM = 8;

__host__ __device__ __forceinline__ int lds_byte(int r, int c) { const int st = (r >> 4) * 2 + (c >> 5), rr = r & 15, cc = c & 31, ob = rr * 64 + cc * 2; return st * 1024 + (ob ^ (((ob >> 9) & 1) << 5)); }
__host__ __device__ __forceinline__ void stage_rc(int b, int& R, int& C) { const int st = b / 1024, sb = b % 1024, swz = sb ^ (((sb >> 9) & 1) << 5); R = (st >> 1) * 16 + swz / 64; C = (st & 1) * 32 + (swz % 64) / 2; }
__host__ __device__ __forceinline__ int perm32(int rho) { const int n = rho >> 4, i = rho & 15; return 8 * (i >> 2) + 4 * n + (i & 3); }

struct Unit { int pm, pn, k0, nkt, part; };
struct Gemm { const bf16_t* A; const bf16_t* Bt; int M, N, K; };

struct StaticOrder {
    int nM, nN, nwg, G, c, nkt;
    __host__ __device__ void init(int M, int N, int G_, int c_, int K_ = 0) { nM = M / BM; nN = N / BM; nwg = nM * nN; G = G_; c = c_; nkt = K_ / BK; }
    __host__ __device__ bool next(int i, Unit& u) const {
        const long L = (long)i * G + c; if (L >= nwg) return false;
        int wgid = (int)L; { const int q = nwg / NXCD, r = nwg % NXCD, xcd = wgid % NXCD, off = wgid / NXCD; wgid = (xcd < r ? xcd * (q + 1) : r * (q + 1) + (xcd - r) * q) + off; }
        const int nig = WGM * nN, gid = wgid / nig, fm = gid * WGM, gsz = (nM - fm) < WGM ? (nM - fm) : WGM;
        u.pm = fm + ((wgid % nig) % gsz); u.pn = (wgid % nig) / gsz; u.k0 = 0; u.nkt = nkt; u.part = -1; return true;
    }
    __device__ __forceinline__ void a_ready(const Unit&) const {}
    __device__ __forceinline__ void done(const Unit&) const {}
};
__device__ __forceinline__ unsigned cvt_pk_bf16(float lo, float hi) { unsigned r; asm volatile("v_cvt_pk_bf16_f32 %0, %1, %2" : "=v"(r) : "v"(lo), "v"(hi)); return r; }

template <class Epi, class Sched, bool STAMP = false>
__device__ __forceinline__ void gemm_phase(PG8_LAS unsigned char* lds, const Gemm g, const Sched& S, const Epi& E, unsigned long long* stamps) {
    int tid_ = threadIdx.x; asm volatile("" : "+v"(tid_)); const int tid = tid_, wid = __builtin_amdgcn_readfirstlane(tid >> 6), lane = tid & 63, wr = wid >> 2, wc = wid & 3, fr = lane & 15, fq = lane >> 4;
    const int K = g.K;
    int ts_lo = 0, ts_hi = 0, nts = 0; const unsigned long long rt_entry = STAMP ? (unsigned long long)wall_clock64() : 0ull;
#define PG8_STAMP() do { if (STAMP && wid == 0 && nts < 64) { const unsigned long long _c = (unsigned long long)clock64(); \
        ts_lo = (lane == nts) ? (int)(unsigned)_c : ts_lo; ts_hi = (lane == nts) ? (int)(unsigned)(_c >> 32) : ts_hi; ++nts; } } while (0)
    PG8_STAMP();
    unsigned voffA[2], voffB[2];
#pragma unroll
    for (int i = 0; i < 2; ++i) { int R, C; stage_rc(tid * 16 + i * 8192, R, C); const int Rb = Epi::PERM ? ((R & ~31) + perm32(R & 31)) : R;
        voffA[i] = (unsigned)(R * K + C) * 2u; voffB[i] = (unsigned)(Rb * K + C) * 2u; }
    const size_t kstep = (size_t)(BK * 2);
    const size_t hstep = (size_t)HALF * K * 2;
    const size_t tstep = 2 * hstep;
    const unsigned ldsw = (unsigned)wid * 1024u;
    const int aoff = lds_byte(wr * 64 + fr, fq * 8), boff = lds_byte(wc * 32 + fr, fq * 8);
#define PG8_SA(b, h) (((b) * 2 + (h)) * HTB)
#define PG8_SB(b, h) ((4 + (b) * 2 + (h)) * HTB)
#define PG8_STAGE(bufoff, gbase, voff) do { _Pragma("unroll") for (int _i = 0; _i < 2; ++_i) \
        __builtin_amdgcn_global_load_lds((const unsigned*)((const char*)(gbase) + (voff)[_i]), (PG8_LAS unsigned*)(lds + (bufoff) + ldsw + _i * 8192), 16, 0, 0); } while (0)
#define PG8_LDA(dst, b, h) do { _Pragma("unroll") for (int m = 0; m < 4; ++m) _Pragma("unroll") for (int k = 0; k < 2; ++k) dst[m][k] = *(const PG8_LAS bf16x8*)(lds + PG8_SA(b, h) + aoff + m * 2048 + k * 1024); } while (0)
#define PG8_LDB(dst, b, h) do { _Pragma("unroll") for (int n = 0; n < 2; ++n) _Pragma("unroll") for (int k = 0; k < 2; ++k) dst[n][k] = *(const PG8_LAS bf16x8*)(lds + PG8_SB(b, h) + boff + n * 2048 + k * 1024); } while (0)
#define PG8_MMA(ai, bj, At, Bt) do { __builtin_amdgcn_s_setprio(1); _Pragma("unroll") for (int m = 0; m < 4; ++m) _Pragma("unroll") for (int n = 0; n < 2; ++n) _Pragma("unroll") for (int k = 0; k < 2; ++k) \
        acc[ai][bj][m][n] = __builtin_amdgcn_mfma_f32_16x16x32_bf16(Bt[n][k], At[m][k], acc[ai][bj][m][n], 0, 0, 0); __builtin_amdgcn_s_setprio(0); } while (0)
#define PG8_WAIT_V(n) asm volatile("s_waitcnt vmcnt(" #n ")" ::: "memory")
#define PG8_WAIT_L(n) asm volatile("s_waitcnt lgkmcnt(" #n ")" ::: "memory")
#define PG8_BAR __builtin_amdgcn_s_barrier()
#define PG8_SCHED __builtin_amdgcn_sched_barrier(0)
    Unit cur, nxt; int ui = 0;
    if (!S.next(0, cur)) return;
    f32x4 acc[2][2][4][2];
#pragma unroll
    for (int a = 0; a < 2; ++a)
#pragma unroll
        for (int b = 0; b < 2; ++b)
#pragma unroll
            for (int m = 0; m < 4; ++m)
#pragma unroll
                for (int n = 0; n < 2; ++n) acc[a][b][m][n] = (f32x4){0.f, 0.f, 0.f, 0.f};
    bf16x8 At[4][2], B0[2][2], B1[2][2];
    const char* cA = (const char*)g.A + (size_t)cur.pm * tstep + (size_t)cur.k0 * kstep; const char* cB = (const char*)g.Bt + (size_t)cur.pn * tstep + (size_t)cur.k0 * kstep;
    S.a_ready(cur);
    PG8_STAGE(PG8_SB(0, 0), cB, voffB); PG8_STAGE(PG8_SA(0, 0), cA, voffA); PG8_STAGE(PG8_SB(0, 1), cB + hstep, voffB); PG8_STAGE(PG8_SA(0, 1), cA + hstep, voffA);
    if (wr == 1) PG8_BAR;
    PG8_WAIT_V(4); PG8_BAR;
    PG8_STAGE(PG8_SB(1, 0), cB + kstep, voffB); PG8_STAGE(PG8_SA(1, 0), cA + kstep, voffA); PG8_STAGE(PG8_SB(1, 1), cB + hstep + kstep, voffB);
    PG8_WAIT_V(6); PG8_BAR;
    PG8_STAMP();
    for (;;) {
        const bool has_next = S.next(ui + 1, nxt);
        const char* nA = has_next ? (const char*)g.A + (size_t)nxt.pm * tstep + (size_t)nxt.k0 * kstep : cA; const char* nB = has_next ? (const char*)g.Bt + (size_t)nxt.pn * tstep + (size_t)nxt.k0 * kstep : cB;
        const int nt = cur.nkt;
        for (int t = 0; t < nt; t += 2) {
            const bool last = (t == nt - 2);
            const char* a1 = cA + (size_t)(t + 1) * kstep;
            const char* a2 = last ? nA : cA + (size_t)(t + 2) * kstep; const char* b2 = last ? nB : cB + (size_t)(t + 2) * kstep;
            const char* a3 = a2 + kstep; const char* b3 = b2 + kstep;
            if (last && has_next) S.a_ready(nxt);
            PG8_LDB(B0, 0, 0); PG8_SCHED; PG8_LDA(At, 0, 0); PG8_STAGE(PG8_SA(1, 1), a1 + hstep, voffA);
            PG8_WAIT_L(8); PG8_BAR; PG8_WAIT_L(0); PG8_MMA(0, 0, At, B0); PG8_BAR; PG8_SCHED;
            PG8_LDB(B1, 0, 1); PG8_STAGE(PG8_SB(0, 0), b2, voffB);
            PG8_BAR; PG8_WAIT_L(0); PG8_MMA(0, 1, At, B1); PG8_BAR;
            PG8_LDA(At, 0, 1); PG8_STAGE(PG8_SA(0, 0), a2, voffA);
            PG8_BAR; PG8_WAIT_L(0); PG8_MMA(1, 0, At, B0); PG8_BAR; PG8_SCHED;
            PG8_STAGE(PG8_SB(0, 1), b2 + hstep, voffB);
            PG8_WAIT_V(6); PG8_BAR; PG8_MMA(1, 1, At, B1); PG8_BAR;
            PG8_LDB(B0, 1, 0); PG8_SCHED; PG8_LDA(At, 1, 0); PG8_STAGE(PG8_SA(0, 1), a2 + hstep, voffA);
            PG8_WAIT_L(8); PG8_BAR; PG8_WAIT_L(0); PG8_MMA(0, 0, At, B0); PG8_BAR; PG8_SCHED;
            PG8_LDB(B1, 1, 1); PG8_STAGE(PG8_SB(1, 0), b3, voffB);
            PG8_BAR; PG8_WAIT_L(0); PG8_MMA(0, 1, At, B1); PG8_BAR;
            PG8_LDA(At, 1, 1); PG8_STAGE(PG8_SA(1, 0), a3, voffA);
            PG8_BAR; PG8_WAIT_L(0); PG8_MMA(1, 0, At, B0); PG8_BAR; PG8_SCHED;
            PG8_STAGE(PG8_SB(1, 1), b3 + hstep, voffB);
            PG8_WAIT_V(6); PG8_BAR; PG8_MMA(1, 1, At, B1); PG8_BAR;
        }
        PG8_STAMP();
        if constexpr (!Epi::AFTER_DRAIN) { E(acc, cur, wr, wc, fr, fq); S.done(cur); }
        PG8_STAMP();
        if (!has_next) break;
#pragma unroll
        for (int a = 0; a < 2; ++a)
#pragma unroll
            for (int b = 0; b < 2; ++b)
#pragma unroll
                for (int m = 0; m < 4; ++m)
#pragma unroll
                    for (int n = 0; n < 2; ++n) acc[a][b][m][n] = (f32x4){0.f, 0.f, 0.f, 0.f};
        cur = nxt; cA = nA; cB = nB; ++ui;
    }
    PG8_WAIT_V(0);
    if (wr == 0) PG8_BAR;
    PG8_BAR;
    if constexpr (Epi::AFTER_DRAIN) { E.fused(acc, cur, wr, wc, fr, fq, lds, wid, lane); S.done(cur); }
    PG8_STAMP();
    if (STAMP && wid == 0) { stamps[lane] = lane < nts ? (((unsigned long long)(unsigned)ts_hi << 32) | (unsigned)ts_lo) : 0ull;
        if (lane == 62) stamps[62] = rt_entry; if (lane == 63) stamps[63] = (unsigned long long)wall_clock64(); }
#undef PG8_STAMP
#undef PG8_SA
#undef PG8_SB
#undef PG8_STAGE
#undef PG8_LDA
#undef PG8_LDB
#undef PG8_MMA
#undef PG8_WAIT_V
#undef PG8_WAIT_L
#undef PG8_BAR
#undef PG8_SCHED
}
}
#define LAS PG8_LAS
#define XB_TMO      128
#define XB_XCNT(j)  (256  + 64 * (j))
#define XB_XSUB(j)  (1280 + 64 * (j))
#define XB_XGEN(j)  (2304 + 64 * (j))
#define XB_TOP      3328
#define XB_TOPGEN   3392
#define XCD_BAR_WORDS 3456
#define XB_SPIN_CAP (1u << 18)

__device__ __forceinline__ unsigned xb_ld(unsigned* p)              { return __hip_atomic_load(p, __ATOMIC_RELAXED, __HIP_MEMORY_SCOPE_AGENT); }
__device__ __forceinline__ unsigned xb_add(unsigned* p, unsigned v) { return __hip_atomic_fetch_add(p, v, __ATOMIC_RELAXED, __HIP_MEMORY_SCOPE_AGENT); }
__device__ __forceinline__ unsigned xb_xcc_id() { return (unsigned)__builtin_amdgcn_s_getreg((3 << 11) | 20) & 0xFu; }
#define XB_SPIN(cond, bar) do { unsigned _sp = 0; while (cond) { __builtin_amdgcn_s_sleep(1); \
    if ((++_sp & 255u) == 0u) { if (xb_ld(&(bar)[XB_TMO])) break; if (_sp > XB_SPIN_CAP) { atomicAdd(&(bar)[XB_TMO], 1u); break; } } } } while (0)

struct XcdBarrier {
    unsigned* bar; unsigned x;
    volatile LAS unsigned* st;
};

__device__ __forceinline__ XcdBarrier xcd_barrier_post(unsigned* bar, volatile LAS unsigned* st) {
    XcdBarrier b; b.bar = bar; b.x = xb_xcc_id(); b.st = st;
    if (threadIdx.x == 0) (void)xb_add(&bar[XB_XCNT(b.x)], 1u);
    return b;
}
__device__ __forceinline__ void xcd_barrier_complete(unsigned* bar, unsigned x, unsigned& nloc, unsigned& nx) {
    const unsigned G = gridDim.x * gridDim.y * gridDim.z;
    unsigned sum, cnt, mine, sp = 0u;
    for (;;) {
        sum = 0u; cnt = 0u; mine = 0u;
#pragma unroll
        for (unsigned j = 0; j < 16; ++j) { const unsigned c = xb_ld(&bar[XB_XCNT(j)]); sum += c; cnt += (c > 0u) ? 1u : 0u; mine = (j == x) ? c : mine; }
        if (sum == G) break;
        __builtin_amdgcn_s_sleep(1);
        if ((++sp & 255u) == 0u) { if (xb_ld(&bar[XB_TMO])) break; if (sp > XB_SPIN_CAP) { atomicAdd(&bar[XB_TMO], 1u); break; } }
    }
    nloc = mine > 0u ? mine : 1u; nx = cnt > 0u ? cnt : 1u;
}

__device__ __forceinline__ void xcd_barrier(const XcdBarrier& b) {
    asm volatile("s_waitcnt vmcnt(0)" ::: "memory");
    __syncthreads();
    if (threadIdx.x == 0) {
        unsigned* bar = b.bar;
        __builtin_amdgcn_s_waitcnt(0);
        unsigned nloc = b.st[0], nx = b.st[1];
        if (nloc == 0u) { xcd_barrier_complete(bar, b.x, nloc, nx); b.st[0] = nloc; b.st[1] = nx; }
        const unsigned old = xb_add(&bar[XB_XSUB(b.x)], 1u);
        const unsigned gen = old / nloc;
        if (old + 1u == (gen + 1u) * nloc) {
            __builtin_amdgcn_fence(__ATOMIC_RELEASE, "agent");
            asm volatile("s_waitcnt vmcnt(0)" ::: "memory");
            const unsigned og = xb_add(&bar[XB_TOP], 1u);
            const unsigned tg = og / nx;
            if (og + 1u == (tg + 1u) * nx) xb_add(&bar[XB_TOPGEN], 1u);
            else XB_SPIN(xb_ld(&bar[XB_TOPGEN]) == tg, bar);
            __builtin_amdgcn_fence(__ATOMIC_ACQUIRE, "agent");
            xb_add(&bar[XB_XGEN(b.x)], 1u);
            asm volatile("s_waitcnt vmcnt(0)" ::: "memory");
        } else {
            XB_SPIN(xb_ld(&bar[XB_XGEN(b.x)]) == gen, bar);
            __builtin_amdgcn_fence(__ATOMIC_ACQUIRE, "agent");
            asm volatile("s_waitcnt vmcnt(0)" ::: "memory");
        }
    }
    __syncthreads();
}

using pg8::bf16_t; using pg8::bf16x8; using pg8::f32x4; using pg8::u32x4; using pg8::Unit; using pg8::cvt_pk_bf16;

typedef float f32x2 __attribute__((ext_vector_type(2)));
typedef unsigned u32x2 __attribute__((ext_vector_type(2)));

constexpr int MROWS = 16640, MPROMPT = 16384, DM = 1024, FF = 2816, NIN = 3216, NINP = 3328, ACOLS = 1664, BOFF = 1664;
constexpr int NSAMP = 16, SAMP_T = 16;
constexpr size_t O_Y = 0, O_SHIFT_P = 17039360, O_WKV_P = 17041024, O_GLA_P = 17073792, O_SHIFT_S = 17106560, O_WKV_S = 17133184, O_GLA_S = 17657472, O_END = 18181760;
constexpr size_t al256(size_t x) { return (x + 255) & ~(size_t)255; }
constexpr size_t WS_W1GU = 0;
constexpr size_t WS_W1D  = WS_W1GU + (size_t)5632 * 1024 * 2;
constexpr size_t WS_WIN  = WS_W1D + (size_t)1024 * 2816 * 2;
constexpr size_t WS_WOUT = WS_WIN + (size_t)NINP * 1024 * 2;
constexpr size_t WS_W2GU = WS_WOUT + (size_t)1024 * 1024 * 2;
constexpr size_t WS_W2D  = WS_W2GU + (size_t)5632 * 1024 * 2;
constexpr size_t WS_SSQ  = WS_W2D + (size_t)1024 * 2816 * 2;
constexpr size_t SSQ_BYTES = (size_t)16 * MROWS * 4;
constexpr size_t WS_HB   = WS_SSQ + 4 * SSQ_BYTES;
constexpr size_t WS_PACT = WS_HB + (size_t)MROWS * 1024 * 2;
constexpr size_t WS_G    = WS_PACT + (size_t)MROWS * NIN * 2;
constexpr size_t WS_HSR  = WS_G + (size_t)144 * 8 * 8192;
constexpr size_t WS_HSG  = WS_HSR + (size_t)144 * 8 * 16384;
constexpr size_t WS_DECG = WS_HSG + (size_t)272 * 4 * 32768;
constexpr size_t WS_BONUS= WS_DECG + (size_t)272 * 4 * 64 * 4;
constexpr size_t WS_BAR  = WS_BONUS + (size_t)MROWS * 8 * 4;
constexpr size_t WS_DUMMY= WS_BAR + 16384;
constexpr size_t WS_GBS  = WS_DUMMY + ((size_t)1 << 20);
constexpr size_t WS_END  = WS_GBS + (size_t)272 * 4 * 4 * 2 * 64 * 4;
constexpr size_t WS_Y    = WS_W1GU;
constexpr size_t WS_HB2  = WS_HSG;
static_assert((size_t)MROWS * 512 * 2 <= WS_WOUT, "Y overlay");
static_assert((size_t)MROWS * 1024 * 2 <= (size_t)272 * 4 * 32768, "HB2 overlay");
constexpr int LDS_BYTES = 131072 + 16;

struct Params { const float* in[31]; float* out; unsigned char* ws; };

__device__ __forceinline__ float rstd_of(const float* ssq, int nparts, int row) {
    float s = 0.f;
    for (int p = 0; p < nparts; ++p) s += ssq[(size_t)p * MROWS + row];
    return rsqrtf(s * (1.0f / 1024.0f) + 1e-6f);
}
__device__ __forceinline__ int tid_opaque() { int t = threadIdx.x; asm volatile("" : "+v"(t)); return t; }
__device__ __forceinline__ float sigmoidf_(float x) { return __builtin_amdgcn_rcpf(1.0f + __expf(-x)); }

struct EpiSwiglu {
    static constexpr bool PERM = true, AFTER_DRAIN = false;
    bf16_t* O; const float* ssq; int nparts;
    __device__ __forceinline__ void operator()(const f32x4 (&acc)[2][2][4][2], const Unit& u, int wr, int wc, int fr, int fq) const {
        const int row0 = u.pm * 256 + wr * 64 + fr, col0 = u.pn * 128 + wc * 32 + 8 * fq;
#pragma unroll
        for (int ai = 0; ai < 2; ++ai)
#pragma unroll
            for (int m = 0; m < 4; ++m) {
                const int row = row0 + ai * 128 + m * 16; const float rs = rstd_of(ssq, nparts, row);
                float a[8];
#pragma unroll
                for (int n = 0; n < 2; ++n)
#pragma unroll
                    for (int j = 0; j < 4; ++j) { const float g = acc[ai][0][m][n][j] * rs, up = acc[ai][1][m][n][j] * rs; a[n * 4 + j] = g * sigmoidf_(g) * up; }
                u32x4 w; w.x = cvt_pk_bf16(a[0], a[1]); w.y = cvt_pk_bf16(a[2], a[3]); w.z = cvt_pk_bf16(a[4], a[5]); w.w = cvt_pk_bf16(a[6], a[7]);
                *(u32x4*)(O + (size_t)row * FF + col0) = w;
            }
    }
};
struct EpiResid {
    static constexpr bool PERM = true, AFTER_DRAIN = false;
    const float* xoldA; float scale; const float* xoldB; int dry; float* xnew; bf16_t* xb; float* ssq; float* part;
    __device__ __forceinline__ void operator()(const f32x4 (&acc)[2][2][4][2], const Unit& u, int wr, int wc, int fr, int fq) const {
        const int row0 = u.pm * 256 + wr * 64 + fr, col0 = u.pn * 256 + wc * 32 + 8 * fq;
        float sc_ = scale; asm volatile("" : "+v"(sc_)); const f32x4 sc4 = (f32x4){sc_, sc_, sc_, sc_};
        if (u.part >= 0) {
            float* pb = part + ((size_t)(u.part * 4 + u.pn) * 256 + wr * 64 + fr) * 256 + wc * 32 + 8 * fq;
#pragma unroll
            for (int ai = 0; ai < 2; ++ai)
#pragma unroll
                for (int m = 0; m < 4; ++m)
#pragma unroll
                    for (int bj = 0; bj < 2; ++bj) { float* q = pb + (size_t)(ai * 128 + m * 16) * 256 + bj * 128; *(f32x4*)q = acc[ai][bj][m][0]; *(f32x4*)(q + 4) = acc[ai][bj][m][1]; }
        } else
#pragma unroll
        for (int ai = 0; ai < 2; ++ai)
#pragma unroll
            for (int m = 0; m < 4; ++m) {
                const int row = row0 + ai * 128 + m * 16;
                const float* xo = row < MPROMPT ? xoldA + (size_t)row * DM : xoldB + (size_t)(row - MPROMPT) * DM;
                float sq = 0.f;
#pragma unroll
                for (int bj = 0; bj < 2; ++bj) {
                    const int col = col0 + bj * 128;
                    f32x4 v0 = *(const f32x4*)(xo + col), v1 = *(const f32x4*)(xo + col + 4);
                    if (!dry) { v0 += acc[ai][bj][m][0] * sc4; v1 += acc[ai][bj][m][1] * sc4; }
                    *(f32x4*)(xnew + (size_t)row * DM + col) = v0; *(f32x4*)(xnew + (size_t)row * DM + col + 4) = v1;
                    if (xb) { u32x4 w; w.x = cvt_pk_bf16(v0[0], v0[1]); w.y = cvt_pk_bf16(v0[2], v0[3]); w.z = cvt_pk_bf16(v1[0], v1[1]); w.w = cvt_pk_bf16(v1[2], v1[3]);
                        *(u32x4*)(xb + (size_t)row * DM + col) = w; }
                    sq += (v0[0] * v0[0] + v0[1] * v0[1]) + (v0[2] * v0[2] + v0[3] * v0[3]) + (v1[0] * v1[0] + v1[1] * v1[1]) + (v1[2] * v1[2] + v1[3] * v1[3]);
                }
                sq += __shfl_xor(sq, 16); sq += __shfl_xor(sq, 32);
                if (fq == 0) ssq[(size_t)(u.pn * 4 + wc) * MROWS + row] = sq;
            }
    }
};
struct EpiP {
    static constexpr bool PERM = true, AFTER_DRAIN = false;
    bf16_t* P; const float* ssq; float* out;
    __device__ __forceinline__ void operator()(const f32x4 (&acc)[2][2][4][2], const Unit& u, int wr, int wc, int fr, int fq) const {
        const int row0 = u.pm * 256 + wr * 64 + fr, col0 = u.pn * 256 + wc * 32 + 8 * fq;
#pragma unroll
        for (int ai = 0; ai < 2; ++ai)
#pragma unroll
            for (int m = 0; m < 4; ++m) {
                const int row = row0 + ai * 128 + m * 16; const float rs = rstd_of(ssq, 16, row);
                float* dst = nullptr;
                if (row == MPROMPT - 1) dst = out + O_SHIFT_P;
                else if (row >= MPROMPT && ((row - MPROMPT) & 15) == 15) dst = out + O_SHIFT_S + (size_t)((row - MPROMPT) >> 4) * ACOLS;
#pragma unroll
                for (int bj = 0; bj < 2; ++bj) {
                    const int col = col0 + bj * 128;
                    if (col < NIN) {
                        const f32x4 v0 = acc[ai][bj][m][0] * rs, v1 = acc[ai][bj][m][1] * rs;
                        u32x4 w; w.x = cvt_pk_bf16(v0[0], v0[1]); w.y = cvt_pk_bf16(v0[2], v0[3]); w.z = cvt_pk_bf16(v1[0], v1[1]); w.w = cvt_pk_bf16(v1[2], v1[3]);
                        *(u32x4*)(P + (size_t)row * NIN + col) = w;
                        if (dst && col < ACOLS) { *(f32x4*)(dst + col) = v0; *(f32x4*)(dst + col + 4) = v1; }
                    }
                }
            }
    }
};
template <class Epi>
__device__ __forceinline__ void run_gemm(LAS unsigned char* lds, const bf16_t* A, const bf16_t* Bt, int N, int K, const Epi& E) {
    pg8::Gemm g; g.A = A; g.Bt = Bt; g.M = MROWS; g.N = N; g.K = K;
    pg8::StaticOrder S; S.init(MROWS, N, (int)gridDim.x, (int)blockIdx.x, K);
    pg8::gemm_phase<Epi, pg8::StaticOrder, false>(lds, g, S, E, nullptr);
}
struct SplitOrder {
    pg8::StaticOrder S; int nsmall, c;
    __device__ void init(int G, int c_, int K) { S.init(MPROMPT, 1024, G, c_, K); c = c_; nsmall = 4 * (K / 256); }
    __device__ bool next(int i, Unit& u) const {
        if (i == 0) return S.next(0, u);
        if (i == 1 && c < nsmall) { u.pm = MPROMPT / 256; u.pn = c & 3; u.part = c >> 2; u.k0 = u.part * 4; u.nkt = 4; return true; }
        return false;
    }
    __device__ __forceinline__ void a_ready(const Unit&) const {}
    __device__ __forceinline__ void done(const Unit&) const {}
};
template <class Epi>
__device__ __forceinline__ void run_gemm_split(LAS unsigned char* lds, const bf16_t* A, const bf16_t* Bt, int K, const Epi& E) {
    pg8::Gemm g; g.A = A; g.Bt = Bt; g.M = MROWS; g.N = 1024; g.K = K;
    SplitOrder S; S.init((int)gridDim.x, (int)blockIdx.x, K);
    pg8::gemm_phase<Epi, SplitOrder, false>(lds, g, S, E, nullptr);
}
__device__ __forceinline__ void split_fixup(const float* part, int nsplit, const float* xold, float* xnew, bf16_t* xb, float* ssq, float scale, int dry, const float* fin_g) {
    const int tid = tid_opaque(), wave = tid >> 6, lane = tid & 63;
    for (int r = blockIdx.x * 8 + wave; r < 256; r += gridDim.x * 8) {
        const int row = MPROMPT + r; float sq = 0.f; f32x4 v[4];
#pragma unroll
        for (int i = 0; i < 4; ++i) {
            const int col = i * 256 + lane * 4;
            f32x4 a = (f32x4){0.f, 0.f, 0.f, 0.f};
            for (int ks = 0; ks < nsplit; ++ks) a += *(const f32x4*)(part + ((size_t)(ks * 4 + i) * 256 + r) * 256 + lane * 4);
            v[i] = *(const f32x4*)(xold + (size_t)r * DM + col);
            if (!dry) v[i] += a * (f32x4){scale, scale, scale, scale};
            sq += (v[i][0] * v[i][0] + v[i][1] * v[i][1]) + (v[i][2] * v[i][2] + v[i][3] * v[i][3]);
        }
#pragma unroll
        for (int o = 32; o > 0; o >>= 1) sq += __shfl_xor(sq, o);
        const float rs = rsqrtf(sq * (1.0f / 1024.0f) + 1e-6f);
#pragma unroll
        for (int i = 0; i < 4; ++i) {
            const int col = i * 256 + lane * 4;
            if (fin_g) v[i] = v[i] * rs * *(const f32x4*)(fin_g + col);
            *(f32x4*)(xnew + (size_t)row * DM + col) = v[i];
            if (xb) { u32x2 w; w.x = cvt_pk_bf16(v[i][0], v[i][1]); w.y = cvt_pk_bf16(v[i][2], v[i][3]); *(u32x2*)(xb + (size_t)row * DM + col) = w; }
        }
        if (lane < 16) ssq[(size_t)lane * MROWS + row] = lane == 0 ? sq : 0.f;
    }
}
struct CvtJob { const float* src; const float* gain; bf16_t* dst; int ldsrc, nvalid, k0, ns0, K, nd0; };
__device__ __forceinline__ void cvt_decode(const Params& p, int tidx, CvtJob& J) {
    if (tidx < 2816) {
        const int f = tidx / 1408, r = tidx % 1408, nb = r / 16, kb = r % 16, pn = nb >> 2, bj = (nb >> 1) & 1, h = nb & 1;
        J.src = f == 0 ? (bj ? p.in[7] : p.in[6]) : (bj ? p.in[28] : p.in[27]); J.gain = f == 0 ? p.in[5] : p.in[26]; J.dst = (bf16_t*)(p.ws + (f == 0 ? WS_W1GU : WS_W2GU));
        J.ldsrc = FF; J.nvalid = FF; J.k0 = kb * 64; J.ns0 = pn * 128 + h * 64; J.K = 1024; J.nd0 = nb * 64;
    } else if (tidx < 4224) {
        const int f = (tidx - 2816) / 704, r = (tidx - 2816) % 704, nb = r / 44, kb = r % 44;
        J.src = f == 0 ? p.in[8] : p.in[29]; J.gain = nullptr; J.dst = (bf16_t*)(p.ws + (f == 0 ? WS_W1D : WS_W2D)); J.ldsrc = 1024; J.nvalid = 1024; J.k0 = kb * 64; J.ns0 = nb * 64; J.K = FF; J.nd0 = nb * 64;
    } else if (tidx < 5056) {
        const int r = tidx - 4224, nb = r / 16, kb = r % 16;
        J.src = p.in[10]; J.gain = p.in[9]; J.dst = (bf16_t*)(p.ws + WS_WIN); J.ldsrc = NIN; J.nvalid = NIN; J.k0 = kb * 64; J.ns0 = nb * 64; J.K = 1024; J.nd0 = nb * 64;
    } else {
        const int r = tidx - 5056, nb = r / 16, kb = r % 16;
        J.src = p.in[25]; J.gain = nullptr; J.dst = (bf16_t*)(p.ws + WS_WOUT); J.ldsrc = 1024; J.nvalid = 1024; J.k0 = kb * 64; J.ns0 = nb * 64; J.K = 1024; J.nd0 = nb * 64;
    }
}
__device__ __forceinline__ int cvt_remap(int i, int late) {
    if (late == 2) return i;
    if (!late) return i < 1408 ? i : (i < 2112 ? i + 1408 : i + 2112);
    return i < 1408 ? i + 1408 : (i < 2112 ? i + 2112 : i + 2944);
}
__device__ __forceinline__ void phase_convert(const Params& p, LAS unsigned char* lds, int late, int wb, int nb) {
    LAS float* tiles = (LAS float*)lds;
    bf16_t* ws16 = (bf16_t*)p.ws;
    const int t = tid_opaque(), ntiles = late == 2 ? 5312 : (late ? 2368 : 2944);
    for (int base = wb; base < ntiles; base += 4 * nb) {
        f32x4 v[4][2]; float gq[4][2];
#pragma unroll
        for (int u = 0; u < 4; ++u) {
            const int tidx = base + u * nb;
            if (tidx < ntiles) { CvtJob J; cvt_decode(p, cvt_remap(tidx, late), J);
#pragma unroll
                for (int h = 0; h < 2; ++h) { const int i = (t >> 4) + h * 32, j4 = (t & 15) * 4;
                    v[u][h] = (f32x4){0.f, 0.f, 0.f, 0.f};
                    if (J.ns0 + j4 < J.nvalid) v[u][h] = *(const f32x4*)(J.src + (size_t)(J.k0 + i) * J.ldsrc + J.ns0 + j4);
                    gq[u][h] = J.gain ? J.gain[J.k0 + i] : 1.0f; } }
        }
#pragma unroll
        for (int u = 0; u < 4; ++u)
            if (base + u * nb < ntiles) {
#pragma unroll
                for (int h = 0; h < 2; ++h) { const int i = (t >> 4) + h * 32, j4 = (t & 15) * 4;
#pragma unroll
                    for (int e = 0; e < 4; ++e) tiles[u * 4160 + i * 65 + j4 + e] = v[u][h][e] * gq[u][h]; } }
        __syncthreads();
#pragma unroll
        for (int u = 0; u < 4; ++u) {
            const int tidx = base + u * nb;
            if (tidx < ntiles) { CvtJob J; cvt_decode(p, cvt_remap(tidx, late), J);
                const int j = t >> 3, ks = (t & 7) * 8; float a[8];
#pragma unroll
                for (int e = 0; e < 8; ++e) a[e] = tiles[u * 4160 + (ks + e) * 65 + j];
                u32x4 w; w.x = cvt_pk_bf16(a[0], a[1]); w.y = cvt_pk_bf16(a[2], a[3]); w.z = cvt_pk_bf16(a[4], a[5]); w.w = cvt_pk_bf16(a[6], a[7]);
                *(u32x4*)(J.dst + (size_t)(J.nd0 + j) * J.K + J.k0 + ks) = w; }
        }
        __syncthreads();
    }
    (void)ws16;
    if (late == 1) return;
    const int tid = tid_opaque(), wave = tid >> 6, lane = tid & 63;
    float* ssq0 = (float*)(p.ws + WS_SSQ);
    bf16_t* hb = (bf16_t*)(p.ws + WS_HB);
    for (int row = blockIdx.x * 8 + wave; row < MROWS; row += gridDim.x * 8) {
        const float* x = row < MPROMPT ? p.in[0] + (size_t)row * DM : p.in[1] + (size_t)(row - MPROMPT) * DM;
        float sq = 0.f;
#pragma unroll
        for (int i = 0; i < 4; ++i) {
            const f32x4 v = *(const f32x4*)(x + i * 256 + lane * 4);
            sq += (v[0] * v[0] + v[1] * v[1]) + (v[2] * v[2] + v[3] * v[3]);
            u32x2 w; w.x = cvt_pk_bf16(v[0], v[1]); w.y = cvt_pk_bf16(v[2], v[3]);
            *(u32x2*)(hb + (size_t)row * DM + i * 256 + lane * 4) = w;
        }
#pragma unroll
        for (int o = 32; o > 0; o >>= 1) sq += __shfl_xor(sq, o);
        if (lane == 0) ssq0[row] = sq;
    }
}
__device__ __forceinline__ void phase_final_norm(const Params& p, int dry) {
    const int tid = tid_opaque(), wave = tid >> 6, lane = tid & 63;
    const float* ssq3 = (const float*)(p.ws + WS_SSQ + 3 * SSQ_BYTES);
    const float* g = p.in[30];
    for (int row = blockIdx.x * 8 + wave; row < MPROMPT; row += gridDim.x * 8) {
        const float rs = rstd_of(ssq3, 16, row);
        float* x = p.out + (size_t)row * DM;
#pragma unroll
        for (int i = 0; i < 4; ++i) {
            const f32x4 v = *(const f32x4*)(x + i * 256 + lane * 4), gg = *(const f32x4*)(g + i * 256 + lane * 4);
            *(f32x4*)(x + i * 256 + lane * 4) = dry ? v : v * rs * gg;
        }
    }
}
__device__ __forceinline__ float bf2f(bf16_t b) { return __uint_as_float(((unsigned)b) << 16); }
__device__ __forceinline__ float quad_sum(float x) {
    x += __int_as_float(__builtin_amdgcn_update_dpp(0, __float_as_int(x), 0xB1, 0xF, 0xF, true));
    x += __int_as_float(__builtin_amdgcn_update_dpp(0, __float_as_int(x), 0x4E, 0xF, 0xF, true));
    return x;
}
__device__ __forceinline__ float wave_sum(float x) {
    x += __int_as_float(__builtin_amdgcn_update_dpp(0, __float_as_int(x), 0xB1, 0xF, 0xF, true));
    x += __int_as_float(__builtin_amdgcn_update_dpp(0, __float_as_int(x), 0x4E, 0xF, 0xF, true));
    x += __int_as_float(__builtin_amdgcn_update_dpp(0, __float_as_int(x), 0x124, 0xF, 0xF, true));
    x += __int_as_float(__builtin_amdgcn_update_dpp(0, __float_as_int(x), 0x128, 0xF, 0xF, true));
    const int xi = __float_as_int(x);
    return (__int_as_float(__builtin_amdgcn_readlane(xi, 0)) + __int_as_float(__builtin_amdgcn_readlane(xi, 16))) + (__int_as_float(__builtin_amdgcn_readlane(xi, 32)) + __int_as_float(__builtin_amdgcn_readlane(xi, 48)));
}
__device__ __forceinline__ float softplusf_(float x) { return fmaxf(x, 0.f) + __logf(1.0f + __expf(-fabsf(x))); }
__device__ __forceinline__ float tanhf_(float x) { return 1.0f - 2.0f * __builtin_amdgcn_rcpf(1.0f + __expf(2.0f * x)); }
__device__ __forceinline__ f32x2 lo2(f32x4 v) { return __builtin_shufflevector(v, v, 0, 1); }
__device__ __forceinline__ f32x2 hi2(f32x4 v) { return __builtin_shufflevector(v, v, 2, 3); }
__device__ __forceinline__ f32x2 bc2(float x) { return (f32x2){x, x}; }

struct Seg { int row0, nsteps, prevkind; const float* prevptr; };
__device__ __forceinline__ float seg_prev0(const bf16_t* P, const Seg& sg, int col) {
    float prev = 0.f;
    if (sg.prevkind == 1) prev = bf2f(P[(size_t)(sg.row0 - 1) * NIN + col]);
    else if (sg.prevkind == 2) prev = sg.prevptr[col];
    return prev;
}
__device__ __forceinline__ float xs_lerp(const bf16_t* P, const Seg& sg, int i, int col, float mu, float prev0) {
    const float cur = bf2f(P[(size_t)(sg.row0 + i) * NIN + col]);
    const float pr = bf2f(P[(size_t)(sg.row0 + (i > 0 ? i - 1 : 0)) * NIN + col]);
    const float prev = i == 0 ? prev0 : pr;
    return cur + (prev - cur) * mu;
}
__device__ __forceinline__ void load16(const LAS float* src, f32x2 (&d)[8]) {
    const LAS f32x4* s4 = (const LAS f32x4*)src;
#pragma unroll
    for (int i = 0; i < 4; ++i) { const f32x4 v = s4[i]; d[2 * i] = lo2(v); d[2 * i + 1] = hi2(v); }
}

constexpr int RST = 384;
__device__ __forceinline__ void rwkv_a_task(const Params& p, LAS unsigned char* lds, int tk, int mode) {
    const int tid = tid_opaque(), wave = tid >> 6, lane = tid & 63;
    const bf16_t* P = (const bf16_t*)(p.ws + WS_PACT);
    Seg sg; int ci, g;
    if (tk < 256) { const int c = tk >> 1; g = tk & 1; sg.row0 = c * 128; sg.nsteps = 128; sg.prevkind = c == 0 ? 0 : 1; sg.prevptr = nullptr; ci = c; }
    else { const int b = (tk - 256) >> 1; g = (tk - 256) & 1; sg.row0 = MPROMPT + b * 16; sg.nsteps = 16; sg.prevkind = 2; sg.prevptr = p.in[2] + (size_t)b * ACOLS; ci = 128 + b; }
    LAS float* stage = (LAS float*)lds;
    LAS float* bcs = (LAS float*)(lds + 98304) + wave * 512;
    const float* mu = p.in[11];
    const int phl = wave & 3, ptb = (wave >> 2) * 8, hd = g * 4 + phl, C = hd * 64 + lane;
    const float mu_r = mu[C], mu_k = mu[512 + C], mu_v = mu[1024 + C], mu_x = mu[1536 + lane];
    const float w0c = p.in[12][C], a0c = p.in[14][C], kkc = p.in[17][C], kac = p.in[18][C], rkc = p.in[19][C];
    const float pv_r = seg_prev0(P, sg, C), pv_k = seg_prev0(P, sg, 512 + C), pv_v = seg_prev0(P, sg, 1024 + C), pv_x = seg_prev0(P, sg, 1536 + lane);
    const float* wup = p.in[13] + C; const float* aup = p.in[15] + C;
    float* bonus = (float*)(p.ws + WS_BONUS);
    const bool isH = wave >= 4; const int rhd = g * 4 + (wave & 3), rg = lane >> 2, ks = lane & 3;
    f32x2 s[4][8];
#pragma unroll
    for (int r = 0; r < 4; ++r)
#pragma unroll
        for (int j = 0; j < 8; ++j) { s[r][j].x = (!isH && (rg * 4 + r == ks * 16 + 2 * j)) ? 1.f : 0.f; s[r][j].y = (!isH && (rg * 4 + r == ks * 16 + 2 * j + 1)) ? 1.f : 0.f; }
    bf16_t* Yb = (bf16_t*)(p.ws + WS_Y); bf16_t* HB = (bf16_t*)(p.ws + WS_HB);
    bf16_t raw[9][4];
#define RW_LOAD(sbn) do { _Pragma("unroll") for (int i = 0; i < 9; ++i) { const int ti_ = (sbn) * 16 + ptb + i - 1; const bf16_t* rp_ = P + (size_t)(sg.row0 + (ti_ < 0 ? 0 : ti_)) * NIN; \
        raw[i][0] = rp_[C]; raw[i][1] = rp_[512 + C]; raw[i][2] = rp_[1024 + C]; raw[i][3] = rp_[1536 + lane]; } } while (0)
    RW_LOAD(0);
    for (int sb = 0; sb < sg.nsteps / 16; ++sb) {
        if (!(mode & 4)) {
#pragma unroll
            for (int i = 0; i < 8; ++i) { const float cur = bf2f(raw[i + 1][3]), prev = (sb * 16 + ptb + i == 0) ? pv_x : bf2f(raw[i][3]); float xv = cur + (prev - cur) * mu_x; if (lane < 32) xv = tanhf_(xv); bcs[i * 64 + lane] = xv; }
            float wl[8], al[8];
#pragma unroll
            for (int i = 0; i < 8; ++i) { wl[i] = w0c; al[i] = a0c; }
#pragma unroll 2
            for (int j4 = 0; j4 < 8; ++j4) {
                float wu[4], au[4];
#pragma unroll
                for (int e = 0; e < 4; ++e) { wu[e] = wup[(size_t)(j4 * 4 + e) * 512]; au[e] = aup[(size_t)(j4 * 4 + e) * 512]; }
#pragma unroll
                for (int i = 0; i < 8; ++i) {
                    const f32x4 t4 = *(const LAS f32x4*)(bcs + i * 64 + j4 * 4), x4 = *(const LAS f32x4*)(bcs + i * 64 + 32 + j4 * 4);
#pragma unroll
                    for (int e = 0; e < 4; ++e) { wl[i] += t4[e] * wu[e]; al[i] += x4[e] * au[e]; }
                }
            }
            float rr[8], kr[8], vr[8];
#pragma unroll
            for (int i = 0; i < 8; ++i) { const bool f0 = (sb * 16 + ptb + i == 0);
                const float cr = bf2f(raw[i + 1][0]), ck = bf2f(raw[i + 1][1]), cv = bf2f(raw[i + 1][2]);
                const float qr = f0 ? pv_r : bf2f(raw[i][0]), qk = f0 ? pv_k : bf2f(raw[i][1]), qv = f0 ? pv_v : bf2f(raw[i][2]);
                rr[i] = cr + (qr - cr) * mu_r; kr[i] = ck + (qk - ck) * mu_k; vr[i] = cv + (qv - cv) * mu_v; }
#pragma unroll
            for (int i = 0; i < 8; ++i) {
                const int ti = sb * 16 + ptb + i, row = sg.row0 + ti;
                const float r = rr[i], k = kr[i], v = vr[i];
                const float wlog = -softplusf_(-wl[i]) - 0.5f, dec = __expf(-__expf(wlog));
                const float a = sigmoidf_(al[i]);
                float kk = k * kkc; const float n2 = wave_sum(kk * kk); kk = kk / fmaxf(sqrtf(n2), 1e-12f);
                const float kmod = k * (1.0f + (a - 1.0f) * kac), kka = kk * a;
                const float bs = wave_sum(r * kmod * rkc);
                if (lane == 0) bonus[(size_t)row * 8 + hd] = bs;
                LAS float* st = stage + ((ptb + i) * 4 + phl) * RST;
                st[lane] = dec; st[64 + lane] = kk; st[128 + lane] = kka; st[192 + lane] = kmod; st[256 + lane] = r; st[320 + lane] = v;
            }
        }
        __syncthreads();
        if (sb + 1 < sg.nsteps / 16) RW_LOAD(sb + 1);
        if (!(mode & 8)) for (int tl = 0; tl < 16; ++tl) {
            const LAS float* st = stage + (tl * 4 + (wave & 3)) * RST;
            const int row = sg.row0 + sb * 16 + tl;
            f32x2 w2[8], kk2[8], ka2[8], r2[8];
            load16(st + ks * 16, w2); load16(st + 64 + ks * 16, kk2); load16(st + 128 + ks * 16, ka2); load16(st + 256 + ks * 16, r2);
            float sa[4];
#pragma unroll
            for (int r = 0; r < 4; ++r) { f32x2 acc = s[r][0] * kk2[0];
#pragma unroll
                for (int j = 1; j < 8; ++j) acc = s[r][j] * kk2[j] + acc;
                sa[r] = quad_sum(acc.x + acc.y); }
            float yo[4];
            if (!isH) {
#pragma unroll
                for (int r = 0; r < 4; ++r) { const f32x2 nsa = bc2(-sa[r]);
#pragma unroll
                    for (int j = 0; j < 8; ++j) s[r][j] = s[r][j] * w2[j] + nsa * ka2[j]; }
            } else {
                f32x2 km2[8]; load16(st + 192 + ks * 16, km2);
                const f32x4 v4 = *(const LAS f32x4*)(st + 320 + rg * 4);
#pragma unroll
                for (int r = 0; r < 4; ++r) { const f32x2 nsa = bc2(-sa[r]), vv = bc2(v4[r]);
#pragma unroll
                    for (int j = 0; j < 8; ++j) s[r][j] = (s[r][j] * w2[j] + nsa * ka2[j]) + vv * km2[j]; }
            }
#pragma unroll
            for (int r = 0; r < 4; ++r) { f32x2 acc = s[r][0] * r2[0];
#pragma unroll
                for (int j = 1; j < 8; ++j) acc = s[r][j] * r2[j] + acc;
                yo[r] = quad_sum(acc.x + acc.y); }
            if (ks == 0) {
                u32x2 w; w.x = cvt_pk_bf16(yo[0], yo[1]); w.y = cvt_pk_bf16(yo[2], yo[3]);
                if (!isH) *(u32x2*)(Yb + (size_t)row * 512 + rhd * 64 + rg * 4) = w;
                else *(u32x2*)(HB + (size_t)row * 1024 + rhd * 64 + rg * 4) = w;
            }
        }
        __syncthreads();
    }
    if (!isH) {
        bf16_t* Gf = (bf16_t*)(p.ws + WS_G) + (size_t)(ci * 8 + rhd) * 4096;
#pragma unroll
        for (int j = 0; j < 8; ++j)
#pragma unroll
            for (int h = 0; h < 2; ++h) {
                const int jj = 2 * j + h;
                u32x2 w; w.x = cvt_pk_bf16(h ? s[0][j].y : s[0][j].x, h ? s[1][j].y : s[1][j].x); w.y = cvt_pk_bf16(h ? s[2][j].y : s[2][j].x, h ? s[3][j].y : s[3][j].x);
                *(u32x2*)(Gf + (size_t)((ks * 2 + (rg >> 3)) * 64 + (rg & 3) * 16 + jj) * 8 + ((rg >> 2) & 1) * 4) = w;
            }
    } else {
        float* Hs = (float*)(p.ws + WS_HSR) + (size_t)(ci * 8 + rhd) * 4096;
#pragma unroll
        for (int r = 0; r < 4; ++r)
#pragma unroll
            for (int q = 0; q < 4; ++q) *(f32x4*)(Hs + (rg * 4 + r) * 64 + ks * 16 + q * 4) = (f32x4){s[r][2 * q].x, s[r][2 * q].y, s[r][2 * q + 1].x, s[r][2 * q + 1].y};
    }
}

constexpr int GST = 320;
__device__ __forceinline__ void gla_a_task(const Params& p, LAS unsigned char* lds, int tk) {
    const int tid = tid_opaque(), wave = tid >> 6, lane = tid & 63;
    const bf16_t* P = (const bf16_t*)(p.ws + WS_PACT) + BOFF;
    int row0, nsteps, ci;
    if (tk < 256) { row0 = tk * 64; nsteps = 64; ci = tk; } else { row0 = MPROMPT + (tk - 256) * 16; nsteps = 16; ci = tk; }
    LAS float* stage = (LAS float*)lds;
    LAS float* red = (LAS float*)(lds + 98304);
    const int hd = wave >> 1, half = wave & 1, rg = lane >> 2, ks = lane & 3;
    const int kc = hd * 64 + lane;
    float gku[16];
#pragma unroll
    for (int j = 0; j < 16; ++j) gku[j] = p.in[22][j * 256 + kc];
    const float gkb = p.in[23][kc];
    float lsum = 0.f;
    f32x2 s[4][8];
#pragma unroll
    for (int r = 0; r < 4; ++r)
#pragma unroll
        for (int j = 0; j < 8; ++j) s[r][j] = (f32x2){0.f, 0.f};
    bf16_t* HB = (bf16_t*)(p.ws + WS_HB);
    unsigned gxw; bf16_t graw[8][4];
#define GL_LOAD(sbn) do { gxw = *(const unsigned*)(P + (size_t)(row0 + (sbn) * 16 + half * 8 + (lane >> 3)) * NIN + 1024 + (lane & 7) * 2); \
        _Pragma("unroll") for (int i = 0; i < 8; ++i) { const bf16_t* pr_ = P + (size_t)(row0 + (sbn) * 16 + half * 8 + i) * NIN; graw[i][0] = pr_[256 + kc]; graw[i][1] = pr_[kc]; graw[i][2] = pr_[512 + hd * 128 + lane]; graw[i][3] = pr_[512 + hd * 128 + 64 + lane]; } } while (0)
    GL_LOAD(0);
    for (int sb = 0; sb < nsteps / 16; ++sb) {
        {
            LAS float* xg = (LAS float*)(lds + 81920) + wave * 128;
            { const int j2 = (lane & 7) * 2; xg[(lane >> 3) * 16 + j2] = __uint_as_float(gxw << 16); xg[(lane >> 3) * 16 + j2 + 1] = __uint_as_float(gxw & 0xffff0000u); }
            float kv[8], qv[8], v0[8], v1[8]; float bsub = 0.f;
#pragma unroll
            for (int i = 0; i < 8; ++i) { kv[i] = bf2f(graw[i][0]); qv[i] = bf2f(graw[i][1]) * 0.125f; v0[i] = bf2f(graw[i][2]); v1[i] = bf2f(graw[i][3]); }
#pragma unroll
            for (int i = 0; i < 8; ++i) {
                const int tl = half * 8 + i;
                float gl = gkb;
#pragma unroll
                for (int j4 = 0; j4 < 4; ++j4) { const f32x4 x4 = *(const LAS f32x4*)(xg + i * 16 + j4 * 4); gl += x4[0] * gku[j4 * 4] + x4[1] * gku[j4 * 4 + 1] + x4[2] * gku[j4 * 4 + 2] + x4[3] * gku[j4 * 4 + 3]; }
                const float la = -softplusf_(-gl) * (1.0f / 16.0f);
                lsum += la; bsub += la;
                LAS float* st = stage + (tl * 4 + hd) * GST;
                st[lane] = __expf(la); st[64 + lane] = kv[i]; st[128 + lane] = qv[i]; st[192 + lane] = v0[i]; st[256 + lane] = v1[i];
            }
            ((float*)(p.ws + WS_GBS))[(size_t)((((ci * 4 + sb) * 4 + hd) * 2 + half)) * 64 + lane] = bsub;
        }
        __syncthreads();
        if (sb + 1 < nsteps / 16) GL_LOAD(sb + 1);
        for (int tl = 0; tl < 16; ++tl) {
            const LAS float* st = stage + (tl * 4 + hd) * GST;
            const int row = row0 + sb * 16 + tl;
            f32x2 a2[8], k2[8], q2[8];
            load16(st + ks * 16, a2); load16(st + 64 + ks * 16, k2); load16(st + 128 + ks * 16, q2);
            const f32x4 v4 = *(const LAS f32x4*)(st + 192 + half * 64 + rg * 4);
            float zo[4];
#pragma unroll
            for (int r = 0; r < 4; ++r) { const f32x2 vv = bc2(v4[r]); f32x2 acc = (f32x2){0.f, 0.f};
#pragma unroll
                for (int j = 0; j < 8; ++j) { s[r][j] = s[r][j] * a2[j] + vv * k2[j]; acc = s[r][j] * q2[j] + acc; }
                zo[r] = quad_sum(acc.x + acc.y); }
            if (ks == 0) { u32x2 w; w.x = cvt_pk_bf16(zo[0], zo[1]); w.y = cvt_pk_bf16(zo[2], zo[3]);
                *(u32x2*)(HB + (size_t)row * 1024 + 512 + hd * 128 + half * 64 + rg * 4) = w; }
        }
        __syncthreads();
    }
    float* Hs = (float*)(p.ws + WS_HSG) + (size_t)(ci * 4 + hd) * 8192;
#pragma unroll
    for (int j = 0; j < 8; ++j) {
        *(f32x4*)(Hs + (ks * 16 + 2 * j) * 128 + half * 64 + rg * 4) = (f32x4){s[0][j].x, s[1][j].x, s[2][j].x, s[3][j].x};
        *(f32x4*)(Hs + (ks * 16 + 2 * j + 1) * 128 + half * 64 + rg * 4) = (f32x4){s[0][j].y, s[1][j].y, s[2][j].y, s[3][j].y};
    }
    red[wave * 64 + lane] = lsum;
    __syncthreads();
    if (half == 0) ((float*)(p.ws + WS_DECG))[(size_t)(ci * 4 + hd) * 64 + lane] = __expf(red[wave * 64 + lane] + red[(wave + 1) * 64 + lane]);
    __syncthreads();
}
__device__ __forceinline__ bf16x8 pack8(const float (&v)[8]);
typedef short bf16x4 __attribute__((ext_vector_type(4)));
typedef __bf16 bf16v2 __attribute__((ext_vector_type(2)));
__device__ __forceinline__ unsigned cvt_pk_native(float a, float b) { const f32x2 v = (f32x2){a, b}; const bf16v2 r = __builtin_convertvector(v, bf16v2); return __builtin_bit_cast(unsigned, r); }
__device__ __forceinline__ bf16x8 pack4z(float a, float b, float c, float d) { u32x4 w; w.x = cvt_pk_bf16(a, b); w.y = cvt_pk_bf16(c, d); w.z = 0u; w.w = 0u; return __builtin_bit_cast(bf16x8, w); }
__device__ __forceinline__ void gla_a_wave_task(const Params& p, LAS unsigned char* wl8, int ci, int row0, int nblk, int hd, int sel) {
    const int lane = tid_opaque() & 63, n = lane & 15, q = lane >> 4, kc = hd * 64 + lane;
    const bf16_t* P = (const bf16_t*)(p.ws + WS_PACT) + BOFF; bf16_t* HB = (bf16_t*)(p.ws + WS_HB);
    LAS float* XG = (LAS float*)wl8; LAS bf16_t* QT = (LAS bf16_t*)(wl8 + 1024); LAS bf16_t* KT = (LAS bf16_t*)(wl8 + 3328); LAS bf16_t* KTt = (LAS bf16_t*)(wl8 + 5632); LAS float* BETA = (LAS float*)(wl8 + 8704);
    float gku[16];
#pragma unroll
    for (int j = 0; j < 16; ++j) gku[j] = p.in[22][j * 256 + kc];
    const float gkb = p.in[23][kc];
    f32x4 H[4][8];
#pragma unroll
    for (int kt = 0; kt < 4; ++kt)
#pragma unroll
        for (int vt = 0; vt < 8; ++vt) H[kt][vt] = (f32x4){0.f, 0.f, 0.f, 0.f};
    float lsum = 0.f;
    for (int blk = 0; blk < nblk; ++blk) {
        const int rowb = row0 + blk * 16;
        { const int idx = lane * 4, tk = idx >> 4, j = idx & 15;
          const u32x2 xw = *(const u32x2*)(P + (size_t)(rowb + tk) * NIN + 1024 + j);
          *(LAS f32x4*)(XG + idx) = (f32x4){__uint_as_float(xw.x << 16), __uint_as_float(xw.x & 0xffff0000u), __uint_as_float(xw.y << 16), __uint_as_float(xw.y & 0xffff0000u)}; }
        unsigned qkr[16];
#pragma unroll
        for (int i = 0; i < 16; ++i) { const bf16_t* pr = P + (size_t)(rowb + i) * NIN; qkr[i] = (unsigned)pr[kc] | ((unsigned)pr[256 + kc] << 16); }
        float bsub = 0.f;
#pragma unroll
        for (int i = 0; i < 16; ++i) {
            float gl = gkb;
#pragma unroll
            for (int j4 = 0; j4 < 4; ++j4) { const f32x4 x4 = *(const LAS f32x4*)(XG + i * 16 + j4 * 4); gl += x4[0] * gku[j4 * 4] + x4[1] * gku[j4 * 4 + 1] + x4[2] * gku[j4 * 4 + 2] + x4[3] * gku[j4 * 4 + 3]; }
            bsub += -softplusf_(-gl) * (1.0f / 16.0f);
            const unsigned qk = cvt_pk_bf16(__uint_as_float(qkr[i] << 16) * 0.125f * __expf(bsub), __uint_as_float(qkr[i] & 0xffff0000u) * __expf(-bsub));
            QT[i * 72 + lane] = (bf16_t)(qk & 0xffffu); KT[i * 72 + lane] = (bf16_t)(qk >> 16); KTt[lane * 24 + i] = (bf16_t)(qk >> 16);
        }
        BETA[lane] = __expf(bsub); lsum += bsub;
        asm volatile("" ::: "memory");
        if (sel & 4) { float* gb = (float*)(p.ws + WS_GBS) + (size_t)(((ci * 4 + blk) * 4 + hd) * 2) * 64 + lane; gb[0] = bsub; gb[64] = 0.f; }
        u32x2 VP[8];
#pragma unroll
        for (int vt = 0; vt < 8; ++vt) { const bf16_t* vp = P + (size_t)(rowb + 4 * q) * NIN + 512 + hd * 128 + vt * 16 + n;
            VP[vt].x = (unsigned)vp[0] | ((unsigned)vp[NIN] << 16); VP[vt].y = (unsigned)vp[2 * NIN] | ((unsigned)vp[3 * NIN] << 16); }
#define VF(vt) __builtin_bit_cast(bf16x8, (u32x4){VP[vt].x, VP[vt].y, 0u, 0u})
        f32x4 sc = (f32x4){0.f, 0.f, 0.f, 0.f};
#pragma unroll
        for (int kh = 0; kh < 2; ++kh) sc = __builtin_amdgcn_mfma_f32_16x16x32_bf16(*(const LAS bf16x8*)(KT + n * 72 + kh * 32 + q * 8), *(const LAS bf16x8*)(QT + n * 72 + kh * 32 + q * 8), sc, 0, 0, 0);
        const bf16x8 SCB = pack4z(4 * q + 0 <= n ? sc[0] : 0.f, 4 * q + 1 <= n ? sc[1] : 0.f, 4 * q + 2 <= n ? sc[2] : 0.f, 4 * q + 3 <= n ? sc[3] : 0.f);
        bf16x8 QB[2];
#pragma unroll
        for (int kh = 0; kh < 2; ++kh) { const u32x2 a = __builtin_bit_cast(u32x2, *(const LAS bf16x4*)(QT + n * 72 + kh * 32 + 4 * q)), b = __builtin_bit_cast(u32x2, *(const LAS bf16x4*)(QT + n * 72 + kh * 32 + 16 + 4 * q));
            u32x4 w; w.x = a.x; w.y = a.y; w.z = b.x; w.w = b.y; QB[kh] = __builtin_bit_cast(bf16x8, w); }
#pragma unroll
        for (int vt = 0; vt < 8; ++vt) {
            f32x4 z = (f32x4){0.f, 0.f, 0.f, 0.f};
#pragma unroll
            for (int kh = 0; kh < 2; ++kh) { const float hv[8] = {H[2 * kh][vt][0], H[2 * kh][vt][1], H[2 * kh][vt][2], H[2 * kh][vt][3], H[2 * kh + 1][vt][0], H[2 * kh + 1][vt][1], H[2 * kh + 1][vt][2], H[2 * kh + 1][vt][3]};
                z = __builtin_amdgcn_mfma_f32_16x16x32_bf16(pack8(hv), QB[kh], z, 0, 0, 0); }
            z = __builtin_amdgcn_mfma_f32_16x16x32_bf16(VF(vt), SCB, z, 0, 0, 0);
            u32x2 w; w.x = cvt_pk_native(z[0], z[1]); w.y = cvt_pk_native(z[2], z[3]);
            if (sel & 1) *(u32x2*)(HB + (size_t)(rowb + n) * 1024 + 512 + hd * 128 + vt * 16 + 4 * q) = w;
        }
#pragma unroll
        for (int kt = 0; kt < 4; ++kt) {
            const u32x2 ka = __builtin_bit_cast(u32x2, *(const LAS bf16x4*)(KTt + (kt * 16 + n) * 24 + 4 * q));
            u32x4 kw; kw.x = ka.x; kw.y = ka.y; kw.z = 0u; kw.w = 0u; const bf16x8 KA = __builtin_bit_cast(bf16x8, kw);
            const f32x4 b4 = *(const LAS f32x4*)(BETA + kt * 16 + 4 * q);
#pragma unroll
            for (int vt = 0; vt < 8; ++vt) H[kt][vt] = __builtin_amdgcn_mfma_f32_16x16x32_bf16(KA, VF(vt), H[kt][vt], 0, 0, 0) * b4;
        }
    }
#undef VF
    float* Hs = (float*)(p.ws + WS_HSG) + (size_t)(ci * 4 + hd) * 8192;
#pragma unroll
    for (int kt = 0; kt < 4; ++kt)
#pragma unroll
        for (int vt = 0; vt < 8; ++vt)
#pragma unroll
            for (int i = 0; i < 4; ++i) if (sel & 2) Hs[(kt * 16 + 4 * q + i) * 128 + vt * 16 + n] = H[kt][vt][i];
    if (sel & 4) ((float*)(p.ws + WS_DECG))[(size_t)(ci * 4 + hd) * 64 + lane] = __expf(lsum);
}
__device__ __forceinline__ void phase_mix_a2(const Params& p, LAS unsigned char* lds, int sel) {
    const int wave = tid_opaque() >> 6, skip = gridDim.x >= 64 ? 32 : 0, ng = (int)gridDim.x - skip, nw = ng * 8;
    if ((int)blockIdx.x >= skip) for (int j = wave * ng + ((int)blockIdx.x - skip); j < 1088; j += nw) {
        int ci, row0, nblk, hd;
        if (j < 1024) { ci = j >> 2; row0 = ci * 64; nblk = 4; hd = j & 3; }
        else { const int r = j - 1024, sb = r >> 2; ci = 256 + sb; row0 = MPROMPT + sb * 16; nblk = 1; hd = r & 3; }
        gla_a_wave_task(p, lds + wave * 16384, ci, row0, nblk, hd, sel);
    }
}
__device__ __forceinline__ void phase_mix_a(const Params& p, LAS unsigned char* lds, int mask) {
    if (mask & 1) for (int t = blockIdx.x; t < 288; t += gridDim.x) rwkv_a_task(p, lds, t, mask);
    if (mask & 2) phase_mix_a2(p, lds, 7);
}

__device__ __forceinline__ void rwkv_scan_job(const Params& p, int head, int vt, int ci0, int nchunks, const float* S0, float* Sout, int dry) {
    const int lane = tid_opaque() & 63, n = lane & 15, q = lane >> 4, v = vt * 16 + n;
    f32x4 D[4];
#pragma unroll
    for (int jt = 0; jt < 4; ++jt) D[jt] = S0 ? *(const f32x4*)(S0 + v * 64 + jt * 16 + q * 4) : (f32x4){0.f, 0.f, 0.f, 0.f};
    for (int c = 0; c < nchunks; ++c) {
        const int ci = ci0 + c;
        float* HS = (float*)(p.ws + WS_HSR) + (size_t)(ci * 8 + head) * 4096;
        const bf16x8* Gf = (const bf16x8*)(p.ws + WS_G + (size_t)(ci * 8 + head) * 8192);
        f32x4 Hc[4]; bf16x8 A[4][2];
#pragma unroll
        for (int jt = 0; jt < 4; ++jt) { Hc[jt] = *(const f32x4*)(HS + v * 64 + jt * 16 + q * 4); A[jt][0] = Gf[(jt * 2 + 0) * 64 + lane]; A[jt][1] = Gf[(jt * 2 + 1) * 64 + lane]; }
#pragma unroll
        for (int jt = 0; jt < 4; ++jt) *(f32x4*)(HS + v * 64 + jt * 16 + q * 4) = dry ? Hc[jt] : D[jt];
        bf16x8 B[2];
#pragma unroll
        for (int kh = 0; kh < 2; ++kh) { u32x4 w; w.x = cvt_pk_native(D[2 * kh][0], D[2 * kh][1]); w.y = cvt_pk_native(D[2 * kh][2], D[2 * kh][3]);
            w.z = cvt_pk_native(D[2 * kh + 1][0], D[2 * kh + 1][1]); w.w = cvt_pk_native(D[2 * kh + 1][2], D[2 * kh + 1][3]); B[kh] = __builtin_bit_cast(bf16x8, w); }
#pragma unroll
        for (int jt = 0; jt < 4; ++jt) { f32x4 d = __builtin_amdgcn_mfma_f32_16x16x32_bf16(A[jt][0], B[0], Hc[jt], 0, 0, 0); D[jt] = __builtin_amdgcn_mfma_f32_16x16x32_bf16(A[jt][1], B[1], d, 0, 0, 0); }
    }
#pragma unroll
    for (int jt = 0; jt < 4; ++jt) *(f32x4*)(Sout + v * 64 + jt * 16 + q * 4) = D[jt];
}
constexpr int SC_SLOT = 12544, SC_NB = 8;
__device__ __forceinline__ void rwkv_scan_prompt(const Params& p, LAS unsigned char* lds, int head, int vt, int dry) {
    const int tid = tid_opaque(), wave = tid >> 6, lane = tid & 63, n = lane & 15, q = lane >> 4, v = vt * 16 + n;
    const unsigned char* Gb = p.ws + WS_G; unsigned char* Hb = p.ws + WS_HSR;
    u32x4 pfA[12], pfB[12];
    unsigned off0[12], hmask = 0u;
#pragma unroll
    for (int i = 0; i < 12; ++i) { const int qd = tid + 512 * i, cl = qd / 768, wi = qd % 768;
        off0[i] = wi < 512 ? (unsigned)(WS_G + (size_t)(cl * 8 + head) * 8192 + wi * 16) : (unsigned)(WS_HSR + ((size_t)(cl * 8 + head) * 4096 + vt * 1024) * 4 + (wi - 512) * 16);
        hmask |= (wi < 512 ? 0u : 1u) << i; }
#define SC_ISSUE(pf, batch) do { _Pragma("unroll") for (int i = 0; i < 12; ++i) { \
        const unsigned o_ = off0[i] + (unsigned)(batch) * ((unsigned)(SC_NB * 8 * 8192) << ((hmask >> i) & 1u)); pf[i] = *(const u32x4*)(p.ws + o_); } } while (0)
#define SC_COMMIT(pf) do { _Pragma("unroll") for (int i = 0; i < 12; ++i) { const int qd = tid + 512 * i, cl = qd / 768, wi = qd % 768; \
        const int dst = cl * SC_SLOT + (wi < 512 ? wi * 16 : 8192 + ((wi - 512) >> 4) * 272 + ((wi - 512) & 15) * 16); *(LAS u32x4*)(lds + dst) = pf[i]; } } while (0)
#define SC_COMPUTE(bb) do { if (wave == 0) { for (int cl = 0; cl < SC_NB; ++cl) { \
                const int ci = (bb) * SC_NB + cl; const LAS unsigned char* sl = lds + cl * SC_SLOT; \
                float* HS = (float*)Hb + (size_t)(ci * 8 + head) * 4096; \
                f32x4 Hc[4]; bf16x8 A[4][2]; \
                _Pragma("unroll") for (int jt = 0; jt < 4; ++jt) { Hc[jt] = *(const LAS f32x4*)(sl + 8192 + n * 272 + (jt * 4 + q) * 16); \
                    A[jt][0] = *(const LAS bf16x8*)(sl + ((jt * 2 + 0) * 64 + lane) * 16); A[jt][1] = *(const LAS bf16x8*)(sl + ((jt * 2 + 1) * 64 + lane) * 16); } \
                _Pragma("unroll") for (int jt = 0; jt < 4; ++jt) *(f32x4*)(HS + v * 64 + jt * 16 + q * 4) = dry ? Hc[jt] : D[jt]; \
                bf16x8 B[2]; \
                _Pragma("unroll") for (int kh = 0; kh < 2; ++kh) { u32x4 w; w.x = cvt_pk_native(D[2 * kh][0], D[2 * kh][1]); w.y = cvt_pk_native(D[2 * kh][2], D[2 * kh][3]); \
                    w.z = cvt_pk_native(D[2 * kh + 1][0], D[2 * kh + 1][1]); w.w = cvt_pk_native(D[2 * kh + 1][2], D[2 * kh + 1][3]); B[kh] = __builtin_bit_cast(bf16x8, w); } \
                _Pragma("unroll") for (int jt = 0; jt < 4; ++jt) { f32x4 d = __builtin_amdgcn_mfma_f32_16x16x32_bf16(A[jt][0], B[0], Hc[jt], 0, 0, 0); D[jt] = __builtin_amdgcn_mfma_f32_16x16x32_bf16(A[jt][1], B[1], d, 0, 0, 0); } \
            } } } while (0)
    f32x4 D[4];
#pragma unroll
    for (int jt = 0; jt < 4; ++jt) D[jt] = (f32x4){0.f, 0.f, 0.f, 0.f};
    constexpr int NBT = 128 / SC_NB;
    SC_ISSUE(pfA, 0); SC_COMMIT(pfA);
    __syncthreads();
    SC_ISSUE(pfA, 1); SC_ISSUE(pfB, 2);
    for (int b = 0; b < NBT; b += 2) {
        SC_COMPUTE(b);
        __syncthreads();
        SC_COMMIT(pfA);
        { const int nb_ = b + 3 < NBT ? b + 3 : NBT - 1; SC_ISSUE(pfA, nb_); }
        __syncthreads();
        SC_COMPUTE(b + 1);
        __syncthreads();
        SC_COMMIT(pfB);
        { const int nb_ = b + 4 < NBT ? b + 4 : NBT - 1; SC_ISSUE(pfB, nb_); }
        __syncthreads();
    }
#undef SC_COMPUTE
    if (wave == 0) {
        float* Sout = p.out + O_WKV_P + (size_t)head * 4096;
#pragma unroll
        for (int jt = 0; jt < 4; ++jt) *(f32x4*)(Sout + v * 64 + jt * 16 + q * 4) = D[jt];
    }
#undef SC_ISSUE
#undef SC_COMMIT
}
__device__ __forceinline__ void phase_scan(const Params& p, LAS unsigned char* lds, int dry) {
    const int tid = tid_opaque(), wave = tid >> 6, b = blockIdx.x;
    float* HSG = (float*)(p.ws + WS_HSG); const float* DEC = (const float*)(p.ws + WS_DECG);
    if (b < 32) rwkv_scan_prompt(p, lds, b >> 2, b & 3, dry);
    else if (b < 96) {
        const int e = (b - 32) * 512 + tid, hd = e >> 13, k = (e >> 7) & 63;
        float S = 0.f;
        for (int c = 0; c < 256; c += 32) {
            float t[32], d[32];
#pragma unroll
            for (int u = 0; u < 32; ++u) { t[u] = HSG[(size_t)(c + u) * 32768 + e]; d[u] = DEC[(size_t)((c + u) * 4 + hd) * 64 + k]; }
#pragma unroll
            for (int u = 0; u < 32; ++u) { HSG[(size_t)(c + u) * 32768 + e] = dry ? t[u] : S; S = S * d[u] + t[u]; }
        }
        p.out[O_GLA_P + e] = S;
    } else {
        const int nb = gridDim.x - 96, bb = b - 96;
        for (int j = bb * 8 + wave; j < 512; j += nb * 8) { const int sb = j >> 5, hd = (j >> 2) & 7, vt = j & 3;
            rwkv_scan_job(p, hd, vt, 128 + sb, 1, p.in[3] + (size_t)(sb * 8 + hd) * 4096, p.out + O_WKV_S + (size_t)(sb * 8 + hd) * 4096, dry); }
        for (int i = bb * 512 + tid; i < 16 * 8192; i += nb * 512) { const int sb = i >> 13, e = (i & 8191) * 4, hd = e >> 13, k = (e >> 7) & 63;
            const f32x4 S0 = *(const f32x4*)(p.in[4] + (size_t)sb * 32768 + e); float* hp = HSG + (size_t)(256 + sb) * 32768 + e;
            const f32x4 t = *(const f32x4*)hp; const float d = DEC[(size_t)((256 + sb) * 4 + hd) * 64 + k];
            *(f32x4*)hp = dry ? t : S0; *(f32x4*)(p.out + O_GLA_S + (size_t)sb * 32768 + e) = S0 * d + t; }
    }
}

struct RwkvCConst { bf16x8 GB[4][2]; float lw[4], lb[4], muv[4]; float mug[16]; };
__device__ __forceinline__ float row16_sum(float x) {
    x += __int_as_float(__builtin_amdgcn_update_dpp(0, __float_as_int(x), 0xB1, 0xF, 0xF, true));
    x += __int_as_float(__builtin_amdgcn_update_dpp(0, __float_as_int(x), 0x4E, 0xF, 0xF, true));
    x += __int_as_float(__builtin_amdgcn_update_dpp(0, __float_as_int(x), 0x124, 0xF, 0xF, true));
    x += __int_as_float(__builtin_amdgcn_update_dpp(0, __float_as_int(x), 0x128, 0xF, 0xF, true));
    return x;
}
__device__ __forceinline__ bf16x8 pack8(const float (&v)[8]) {
    u32x4 w; w.x = cvt_pk_bf16(v[0], v[1]); w.y = cvt_pk_bf16(v[2], v[3]); w.z = cvt_pk_bf16(v[4], v[5]); w.w = cvt_pk_bf16(v[6], v[7]); return __builtin_bit_cast(bf16x8, w);
}
__device__ __forceinline__ void unpack8(u32x4 w, float (&v)[8]) {
    v[0] = __uint_as_float(w.x << 16); v[1] = __uint_as_float(w.x & 0xffff0000u); v[2] = __uint_as_float(w.y << 16); v[3] = __uint_as_float(w.y & 0xffff0000u);
    v[4] = __uint_as_float(w.z << 16); v[5] = __uint_as_float(w.z & 0xffff0000u); v[6] = __uint_as_float(w.w << 16); v[7] = __uint_as_float(w.w & 0xffff0000u);
}
__device__ __forceinline__ void rwkv_c_const(const Params& p, int hd, RwkvCConst& K) {
    const int lane = tid_opaque() & 63, n = lane & 15, q = lane >> 4;
#pragma unroll
    for (int nt = 0; nt < 4; ++nt) {
        const int C = hd * 64 + nt * 16 + n;
        K.lw[nt] = p.in[20][C]; K.lb[nt] = p.in[21][C]; K.muv[nt] = p.in[11][1024 + C];
#pragma unroll
        for (int kh = 0; kh < 2; ++kh) { float g[8];
#pragma unroll
            for (int e = 0; e < 8; ++e) g[e] = p.in[16][(size_t)(kh * 32 + q * 8 + e) * 512 + C];
            K.GB[nt][kh] = pack8(g); }
    }
#pragma unroll
    for (int kh = 0; kh < 2; ++kh)
#pragma unroll
        for (int e = 0; e < 8; ++e) K.mug[kh * 8 + e] = p.in[11][1600 + kh * 32 + q * 8 + e];
}
__device__ __forceinline__ void rwkv_c_task(const Params& p, const RwkvCConst& K, int ci, int tok0, int hd, const Seg& sg, int dry) {
    const int lane = tid_opaque() & 63, n = lane & 15, q = lane >> 4;
    const bf16_t* P = (const bf16_t*)(p.ws + WS_PACT);
    const bf16_t* Yb = (const bf16_t*)(p.ws + WS_Y); bf16_t* HB = (bf16_t*)(p.ws + WS_HB);
    const float* Ss = (const float*)(p.ws + WS_HSR) + (size_t)(ci * 8 + hd) * 4096;
    const float* bonus = (const float*)(p.ws + WS_BONUS);
    const int rowb = sg.row0 + tok0;
    bf16x8 SB[4][2]; float bo[4]; bf16_t zr[4][4], cr_[4][4]; float pv0[4];
#pragma unroll
    for (int nt = 0; nt < 4; ++nt)
#pragma unroll
        for (int kh = 0; kh < 2; ++kh) {
            const float* sp = Ss + (nt * 16 + n) * 64 + kh * 32 + q * 8;
            const f32x4 s0 = *(const f32x4*)sp, s1 = *(const f32x4*)(sp + 4);
            const float sv[8] = {s0[0], s0[1], s0[2], s0[3], s1[0], s1[1], s1[2], s1[3]};
            SB[nt][kh] = pack8(sv);
        }
#pragma unroll
    for (int i = 0; i < 4; ++i) bo[i] = bonus[(size_t)(rowb + q * 4 + i) * 8 + hd];
#pragma unroll
    for (int nt = 0; nt < 4; ++nt) {
        const int C = hd * 64 + nt * 16 + n;
        const bool first = (tok0 + q * 4 == 0) && sg.prevkind != 1;
        pv0[nt] = bf2f(P[(size_t)(rowb + q * 4 - (first ? 0 : 1)) * NIN + 1024 + C]);
        if (first) pv0[nt] = sg.prevkind == 2 ? sg.prevptr[1024 + C] : 0.f;
#pragma unroll
        for (int i = 0; i < 4; ++i) { const int row = rowb + q * 4 + i; zr[nt][i] = HB[(size_t)row * 1024 + C]; cr_[nt][i] = P[(size_t)row * NIN + 1024 + C]; }
    }
    bf16x8 AY[2], AG[2];
    {
        const bool first = (tok0 + n == 0) && sg.prevkind != 1;
        const bf16_t* cr = P + (size_t)(rowb + n) * NIN + 1600 + q * 8;
        const bf16_t* pr = P + (size_t)(rowb + n - (first ? 0 : 1)) * NIN + 1600 + q * 8;
#pragma unroll
        for (int kh = 0; kh < 2; ++kh) {
            AY[kh] = *(const bf16x8*)(Yb + (size_t)(rowb + n) * 512 + hd * 64 + kh * 32 + q * 8);
            float c8[8], p8[8];
            unpack8(*(const u32x4*)(cr + kh * 32), c8); unpack8(*(const u32x4*)(pr + kh * 32), p8);
            if (first) {
#pragma unroll
                for (int e = 0; e < 8; ++e) p8[e] = sg.prevkind == 2 ? sg.prevptr[1600 + kh * 32 + q * 8 + e] : 0.f;
            }
#pragma unroll
            for (int e = 0; e < 8; ++e) c8[e] = sigmoidf_(c8[e] + (p8[e] - c8[e]) * K.mug[kh * 8 + e]);
            AG[kh] = pack8(c8);
        }
    }
    f32x4 D[4], G[4];
#pragma unroll
    for (int nt = 0; nt < 4; ++nt) {
        f32x4 d = (f32x4){0.f, 0.f, 0.f, 0.f}, g = (f32x4){0.f, 0.f, 0.f, 0.f};
#pragma unroll
        for (int kh = 0; kh < 2; ++kh) {
            d = __builtin_amdgcn_mfma_f32_16x16x32_bf16(AY[kh], SB[nt][kh], d, 0, 0, 0);
            g = __builtin_amdgcn_mfma_f32_16x16x32_bf16(AG[kh], K.GB[nt][kh], g, 0, 0, 0);
        }
        D[nt] = d; G[nt] = g;
    }
    float o[4][4], vv[4][4];
#pragma unroll
    for (int nt = 0; nt < 4; ++nt) {
        float pv = pv0[nt];
#pragma unroll
        for (int i = 0; i < 4; ++i) {
            o[nt][i] = D[nt][i] + bf2f(zr[nt][i]);
            const float cv = bf2f(cr_[nt][i]);
            vv[nt][i] = cv + (pv - cv) * K.muv[nt]; pv = cv;
        }
    }
#pragma unroll
    for (int i = 0; i < 4; ++i) {
        const float mean = row16_sum((o[0][i] + o[1][i]) + (o[2][i] + o[3][i])) * (1.0f / 64.0f);
        float d2 = 0.f;
#pragma unroll
        for (int nt = 0; nt < 4; ++nt) { o[nt][i] -= mean; d2 += o[nt][i] * o[nt][i]; }
        const float rs = rsqrtf(row16_sum(d2) * (1.0f / 64.0f) + 64e-5f);
#pragma unroll
        for (int nt = 0; nt < 4; ++nt) {
            const int C = hd * 64 + nt * 16 + n;
            const float res = (o[nt][i] * rs * K.lw[nt] + K.lb[nt] + bo[i] * vv[nt][i]) * G[nt][i];
            const unsigned rb = cvt_pk_bf16(res, 0.f);
            bf16_t* dp = dry ? (bf16_t*)(p.ws + WS_DUMMY) + (size_t)blockIdx.x * 512 + threadIdx.x : HB + (size_t)(rowb + q * 4 + i) * 1024 + C;
            *dp = (bf16_t)(rb & 0xffffu);
        }
    }
}
__device__ __forceinline__ void gla_c_task(const Params& p, LAS float* wl, int ci, int row0, int rd, int hd, int dry) {
    const int lane = tid_opaque() & 63, n = lane & 15, q = lane >> 4, kc = hd * 64 + lane;
    const bf16_t* P = (const bf16_t*)(p.ws + WS_PACT) + BOFF; bf16_t* HB = (bf16_t*)(p.ws + WS_HB);
    const float* Ss = (const float*)(p.ws + WS_HSG) + (size_t)(ci * 4 + hd) * 8192;
    LAS float* XG = wl; LAS bf16_t* QT = (LAS bf16_t*)(wl + 256);
    const int rowb = row0 + rd * 16;
    float gku[16];
#pragma unroll
    for (int j = 0; j < 16; ++j) gku[j] = p.in[22][j * 256 + kc];
    const float gkb = p.in[23][kc];
    float bsum = 0.f;
    for (int sb = 0; sb < rd; ++sb) { const float* g = (const float*)(p.ws + WS_GBS) + (size_t)(((ci * 4 + sb) * 4 + hd) * 2) * 64 + lane; bsum += g[0]; bsum += g[64]; }
    { const int idx = lane * 4, tk = idx >> 4, j = idx & 15;
      const u32x2 xw = *(const u32x2*)(P + (size_t)(rowb + tk) * NIN + 1024 + j);
      *(LAS f32x4*)(XG + idx) = (f32x4){__uint_as_float(xw.x << 16), __uint_as_float(xw.x & 0xffff0000u), __uint_as_float(xw.y << 16), __uint_as_float(xw.y & 0xffff0000u)}; }
    float qv[16];
#pragma unroll
    for (int i = 0; i < 16; ++i) qv[i] = bf2f(P[(size_t)(rowb + i) * NIN + kc]) * 0.125f;
    bf16x8 B[8][2];
#pragma unroll
    for (int nt = 0; nt < 8; ++nt)
#pragma unroll
        for (int kh = 0; kh < 2; ++kh) { float sv[8];
#pragma unroll
            for (int e = 0; e < 8; ++e) sv[e] = Ss[(size_t)(kh * 32 + q * 8 + e) * 128 + nt * 16 + n];
            B[nt][kh] = pack8(sv); }
    bf16_t zr[4][8], gr[4][8]; float ng[8];
#pragma unroll
    for (int nt = 0; nt < 8; ++nt) ng[nt] = p.in[24][nt * 16 + n];
#pragma unroll
    for (int i = 0; i < 4; ++i) {
        const int row = rowb + q * 4 + i;
#pragma unroll
        for (int nt = 0; nt < 8; ++nt) { zr[i][nt] = HB[(size_t)row * 1024 + 512 + hd * 128 + nt * 16 + n]; gr[i][nt] = P[(size_t)row * NIN + 1040 + hd * 128 + nt * 16 + n]; }
    }
    __builtin_amdgcn_sched_barrier(0);
#pragma unroll
    for (int i = 0; i < 16; ++i) {
        float gl = gkb;
#pragma unroll
        for (int j4 = 0; j4 < 4; ++j4) { const f32x4 x4 = *(const LAS f32x4*)(XG + i * 16 + j4 * 4); gl += x4[0] * gku[j4 * 4] + x4[1] * gku[j4 * 4 + 1] + x4[2] * gku[j4 * 4 + 2] + x4[3] * gku[j4 * 4 + 3]; }
        bsum += -softplusf_(-gl) * (1.0f / 16.0f);
        QT[i * 72 + lane] = (bf16_t)(cvt_pk_bf16(qv[i] * __expf(bsum), 0.f) & 0xffffu);
    }
    bf16x8 A[2];
#pragma unroll
    for (int kh = 0; kh < 2; ++kh) A[kh] = *(const LAS bf16x8*)(QT + n * 72 + kh * 32 + q * 8);
    f32x4 D[8];
#pragma unroll
    for (int nt = 0; nt < 8; ++nt) {
        f32x4 d = (f32x4){0.f, 0.f, 0.f, 0.f};
#pragma unroll
        for (int kh = 0; kh < 2; ++kh) d = __builtin_amdgcn_mfma_f32_16x16x32_bf16(A[kh], B[nt][kh], d, 0, 0, 0);
        D[nt] = d;
    }
#pragma unroll
    for (int i = 0; i < 4; ++i) {
        const int row = rowb + q * 4 + i;
        bf16_t* ob = HB + (size_t)row * 1024 + 512 + hd * 128 + n;
        float o[8], ss = 0.f;
#pragma unroll
        for (int nt = 0; nt < 8; ++nt) { o[nt] = D[nt][i] + bf2f(zr[i][nt]); ss += o[nt] * o[nt]; }
        const float rs = rsqrtf(row16_sum(ss) * (1.0f / 128.0f) + 1e-6f);
#pragma unroll
        for (int nt = 0; nt < 8; ++nt) {
            const float g = bf2f(gr[i][nt]);
            const unsigned rb = cvt_pk_bf16(o[nt] * rs * ng[nt] * g * sigmoidf_(g), 0.f);
            bf16_t* dp = dry ? (bf16_t*)(p.ws + WS_DUMMY) + (size_t)blockIdx.x * 512 + threadIdx.x : ob + nt * 16;
            *dp = (bf16_t)(rb & 0xffffu);
        }
    }
}
__device__ __forceinline__ void phase_mix_c(const Params& p, LAS unsigned char* lds, int dry, int mask) {
    const int wave = tid_opaque() >> 6, widx = wave * (int)gridDim.x + (int)blockIdx.x, nw = gridDim.x * 8;
    LAS float* wl = (LAS float*)(lds + wave * 16384);
    if (mask & 1) for (int j = widx; j < 4160; j += nw) {
        int ci, row0, rd, hd;
        if (j < 4096) { ci = j >> 4; row0 = ci * 64; rd = (j >> 2) & 3; hd = j & 3; }
        else { const int r = j - 4096, sb = r >> 2; ci = 256 + sb; row0 = MPROMPT + sb * 16; rd = 0; hd = r & 3; }
        gla_c_task(p, wl, ci, row0, rd, hd, dry);
    }
    const int jb = (widx + 4160) % nw, js = nw, je = 8320;
    RwkvCConst KC; rwkv_c_const(p, jb & 7, KC);
    if (mask & 2) for (int j = jb; j < je; j += js) {
        Seg sg; int ci, tok0, hd;
        if (j < 8192) { const int c = j >> 6; ci = c; tok0 = ((j >> 3) & 7) * 16; hd = j & 7; sg.row0 = c * 128; sg.nsteps = 128; sg.prevkind = c == 0 ? 0 : 1; sg.prevptr = nullptr; }
        else { const int r = j - 8192, sb = r >> 3; ci = 128 + sb; tok0 = 0; hd = r & 7; sg.row0 = MPROMPT + sb * 16; sg.nsteps = 16; sg.prevkind = 2; sg.prevptr = p.in[2] + (size_t)sb * ACOLS; }
        rwkv_c_task(p, KC, ci, tok0, hd, sg, dry);
    }
}
__global__ void __launch_bounds__(512, 2) fwd_megakernel(Params p) {
    extern __shared__ __attribute__((aligned(16))) unsigned char shm[];
    LAS unsigned char* lds = (LAS unsigned char*)shm;
    cg::grid_group grid = cg::this_grid();
    float* ssq = (float*)(p.ws + WS_SSQ);
    bf16_t* HB = (bf16_t*)(p.ws + WS_HB); bf16_t* HB2 = (bf16_t*)(p.ws + WS_HB2); bf16_t* PACT = (bf16_t*)(p.ws + WS_PACT);
    float* XRES = p.out;
    float* PART = (float*)(p.ws + WS_HSR);
#if BARRIER_KIND == 0
#define GSYNC() grid.sync()
#elif BARRIER_KIND == 1
#define GSYNC() xcd_barrier(xb)
#else
    unsigned bar_round = 0;
    const unsigned bar_g = blockIdx.x & 7u, bar_gsize = (gridDim.x + 7u - bar_g) >> 3, bar_ngrp = gridDim.x < 8u ? gridDim.x : 8u;
#define GSYNC() do { asm volatile("s_waitcnt vmcnt(0)" ::: "memory"); __syncthreads(); if (threadIdx.x == 0) { size_t off_ = WS_BAR + 3520 * 4; asm volatile("" : "+s"(off_)); unsigned* cnt_ = (unsigned*)(p.ws + off_); ++bar_round; \
        __builtin_amdgcn_fence(__ATOMIC_RELEASE, "agent"); \
        const unsigned old_ = __hip_atomic_fetch_add(cnt_ + 64 * (1 + bar_g), 1u, __ATOMIC_RELAXED, __HIP_MEMORY_SCOPE_AGENT); \
        if (old_ + 1u == bar_gsize * bar_round) __hip_atomic_fetch_add(cnt_, 1u, __ATOMIC_RELAXED, __HIP_MEMORY_SCOPE_AGENT); \
        while (__hip_atomic_load(cnt_, __ATOMIC_RELAXED, __HIP_MEMORY_SCOPE_AGENT) < bar_round * bar_ngrp) __builtin_amdgcn_s_sleep(1); \
        __builtin_amdgcn_fence(__ATOMIC_ACQUIRE, "agent"); asm volatile("s_waitcnt vmcnt(0)" ::: "memory"); } __syncthreads(); } while (0)
#endif
#define REPS(k) (1 + (DUP_PHASE == (k) ? DUP_N : 0))
#define PHASE(k, ...) for (int rep_ = 0; rep_ < REPS(k); ++rep_) { int dry = rep_ < REPS(k) - 1; asm volatile("" : "+s"(dry)); __VA_ARGS__ GSYNC(); }
    if (p.ws == nullptr) grid.sync();
    for (int rep_ = 0; rep_ < REPS(0); ++rep_) { phase_convert(p, lds, 2, (int)blockIdx.x, (int)gridDim.x); GSYNC(); }
    if (threadIdx.x == 0) *(LAS u32x4*)(lds + 131072) = (u32x4){0u, 0u, 0u, 0u};
    __syncthreads();
#if BARRIER_KIND == 1
    const XcdBarrier xb = xcd_barrier_post((unsigned*)(p.ws + WS_BAR), (volatile LAS unsigned*)(lds + 131072));
#endif
    PHASE(1, { EpiSwiglu E; E.O = PACT; E.ssq = ssq; E.nparts = 1; run_gemm(lds, HB, (const bf16_t*)(p.ws + WS_W1GU), 5632, 1024, E); })
    PHASE(2, { const EpiResid E{p.in[0], 0.5f, p.in[1], 0, XRES, HB, ssq + 16 * MROWS, PART}; run_gemm_split(lds, PACT, (const bf16_t*)(p.ws + WS_W1D), FF, E); })
    split_fixup(PART, 11, p.in[1], XRES, HB, ssq + 16 * MROWS, 0.5f, 0, nullptr); GSYNC();
    PHASE(3, { EpiP E; E.P = PACT; E.ssq = ssq + 16 * MROWS; E.out = p.out; run_gemm(lds, HB, (const bf16_t*)(p.ws + WS_WIN), NINP, 1024, E); })
    PHASE(4, { int mask = dry ? DUP_MASK : 3; asm volatile("" : "+s"(mask)); phase_mix_a(p, lds, mask); })
#if GLA2_SEL >= 0
    { int sel = GLA2_SEL; asm volatile("" : "+s"(sel)); phase_mix_a2(p, lds, sel); GSYNC(); }
#endif
    PHASE(5, phase_scan(p, lds, dry);)
    PHASE(6, { int mask = dry ? DUP_MASK : 3; asm volatile("" : "+s"(mask)); phase_mix_c(p, lds, dry, mask); })
    PHASE(7, { const EpiResid E{XRES, 1.0f, XRES + (size_t)MPROMPT * DM, dry, XRES, HB2, ssq + 32 * MROWS, PART}; run_gemm_split(lds, HB, (const bf16_t*)(p.ws + WS_WOUT), 1024, E); })
    split_fixup(PART, 4, XRES + (size_t)MPROMPT * DM, XRES, HB2, ssq + 32 * MROWS, 1.0f, 0, nullptr); GSYNC();
    PHASE(8, { EpiSwiglu E; E.O = PACT; E.ssq = ssq + 32 * MROWS; E.nparts = 16; run_gemm(lds, HB2, (const bf16_t*)(p.ws + WS_W2GU), 5632, 1024, E); })
    PHASE(9, { const EpiResid E{XRES, 0.5f, XRES + (size_t)MPROMPT * DM, dry, XRES, nullptr, ssq + 48 * MROWS, PART}; run_gemm_split(lds, PACT, (const bf16_t*)(p.ws + WS_W2D), FF, E); })
    split_fixup(PART, 11, XRES + (size_t)MPROMPT * DM, XRES, nullptr, ssq + 48 * MROWS, 0.5f, 0, p.in[30]);
#if DUP_PHASE == 11
    for (int rep_ = 0; rep_ < 10 * DUP_N; ++rep_) GSYNC();
#endif
    for (int rep_ = 0; rep_ < REPS(10); ++rep_) { int dry = rep_ < REPS(10) - 1; asm volatile("" : "+s"(dry)); phase_final_norm(p, dry); if (dry) GSYNC(); }
}

extern "C" void kernel_launch(void* const* d_in, const int* in_sizes, int n_in, void* d_out, int out_size, void* d_ws, size_t ws_size, hipStream_t stream) {
    static int grid = 0;
    if (grid == 0) {
        if (n_in != 31 || (size_t)out_size != O_END || ws_size < WS_END) { fprintf(stderr, "kernel_launch: unexpected sizes n_in %d out %d ws %zu (need %zu)\n", n_in, out_size, ws_size, (size_t)WS_END); grid = -1; return; }
        int dev = 0, cus = 0, per_cu = 0;
        hipGetDevice(&dev); hipDeviceGetAttribute(&cus, hipDeviceAttributeMultiprocessorCount, dev);
        if (hipFuncSetAttribute((const void*)fwd_megakernel, hipFuncAttributeMaxDynamicSharedMemorySize, LDS_BYTES) != hipSuccess) { fprintf(stderr, "kernel_launch: hipFuncSetAttribute failed\n"); grid = -1; return; }
        if (hipOccupancyMaxActiveBlocksPerMultiprocessor(&per_cu, (const void*)fwd_megakernel, 512, LDS_BYTES) != hipSuccess || per_cu < 1) { fprintf(stderr, "kernel_launch: occupancy query says %d\n", per_cu); per_cu = 1; }
        (void)hipGetLastError();
        grid = cus;
    }
    if (grid < 0) return;
    if (hipMemsetAsync((unsigned char*)d_ws + WS_BAR, 0, 16384, stream) != hipSuccess) { fprintf(stderr, "kernel_launch: memset failed\n"); return; }
    Params p{};
    for (int i = 0; i < 31; ++i) p.in[i] = (const float*)d_in[i];
    p.out = (float*)d_out; p.ws = (unsigned char*)d_ws;
    void* args[] = {&p};
    hipError_t e = hipLaunchCooperativeKernel((const void*)fwd_megakernel, dim3(grid), dim3(512), args, LDS_BYTES, stream);
    if (e != hipSuccess) fprintf(stderr, "cooperative launch failed: %s (grid %d)\n", hipGetErrorString(e), grid);
}
```

```cpp
#include <hip/hip_runtime.h>
#include <hip/hip_cooperative_groups.h>
#include <cstdio>
namespace cg = cooperative_groups;
#define BARRIER_KIND 2
#define GLA2_SEL -1
#ifndef DUP_PHASE
#define DUP_PHASE -1
#define DUP_N 1
#define DUP_MASK 3
#endif
namespace pg8 {
#define PG8_LAS __attribute__((address_space(3)))
typedef unsigned short bf16_t;
typedef short bf16x8 __attribute__((ext_vector_type(8)));
typedef float f32x4 __attribute__((ext_vector_type(4)));
typedef unsigned u32x4 __attribute__((ext_vector_type(4)));
constexpr int BM = 256, BK = 64, HALF = 128, HTB = HALF * BK * 2  , STAGE_BYTES = 8 * HTB, NXCD = 8, WGM = 8;

__host__ __device__ __forceinline__ int lds_byte(int r, int c) { const int st = (r >> 4) * 2 + (c >> 5), rr = r & 15, cc = c & 31, ob = rr * 64 + cc * 2; return st * 1024 + (ob ^ (((ob >> 9) & 1) << 5)); }
__host__ __device__ __forceinline__ void stage_rc(int b, int& R, int& C) { const int st = b / 1024, sb = b % 1024, swz = sb ^ (((sb >> 9) & 1) << 5); R = (st >> 1) * 16 + swz / 64; C = (st & 1) * 32 + (swz % 64) / 2; }
__host__ __device__ __forceinline__ int perm32(int rho) { const int n = rho >> 4, i = rho & 15; return 8 * (i >> 2) + 4 * n + (i & 3); }

struct Unit { int pm, pn, k0, nkt, part; };
struct Gemm { const bf16_t* A; const bf16_t* Bt; int M, N, K; };

struct StaticOrder {
    int nM, nN, nwg, G, c, nkt;
    __host__ __device__ void init(int M, int N, int G_, int c_, int K_ = 0) { nM = M / BM; nN = N / BM; nwg = nM * nN; G = G_; c = c_; nkt = K_ / BK; }
    __host__ __device__ bool next(int i, Unit& u) const {
        const long L = (long)i * G + c; if (L >= nwg) return false;
        int wgid = (int)L; { const int q = nwg / NXCD, r = nwg % NXCD, xcd = wgid % NXCD, off = wgid / NXCD; wgid = (xcd < r ? xcd * (q + 1) : r * (q + 1) + (xcd - r) * q) + off; }
        const int nig = WGM * nN, gid = wgid / nig, fm = gid * WGM, gsz = (nM - fm) < WGM ? (nM - fm) : WGM;
        u.pm = fm + ((wgid % nig) % gsz); u.pn = (wgid % nig) / gsz; u.k0 = 0; u.nkt = nkt; u.part = -1; return true;
    }
    __device__ __forceinline__ void a_ready(const Unit&) const {}
    __device__ __forceinline__ void done(const Unit&) const {}
};
__device__ __forceinline__ unsigned cvt_pk_bf16(float lo, float hi) { unsigned r; asm volatile("v_cvt_pk_bf16_f32 %0, %1, %2" : "=v"(r) : "v"(lo), "v"(hi)); return r; }

template <class Epi, class Sched, bool STAMP = false>
__device__ __forceinline__ void gemm_phase(PG8_LAS unsigned char* lds, const Gemm g, const Sched& S, const Epi& E, unsigned long long* stamps) {
    int tid_ = threadIdx.x; asm volatile("" : "+v"(tid_)); const int tid = tid_, wid = __builtin_amdgcn_readfirstlane(tid >> 6), lane = tid & 63, wr = wid >> 2, wc = wid & 3, fr = lane & 15, fq = lane >> 4;
    const int K = g.K;
    int ts_lo = 0, ts_hi = 0, nts = 0; const unsigned long long rt_entry = STAMP ? (unsigned long long)wall_clock64() : 0ull;
#define PG8_STAMP() do { if (STAMP && wid == 0 && nts < 64) { const unsigned long long _c = (unsigned long long)clock64(); \
        ts_lo = (lane == nts) ? (int)(unsigned)_c : ts_lo; ts_hi = (lane == nts) ? (int)(unsigned)(_c >> 32) : ts_hi; ++nts; } } while (0)
    PG8_STAMP();
    unsigned voffA[2], voffB[2];
#pragma unroll
    for (int i = 0; i < 2; ++i) { int R, C; stage_rc(tid * 16 + i * 8192, R, C); const int Rb = Epi::PERM ? ((R & ~31) + perm32(R & 31)) : R;
        voffA[i] = (unsigned)(R * K + C) * 2u; voffB[i] = (unsigned)(Rb * K + C) * 2u; }
    const size_t kstep = (size_t)(BK * 2);
    const size_t hstep = (size_t)HALF * K * 2;
    const size_t tstep = 2 * hstep;
    const unsigned ldsw = (unsigned)wid * 1024u;
    const int aoff = lds_byte(wr * 64 + fr, fq * 8), boff = lds_byte(wc * 32 + fr, fq * 8);
#define PG8_SA(b, h) (((b) * 2 + (h)) * HTB)
#define PG8_SB(b, h) ((4 + (b) * 2 + (h)) * HTB)
#define PG8_STAGE(bufoff, gbase, voff) do { _Pragma("unroll") for (int _i = 0; _i < 2; ++_i) \
        __builtin_amdgcn_global_load_lds((const unsigned*)((const char*)(gbase) + (voff)[_i]), (PG8_LAS unsigned*)(lds + (bufoff) + ldsw + _i * 8192), 16, 0, 0); } while (0)
#define PG8_LDA(dst, b, h) do { _Pragma("unroll") for (int m = 0; m < 4; ++m) _Pragma("unroll") for (int k = 0; k < 2; ++k) dst[m][k] = *(const PG8_LAS bf16x8*)(lds + PG8_SA(b, h) + aoff + m * 2048 + k * 1024); } while (0)
#define PG8_LDB(dst, b, h) do { _Pragma("unroll") for (int n = 0; n < 2; ++n) _Pragma("unroll") for (int k = 0; k < 2; ++k) dst[n][k] = *(const PG8_LAS bf16x8*)(lds + PG8_SB(b, h) + boff + n * 2048 + k * 1024); } while (0)
#define PG8_MMA(ai, bj, At, Bt) do { __builtin_amdgcn_s_setprio(1); _Pragma("unroll") for (int m = 0; m < 4; ++m) _Pragma("unroll") for (int n = 0; n < 2; ++n) _Pragma("unroll") for (int k = 0; k < 2; ++k) \
        acc[ai][bj][m][n] = __builtin_amdgcn_mfma_f32_16x16x32_bf16(Bt[n][k], At[m][k], acc[ai][bj][m][n], 0, 0, 0); __builtin_amdgcn_s_setprio(0); } while (0)
#define PG8_WAIT_V(n) asm volatile("s_waitcnt vmcnt(" #n ")" ::: "memory")
#define PG8_WAIT_L(n) asm volatile("s_waitcnt lgkmcnt(" #n ")" ::: "memory")
#define PG8_BAR __builtin_amdgcn_s_barrier()
#define PG8_SCHED __builtin_amdgcn_sched_barrier(0)
    Unit cur, nxt; int ui = 0;
    if (!S.next(0, cur)) return;
    f32x4 acc[2][2][4][2];
#pragma unroll
    for (int a = 0; a < 2; ++a)
#pragma unroll
        for (int b = 0; b < 2; ++b)
#pragma unroll
            for (int m = 0; m < 4; ++m)
#pragma unroll
                for (int n = 0; n < 2; ++n) acc[a][b][m][n] = (f32x4){0.f, 0.f, 0.f, 0.f};
    bf16x8 At[4][2], B0[2][2], B1[2][2];
    const char* cA = (const char*)g.A + (size_t)cur.pm * tstep + (size_t)cur.k0 * kstep; const char* cB = (const char*)g.Bt + (size_t)cur.pn * tstep + (size_t)cur.k0 * kstep;
    S.a_ready(cur);
    PG8_STAGE(PG8_SB(0, 0), cB, voffB); PG8_STAGE(PG8_SA(0, 0), cA, voffA); PG8_STAGE(PG8_SB(0, 1), cB + hstep, voffB); PG8_STAGE(PG8_SA(0, 1), cA + hstep, voffA);
    if (wr == 1) PG8_BAR;
    PG8_WAIT_V(4); PG8_BAR;
    PG8_STAGE(PG8_SB(1, 0), cB + kstep, voffB); PG8_STAGE(PG8_SA(1, 0), cA + kstep, voffA); PG8_STAGE(PG8_SB(1, 1), cB + hstep + kstep, voffB);
    PG8_WAIT_V(6); PG8_BAR;
    PG8_STAMP();
    for (;;) {
        const bool has_next = S.next(ui + 1, nxt);
        const char* nA = has_next ? (const char*)g.A + (size_t)nxt.pm * tstep + (size_t)nxt.k0 * kstep : cA; const char* nB = has_next ? (const char*)g.Bt + (size_t)nxt.pn * tstep + (size_t)nxt.k0 * kstep : cB;
        const int nt = cur.nkt;
        for (int t = 0; t < nt; t += 2) {
            const bool last = (t == nt - 2);
            const char* a1 = cA + (size_t)(t + 1) * kstep;
            const char* a2 = last ? nA : cA + (size_t)(t + 2) * kstep; const char* b2 = last ? nB : cB + (size_t)(t + 2) * kstep;
            const char* a3 = a2 + kstep; const char* b3 = b2 + kstep;
            if (last && has_next) S.a_ready(nxt);
            PG8_LDB(B0, 0, 0); PG8_SCHED; PG8_LDA(At, 0, 0); PG8_STAGE(PG8_SA(1, 1), a1 + hstep, voffA);
            PG8_WAIT_L(8); PG8_BAR; PG8_WAIT_L(0); PG8_MMA(0, 0, At, B0); PG8_BAR; PG8_SCHED;
            PG8_LDB(B1, 0, 1); PG8_STAGE(PG8_SB(0, 0), b2, voffB);
            PG8_BAR; PG8_WAIT_L(0); PG8_MMA(0, 1, At, B1); PG8_BAR;
            PG8_LDA(At, 0, 1); PG8_STAGE(PG8_SA(0, 0), a2, voffA);
            PG8_BAR; PG8_WAIT_L(0); PG8_MMA(1, 0, At, B0); PG8_BAR; PG8_SCHED;
            PG8_STAGE(PG8_SB(0, 1), b2 + hstep, voffB);
            PG8_WAIT_V(6); PG8_BAR; PG8_MMA(1, 1, At, B1); PG8_BAR;
            PG8_LDB(B0, 1, 0); PG8_SCHED; PG8_LDA(At, 1, 0); PG8_STAGE(PG8_SA(0, 1), a2 + hstep, voffA);
            PG8_WAIT_L(8); PG8_BAR; PG8_WAIT_L(0); PG8_MMA(0, 0, At, B0); PG8_BAR; PG8_SCHED;
            PG8_LDB(B1, 1, 1); PG8_STAGE(PG8_SB(1, 0), b3, voffB);
            PG8_BAR; PG8_WAIT_L(0); PG8_MMA(0, 1, At, B1); PG8_BAR;
            PG8_LDA(At, 1, 1); PG8_STAGE(PG8_SA(1, 0), a3, voffA);
            PG8_BAR; PG8_WAIT_L(0); PG8_MMA(1, 0, At, B0); PG8_BAR; PG8_SCHED;
            PG8_STAGE(PG8_SB(1, 1), b3 + hstep, voffB);
            PG8_WAIT_V(6); PG8_BAR; PG8_MMA(1, 1, At, B1); PG8_BAR;
        }
        PG8_STAMP();
        if constexpr (!Epi::AFTER_DRAIN) { E(acc, cur, wr, wc, fr, fq); S.done(cur); }
        PG8_STAMP();
        if (!has_next) break;
#pragma unroll
        for (int a = 0; a < 2; ++a)
#pragma unroll
            for (int b = 0; b < 2; ++b)
#pragma unroll
                for (int m = 0; m < 4; ++m)
#pragma unroll
                    for (int n = 0; n < 2; ++n) acc[a][b][m][n] = (f32x4){0.f, 0.f, 0.f, 0.f};
        cur = nxt; cA = nA; cB = nB; ++ui;
    }
    PG8_WAIT_V(0);
    if (wr == 0) PG8_BAR;
    PG8_BAR;
    if constexpr (Epi::AFTER_DRAIN) { E.fused(acc, cur, wr, wc, fr, fq, lds, wid, lane); S.done(cur); }
    PG8_STAMP();
    if (STAMP && wid == 0) { stamps[lane] = lane < nts ? (((unsigned long long)(unsigned)ts_hi << 32) | (unsigned)ts_lo) : 0ull;
        if (lane == 62) stamps[62] = rt_entry; if (lane == 63) stamps[63] = (unsigned long long)wall_clock64(); }
#undef PG8_STAMP
#undef PG8_SA
#undef PG8_SB
#undef PG8_STAGE
#undef PG8_LDA
#undef PG8_LDB
#undef PG8_MMA
#undef PG8_WAIT_V
#undef PG8_WAIT_L
#undef PG8_BAR
#undef PG8_SCHED
}
}
#define LAS PG8_LAS
#define XB_TMO      128
#define XB_XCNT(j)  (256  + 64 * (j))
#define XB_XSUB(j)  (1280 + 64 * (j))
#define XB_XGEN(j)  (2304 + 64 * (j))
#define XB_TOP      3328
#define XB_TOPGEN   3392
#define XCD_BAR_WORDS 3456
#define XB_SPIN_CAP (1u << 18)

__device__ __forceinline__ unsigned xb_ld(unsigned* p)              { return __hip_atomic_load(p, __ATOMIC_RELAXED, __HIP_MEMORY_SCOPE_AGENT); }
__device__ __forceinline__ unsigned xb_add(unsigned* p, unsigned v) { return __hip_atomic_fetch_add(p, v, __ATOMIC_RELAXED, __HIP_MEMORY_SCOPE_AGENT); }
__device__ __forceinline__ unsigned xb_xcc_id() { return (unsigned)__builtin_amdgcn_s_getreg((3 << 11) | 20) & 0xFu; }
#define XB_SPIN(cond, bar) do { unsigned _sp = 0; while (cond) { __builtin_amdgcn_s_sleep(1); \
    if ((++_sp & 255u) == 0u) { if (xb_ld(&(bar)[XB_TMO])) break; if (_sp > XB_SPIN_CAP) { atomicAdd(&(bar)[XB_TMO], 1u); break; } } } } while (0)

struct XcdBarrier {
    unsigned* bar; unsigned x;
    volatile LAS unsigned* st;
};

__device__ __forceinline__ XcdBarrier xcd_barrier_post(unsigned* bar, volatile LAS unsigned* st) {
    XcdBarrier b; b.bar = bar; b.x = xb_xcc_id(); b.st = st;
    if (threadIdx.x == 0) (void)xb_add(&bar[XB_XCNT(b.x)], 1u);
    return b;
}
__device__ __forceinline__ void xcd_barrier_complete(unsigned* bar, unsigned x, unsigned& nloc, unsigned& nx) {
    const unsigned G = gridDim.x * gridDim.y * gridDim.z;
    unsigned sum, cnt, mine, sp = 0u;
    for (;;) {
        sum = 0u; cnt = 0u; mine = 0u;
#pragma unroll
        for (unsigned j = 0; j < 16; ++j) { const unsigned c = xb_ld(&bar[XB_XCNT(j)]); sum += c; cnt += (c > 0u) ? 1u : 0u; mine = (j == x) ? c : mine; }
        if (sum == G) break;
        __builtin_amdgcn_s_sleep(1);
        if ((++sp & 255u) == 0u) { if (xb_ld(&bar[XB_TMO])) break; if (sp > XB_SPIN_CAP) { atomicAdd(&bar[XB_TMO], 1u); break; } }
    }
    nloc = mine > 0u ? mine : 1u; nx = cnt > 0u ? cnt : 1u;
}

__device__ __forceinline__ void xcd_barrier(const XcdBarrier& b) {
    asm volatile("s_waitcnt vmcnt(0)" ::: "memory");
    __syncthreads();
    if (threadIdx.x == 0) {
        unsigned* bar = b.bar;
        __builtin_amdgcn_s_waitcnt(0);
        unsigned nloc = b.st[0], nx = b.st[1];
        if (nloc == 0u) { xcd_barrier_complete(bar, b.x, nloc, nx); b.st[0] = nloc; b.st[1] = nx; }
        const unsigned old = xb_add(&bar[XB_XSUB(b.x)], 1u);
        const unsigned gen = old / nloc;
        if (old + 1u == (gen + 1u) * nloc) {
            __builtin_amdgcn_fence(__ATOMIC_RELEASE, "agent");
            asm volatile("s_waitcnt vmcnt(0)" ::: "memory");
            const unsigned og = xb_add(&bar[XB_TOP], 1u);
            const unsigned tg = og / nx;
            if (og + 1u == (tg + 1u) * nx) xb_add(&bar[XB_TOPGEN], 1u);
            else XB_SPIN(xb_ld(&bar[XB_TOPGEN]) == tg, bar);
            __builtin_amdgcn_fence(__ATOMIC_ACQUIRE, "agent");
            xb_add(&bar[XB_XGEN(b.x)], 1u);
            asm volatile("s_waitcnt vmcnt(0)" ::: "memory");
        } else {
            XB_SPIN(xb_ld(&bar[XB_XGEN(b.x)]) == gen, bar);
            __builtin_amdgcn_fence(__ATOMIC_ACQUIRE, "agent");
            asm volatile("s_waitcnt vmcnt(0)" ::: "memory");
        }
    }
    __syncthreads();
}

using pg8::bf16_t; using pg8::bf16x8; using pg8::f32x4; using pg8::u32x4; using pg8::Unit; using pg8::cvt_pk_bf16;

typedef float f32x2 __attribute__((ext_vector_type(2)));
typedef unsigned u32x2 __attribute__((ext_vector_type(2)));

constexpr int MROWS = 16640, MPROMPT = 16384, DM = 1024, FF = 2816, NIN = 3216, NINP = 3328, ACOLS = 1664, BOFF = 1664;
constexpr int NSAMP = 16, SAMP_T = 16;
constexpr size_t O_Y = 0, O_SHIFT_P = 17039360, O_WKV_P = 17041024, O_GLA_P = 17073792, O_SHIFT_S = 17106560, O_WKV_S = 17133184, O_GLA_S = 17657472, O_END = 18181760;
constexpr size_t al256(size_t x) { return (x + 255) & ~(size_t)255; }
constexpr size_t WS_W1GU = 0;
constexpr size_t WS_W1D  = WS_W1GU + (size_t)5632 * 1024 * 2;
constexpr size_t WS_WIN  = WS_W1D + (size_t)1024 * 2816 * 2;
constexpr size_t WS_WOUT = WS_WIN + (size_t)NINP * 1024 * 2;
constexpr size_t WS_W2GU = WS_WOUT + (size_t)1024 * 1024 * 2;
constexpr size_t WS_W2D  = WS_W2GU + (size_t)5632 * 1024 * 2;
constexpr size_t WS_SSQ  = WS_W2D + (size_t)1024 * 2816 * 2;
constexpr size_t SSQ_BYTES = (size_t)16 * MROWS * 4;
constexpr size_t WS_HB   = WS_SSQ + 4 * SSQ_BYTES;
constexpr size_t WS_PACT = WS_HB + (size_t)MROWS * 1024 * 2;
constexpr size_t WS_G    = WS_PACT + (size_t)MROWS * NIN * 2;
constexpr size_t WS_HSR  = WS_G + (size_t)144 * 8 * 8192;
constexpr size_t WS_HSG  = WS_HSR + (size_t)144 * 8 * 16384;
constexpr size_t WS_DECG = WS_HSG + (size_t)272 * 4 * 32768;
constexpr size_t WS_BONUS= WS_DECG + (size_t)272 * 4 * 64 * 4;
constexpr size_t WS_BAR  = WS_BONUS + (size_t)MROWS * 8 * 4;
constexpr size_t WS_DUMMY= WS_BAR + 16384;
constexpr size_t WS_GBS  = WS_DUMMY + ((size_t)1 << 20);
constexpr size_t WS_END  = WS_GBS + (size_t)272 * 4 * 4 * 2 * 64 * 4;
constexpr size_t WS_Y    = WS_W1GU;
constexpr size_t WS_HB2  = WS_HSG;
static_assert((size_t)MROWS * 512 * 2 <= WS_WOUT, "Y overlay");
static_assert((size_t)MROWS * 1024 * 2 <= (size_t)272 * 4 * 32768, "HB2 overlay");
constexpr int LDS_BYTES = 131072 + 16;

struct Params { const float* in[31]; float* out; unsigned char* ws; };

__device__ __forceinline__ float rstd_of(const float* ssq, int nparts, int row) {
    float s = 0.f;
    for (int p = 0; p < nparts; ++p) s += ssq[(size_t)p * MROWS + row];
    return rsqrtf(s * (1.0f / 1024.0f) + 1e-6f);
}
__device__ __forceinline__ int tid_opaque() { int t = threadIdx.x; asm volatile("" : "+v"(t)); return t; }
__device__ __forceinline__ float sigmoidf_(float x) { return __builtin_amdgcn_rcpf(1.0f + __expf(-x)); }

struct EpiSwiglu {
    static constexpr bool PERM = true, AFTER_DRAIN = false;
    bf16_t* O; const float* ssq; int nparts;
    __device__ __forceinline__ void operator()(const f32x4 (&acc)[2][2][4][2], const Unit& u, int wr, int wc, int fr, int fq) const {
        const int row0 = u.pm * 256 + wr * 64 + fr, col0 = u.pn * 128 + wc * 32 + 8 * fq;
#pragma unroll
        for (int ai = 0; ai < 2; ++ai)
#pragma unroll
            for (int m = 0; m < 4; ++m) {
                const int row = row0 + ai * 128 + m * 16; const float rs = nparts ? rstd_of(ssq, nparts, row) : 1.0f;
                float a[8];
#pragma unroll
                for (int n = 0; n < 2; ++n)
#pragma unroll
                    for (int j = 0; j < 4; ++j) { const float g = acc[ai][0][m][n][j] * rs, up = acc[ai][1][m][n][j] * rs; a[n * 4 + j] = g * sigmoidf_(g) * up; }
                u32x4 w; w.x = cvt_pk_bf16(a[0], a[1]); w.y = cvt_pk_bf16(a[2], a[3]); w.z = cvt_pk_bf16(a[4], a[5]); w.w = cvt_pk_bf16(a[6], a[7]);
                *(u32x4*)(O + (size_t)row * FF + col0) = w;
            }
    }
};
struct EpiResid {
    static constexpr bool PERM = true, AFTER_DRAIN = false;
    const float* xoldA; float scale; const float* xoldB; int dry; float* xnew; bf16_t* xb; float* ssq; float* part;
    __device__ __forceinline__ void operator()(const f32x4 (&acc)[2][2][4][2], const Unit& u, int wr, int wc, int fr, int fq) const {
        const int row0 = u.pm * 256 + wr * 64 + fr, col0 = u.pn * 256 + wc * 32 + 8 * fq;
        float sc_ = scale; asm volatile("" : "+v"(sc_)); const f32x4 sc4 = (f32x4){sc_, sc_, sc_, sc_};
        if (u.part >= 0) {
            float* pb = part + ((size_t)(u.part * 4 + u.pn) * 256 + wr * 64 + fr) * 256 + wc * 32 + 8 * fq;
#pragma unroll
            for (int ai = 0; ai < 2; ++ai)
#pragma unroll
                for (int m = 0; m < 4; ++m)
#pragma unroll
                    for (int bj = 0; bj < 2; ++bj) { float* q = pb + (size_t)(ai * 128 + m * 16) * 256 + bj * 128; *(f32x4*)q = acc[ai][bj][m][0]; *(f32x4*)(q + 4) = acc[ai][bj][m][1]; }
        } else
#pragma unroll
        for (int ai = 0; ai < 2; ++ai)
#pragma unroll
            for (int m = 0; m < 4; ++m) {
                const int row = row0 + ai * 128 + m * 16;
                const float* xo = row < MPROMPT ? xoldA + (size_t)row * DM : xoldB + (size_t)(row - MPROMPT) * DM;
                float sq = 0.f;
#pragma unroll
                for (int bj = 0; bj < 2; ++bj) {
                    const int col = col0 + bj * 128;
                    f32x4 v0 = *(const f32x4*)(xo + col), v1 = *(const f32x4*)(xo + col + 4);
                    if (!dry) { v0 += acc[ai][bj][m][0] * sc4; v1 += acc[ai][bj][m][1] * sc4; }
                    *(f32x4*)(xnew + (size_t)row * DM + col) = v0; *(f32x4*)(xnew + (size_t)row * DM + col + 4) = v1;
                    if (xb) { u32x4 w; w.x = cvt_pk_bf16(v0[0], v0[1]); w.y = cvt_pk_bf16(v0[2], v0[3]); w.z = cvt_pk_bf16(v1[0], v1[1]); w.w = cvt_pk_bf16(v1[2], v1[3]);
                        *(u32x4*)(xb + (size_t)row * DM + col) = w; }
                    sq += (v0[0] * v0[0] + v0[1] * v0[1]) + (v0[2] * v0[2] + v0[3] * v0[3]) + (v1[0] * v1[0] + v1[1] * v1[1]) + (v1[2] * v1[2] + v1[3] * v1[3]);
                }
                sq += __shfl_xor(sq, 16); sq += __shfl_xor(sq, 32);
                if (fq == 0) ssq[(size_t)(u.pn * 4 + wc) * MROWS + row] = sq;
            }
    }
};
struct EpiP {
    static constexpr bool PERM = true, AFTER_DRAIN = false;
    bf16_t* P; const float* ssq; float* out;
    __device__ __forceinline__ void operator()(const f32x4 (&acc)[2][2][4][2], const Unit& u, int wr, int wc, int fr, int fq) const {
        const int row0 = u.pm * 256 + wr * 64 + fr, col0 = u.pn * 256 + wc * 32 + 8 * fq;
#pragma unroll
        for (int ai = 0; ai < 2; ++ai)
#pragma unroll
            for (int m = 0; m < 4; ++m) {
                const int row = row0 + ai * 128 + m * 16; const float rs = rstd_of(ssq, 16, row);
                float* dst = nullptr;
                if (row == MPROMPT - 1) dst = out + O_SHIFT_P;
                else if (row >= MPROMPT && ((row - MPROMPT) & 15) == 15) dst = out + O_SHIFT_S + (size_t)((row - MPROMPT) >> 4) * ACOLS;
#pragma unroll
                for (int bj = 0; bj < 2; ++bj) {
                    const int col = col0 + bj * 128;
                    if (col < NIN) {
                        const f32x4 v0 = acc[ai][bj][m][0] * rs, v1 = acc[ai][bj][m][1] * rs;
                        u32x4 w; w.x = cvt_pk_bf16(v0[0], v0[1]); w.y = cvt_pk_bf16(v0[2], v0[3]); w.z = cvt_pk_bf16(v1[0], v1[1]); w.w = cvt_pk_bf16(v1[2], v1[3]);
                        *(u32x4*)(P + (size_t)row * NIN + col) = w;
                        if (dst && col < ACOLS) { *(f32x4*)(dst + col) = v0; *(f32x4*)(dst + col + 4) = v1; }
                    }
                }
            }
    }
};
template <class Epi>
__device__ __forceinline__ void run_gemm(LAS unsigned char* lds, const bf16_t* A, const bf16_t* Bt, int N, int K, const Epi& E) {
    pg8::Gemm g; g.A = A; g.Bt = Bt; g.M = MROWS; g.N = N; g.K = K;
    pg8::StaticOrder S; S.init(MROWS, N, (int)gridDim.x, (int)blockIdx.x, K);
    pg8::gemm_phase<Epi, pg8::StaticOrder, false>(lds, g, S, E, nullptr);
}
struct SplitOrder {
    pg8::StaticOrder S; int nsmall, c;
    __device__ void init(int G, int c_, int K) { S.init(MPROMPT, 1024, G, c_, K); c = c_; nsmall = 4 * (K / 256); }
    __device__ bool next(int i, Unit& u) const {
        if (i == 0) return S.next(0, u);
        if (i == 1 && c < nsmall) { u.pm = MPROMPT / 256; u.pn = c & 3; u.part = c >> 2; u.k0 = u.part * 4; u.nkt = 4; return true; }
        return false;
    }
    __device__ __forceinline__ void a_ready(const Unit&) const {}
    __device__ __forceinline__ void done(const Unit&) const {}
};
template <class Epi>
__device__ __forceinline__ void run_gemm_split(LAS unsigned char* lds, const bf16_t* A, const bf16_t* Bt, int K, const Epi& E) {
    pg8::Gemm g; g.A = A; g.Bt = Bt; g.M = MROWS; g.N = 1024; g.K = K;
    SplitOrder S; S.init((int)gridDim.x, (int)blockIdx.x, K);
    pg8::gemm_phase<Epi, SplitOrder, false>(lds, g, S, E, nullptr);
}
__device__ __forceinline__ void split_fixup(const float* part, int nsplit, const float* xold, float* xnew, bf16_t* xb, float* ssq, float scale, int dry, const float* fin_g) {
    const int tid = tid_opaque(), wave = tid >> 6, lane = tid & 63;
    for (int r = blockIdx.x * 8 + wave; r < 256; r += gridDim.x * 8) {
        const int row = MPROMPT + r; float sq = 0.f; f32x4 v[4];
#pragma unroll
        for (int i = 0; i < 4; ++i) {
            const int col = i * 256 + lane * 4;
            f32x4 a = (f32x4){0.f, 0.f, 0.f, 0.f};
            for (int ks = 0; ks < nsplit; ++ks) a += *(const f32x4*)(part + ((size_t)(ks * 4 + i) * 256 + r) * 256 + lane * 4);
            v[i] = *(const f32x4*)(xold + (size_t)r * DM + col);
            if (!dry) v[i] += a * (f32x4){scale, scale, scale, scale};
            sq += (v[i][0] * v[i][0] + v[i][1] * v[i][1]) + (v[i][2] * v[i][2] + v[i][3] * v[i][3]);
        }
#pragma unroll
        for (int o = 32; o > 0; o >>= 1) sq += __shfl_xor(sq, o);
        const float rs = rsqrtf(sq * (1.0f / 1024.0f) + 1e-6f);
#pragma unroll
        for (int i = 0; i < 4; ++i) {
            const int col = i * 256 + lane * 4;
            if (fin_g) v[i] = v[i] * rs * *(const f32x4*)(fin_g + col);
            *(f32x4*)(xnew + (size_t)row * DM + col) = v[i];
            if (xb) { u32x2 w; w.x = cvt_pk_bf16(v[i][0], v[i][1]); w.y = cvt_pk_bf16(v[i][2], v[i][3]); *(u32x2*)(xb + (size_t)row * DM + col) = w; }
        }
        if (lane < 16) ssq[(size_t)lane * MROWS + row] = lane == 0 ? sq : 0.f;
    }
}
struct CvtJob { const float* src; const float* gain; bf16_t* dst; int ldsrc, nvalid, k0, ns0, K, nd0; };
__device__ __forceinline__ void cvt_decode(const Params& p, int tidx, CvtJob& J) {
    if (tidx < 2816) {
        const int f = tidx / 1408, r = tidx % 1408, nb = r / 16, kb = r % 16, pn = nb >> 2, bj = (nb >> 1) & 1, h = nb & 1;
        J.src = f == 0 ? (bj ? p.in[7] : p.in[6]) : (bj ? p.in[28] : p.in[27]); J.gain = f == 0 ? nullptr : p.in[26]; J.dst = (bf16_t*)(p.ws + (f == 0 ? WS_W1GU : WS_W2GU));
        J.ldsrc = FF; J.nvalid = FF; J.k0 = kb * 64; J.ns0 = pn * 128 + h * 64; J.K = 1024; J.nd0 = nb * 64;
    } else if (tidx < 4224) {
        const int f = (tidx - 2816) / 704, r = (tidx - 2816) % 704, nb = r / 44, kb = r % 44;
        J.src = f == 0 ? p.in[8] : p.in[29]; J.gain = nullptr; J.dst = (bf16_t*)(p.ws + (f == 0 ? WS_W1D : WS_W2D)); J.ldsrc = 1024; J.nvalid = 1024; J.k0 = kb * 64; J.ns0 = nb * 64; J.K = FF; J.nd0 = nb * 64;
    } else if (tidx < 5056) {
        const int r = tidx - 4224, nb = r / 16, kb = r % 16;
        J.src = p.in[10]; J.gain = p.in[9]; J.dst = (bf16_t*)(p.ws + WS_WIN); J.ldsrc = NIN; J.nvalid = NIN; J.k0 = kb * 64; J.ns0 = nb * 64; J.K = 1024; J.nd0 = nb * 64;
    } else {
        const int r = tidx - 5056, nb = r / 16, kb = r % 16;
        J.src = p.in[25]; J.gain = nullptr; J.dst = (bf16_t*)(p.ws + WS_WOUT); J.ldsrc = 1024; J.nvalid = 1024; J.k0 = kb * 64; J.ns0 = nb * 64; J.K = 1024; J.nd0 = nb * 64;
    }
}
__device__ __forceinline__ int cvt_remap(int i, int late) {
    if (late == 2) return i;
    if (!late) return i < 1408 ? i : (i < 2112 ? i + 1408 : i + 2112);
    return i < 1408 ? i + 1408 : (i < 2112 ? i + 2112 : i + 2944);
}
__device__ __forceinline__ void phase_convert(const Params& p, LAS unsigned char* lds, int late, int wb, int nb) {
    LAS float* tiles = (LAS float*)lds;
    bf16_t* ws16 = (bf16_t*)p.ws;
    const int t = tid_opaque(), ntiles = late == 2 ? 5312 : (late ? 2368 : 2944);
    for (int base = wb; base < ntiles; base += 4 * nb) {
        f32x4 v[4][2]; float gq[4][2];
#pragma unroll
        for (int u = 0; u < 4; ++u) {
            const int tidx = base + u * nb;
            if (tidx < ntiles) { CvtJob J; cvt_decode(p, cvt_remap(tidx, late), J);
#pragma unroll
                for (int h = 0; h < 2; ++h) { const int i = (t >> 4) + h * 32, j4 = (t & 15) * 4;
                    v[u][h] = (f32x4){0.f, 0.f, 0.f, 0.f};
                    if (J.ns0 + j4 < J.nvalid) v[u][h] = *(const f32x4*)(J.src + (size_t)(J.k0 + i) * J.ldsrc + J.ns0 + j4);
                    gq[u][h] = J.gain ? J.gain[J.k0 + i] : 1.0f; } }
        }
#pragma unroll
        for (int u = 0; u < 4; ++u)
            if (base + u * nb < ntiles) {
#pragma unroll
                for (int h = 0; h < 2; ++h) { const int i = (t >> 4) + h * 32, j4 = (t & 15) * 4;
#pragma unroll
                    for (int e = 0; e < 4; ++e) tiles[u * 4160 + i * 65 + j4 + e] = v[u][h][e] * gq[u][h]; } }
        __syncthreads();
#pragma unroll
        for (int u = 0; u < 4; ++u) {
            const int tidx = base + u * nb;
            if (tidx < ntiles) { CvtJob J; cvt_decode(p, cvt_remap(tidx, late), J);
                const int j = t >> 3, ks = (t & 7) * 8; float a[8];
#pragma unroll
                for (int e = 0; e < 8; ++e) a[e] = tiles[u * 4160 + (ks + e) * 65 + j];
                u32x4 w; w.x = cvt_pk_bf16(a[0], a[1]); w.y = cvt_pk_bf16(a[2], a[3]); w.z = cvt_pk_bf16(a[4], a[5]); w.w = cvt_pk_bf16(a[6], a[7]);
                *(u32x4*)(J.dst + (size_t)(J.nd0 + j) * J.K + J.k0 + ks) = w; }
        }
        __syncthreads();
    }
    (void)ws16;
    if (late == 1) return;
    const int tid = tid_opaque(), wave = tid >> 6, lane = tid & 63;
    float* ssq0 = (float*)(p.ws + WS_SSQ);
    bf16_t* hb = (bf16_t*)(p.ws + WS_HB);
    for (int row = blockIdx.x * 8 + wave; row < MROWS; row += gridDim.x * 8) {
        const float* x = row < MPROMPT ? p.in[0] + (size_t)row * DM : p.in[1] + (size_t)(row - MPROMPT) * DM;
        float sq = 0.f; f32x4 v[4];
#pragma unroll
        for (int i = 0; i < 4; ++i) { v[i] = *(const f32x4*)(x + i * 256 + lane * 4); sq += (v[i][0] * v[i][0] + v[i][1] * v[i][1]) + (v[i][2] * v[i][2] + v[i][3] * v[i][3]); }
#pragma unroll
        for (int o = 32; o > 0; o >>= 1) sq += __shfl_xor(sq, o);
        const float rs = rsqrtf(sq * (1.0f / 1024.0f) + 1e-6f);
#pragma unroll
        for (int i = 0; i < 4; ++i) {
            const f32x4 h = v[i] * rs * *(const f32x4*)(p.in[5] + i * 256 + lane * 4);
            u32x2 w; w.x = cvt_pk_bf16(h[0], h[1]); w.y = cvt_pk_bf16(h[2], h[3]);
            *(u32x2*)(hb + (size_t)row * DM + i * 256 + lane * 4) = w;
        }
    }
}
__device__ __forceinline__ void phase_final_norm(const Params& p, int dry) {
    const int tid = tid_opaque(), wave = tid >> 6, lane = tid & 63;
    const float* ssq3 = (const float*)(p.ws + WS_SSQ + 3 * SSQ_BYTES);
    const float* g = p.in[30];
    for (int row = blockIdx.x * 8 + wave; row < MPROMPT; row += gridDim.x * 8) {
        const float rs = rstd_of(ssq3, 16, row);
        float* x = p.out + (size_t)row * DM;
#pragma unroll
        for (int i = 0; i < 4; ++i) {
            const f32x4 v = *(const f32x4*)(x + i * 256 + lane * 4), gg = *(const f32x4*)(g + i * 256 + lane * 4);
            *(f32x4*)(x + i * 256 + lane * 4) = dry ? v : v * rs * gg;
        }
    }
}
__device__ __forceinline__ float bf2f(bf16_t b) { return __uint_as_float(((unsigned)b) << 16); }
__device__ __forceinline__ float quad_sum(float x) {
    x += __int_as_float(__builtin_amdgcn_update_dpp(0, __float_as_int(x), 0xB1, 0xF, 0xF, true));
    x += __int_as_float(__builtin_amdgcn_update_dpp(0, __float_as_int(x), 0x4E, 0xF, 0xF, true));
    return x;
}
__device__ __forceinline__ float wave_sum(float x) {
    x += __int_as_float(__builtin_amdgcn_update_dpp(0, __float_as_int(x), 0xB1, 0xF, 0xF, true));
    x += __int_as_float(__builtin_amdgcn_update_dpp(0, __float_as_int(x), 0x4E, 0xF, 0xF, true));
    x += __int_as_float(__builtin_amdgcn_update_dpp(0, __float_as_int(x), 0x124, 0xF, 0xF, true));
    x += __int_as_float(__builtin_amdgcn_update_dpp(0, __float_as_int(x), 0x128, 0xF, 0xF, true));
    const int xi = __float_as_int(x);
    return (__int_as_float(__builtin_amdgcn_readlane(xi, 0)) + __int_as_float(__builtin_amdgcn_readlane(xi, 16))) + (__int_as_float(__builtin_amdgcn_readlane(xi, 32)) + __int_as_float(__builtin_amdgcn_readlane(xi, 48)));
}
__device__ __forceinline__ float softplusf_(float x) { return fmaxf(x, 0.f) + __logf(1.0f + __expf(-fabsf(x))); }
__device__ __forceinline__ float tanhf_(float x) { return 1.0f - 2.0f * __builtin_amdgcn_rcpf(1.0f + __expf(2.0f * x)); }
__device__ __forceinline__ f32x2 lo2(f32x4 v) { return __builtin_shufflevector(v, v, 0, 1); }
__device__ __forceinline__ f32x2 hi2(f32x4 v) { return __builtin_shufflevector(v, v, 2, 3); }
__device__ __forceinline__ f32x2 bc2(float x) { return (f32x2){x, x}; }

struct Seg { int row0, nsteps, prevkind; const float* prevptr; };
__device__ __forceinline__ float seg_prev0(const bf16_t* P, const Seg& sg, int col) {
    float prev = 0.f;
    if (sg.prevkind == 1) prev = bf2f(P[(size_t)(sg.row0 - 1) * NIN + col]);
    else if (sg.prevkind == 2) prev = sg.prevptr[col];
    return prev;
}
__device__ __forceinline__ float xs_lerp(const bf16_t* P, const Seg& sg, int i, int col, float mu, float prev0) {
    const float cur = bf2f(P[(size_t)(sg.row0 + i) * NIN + col]);
    const float pr = bf2f(P[(size_t)(sg.row0 + (i > 0 ? i - 1 : 0)) * NIN + col]);
    const float prev = i == 0 ? prev0 : pr;
    return cur + (prev - cur) * mu;
}
__device__ __forceinline__ void load16(const LAS float* src, f32x2 (&d)[8]) {
    const LAS f32x4* s4 = (const LAS f32x4*)src;
#pragma unroll
    for (int i = 0; i < 4; ++i) { const f32x4 v = s4[i]; d[2 * i] = lo2(v); d[2 * i + 1] = hi2(v); }
}

constexpr int RST = 384;
__device__ __forceinline__ void rwkv_a_task(const Params& p, LAS unsigned char* lds, int tk, int mode) {
    const int tid = tid_opaque(), wave = tid >> 6, lane = tid & 63;
    const bf16_t* P = (const bf16_t*)(p.ws + WS_PACT);
    Seg sg; int ci, g;
    if (tk < 256) { const int c = tk >> 1; g = tk & 1; sg.row0 = c * 128; sg.nsteps = 128; sg.prevkind = c == 0 ? 0 : 1; sg.prevptr = nullptr; ci = c; }
    else { const int b = (tk - 256) >> 1; g = (tk - 256) & 1; sg.row0 = MPROMPT + b * 16; sg.nsteps = 16; sg.prevkind = 2; sg.prevptr = p.in[2] + (size_t)b * ACOLS; ci = 128 + b; }
    LAS float* stage = (LAS float*)lds;
    LAS float* bcs = (LAS float*)(lds + 98304) + wave * 512;
    const float* mu = p.in[11];
    const int phl = wave & 3, ptb = (wave >> 2) * 8, hd = g * 4 + phl, C = hd * 64 + lane;
    const float mu_r = mu[C], mu_k = mu[512 + C], mu_v = mu[1024 + C], mu_x = mu[1536 + lane];
    const float w0c = p.in[12][C], a0c = p.in[14][C], kkc = p.in[17][C], kac = p.in[18][C], rkc = p.in[19][C];
    const float pv_r = seg_prev0(P, sg, C), pv_k = seg_prev0(P, sg, 512 + C), pv_v = seg_prev0(P, sg, 1024 + C), pv_x = seg_prev0(P, sg, 1536 + lane);
    const float* wup = p.in[13] + C; const float* aup = p.in[15] + C;
    float* bonus = (float*)(p.ws + WS_BONUS);
    const bool isH = wave >= 4; const int rhd = g * 4 + (wave & 3), rg = lane >> 2, ks = lane & 3;
    f32x2 s[4][8];
#pragma unroll
    for (int r = 0; r < 4; ++r)
#pragma unroll
        for (int j = 0; j < 8; ++j) { s[r][j].x = (!isH && (rg * 4 + r == ks * 16 + 2 * j)) ? 1.f : 0.f; s[r][j].y = (!isH && (rg * 4 + r == ks * 16 + 2 * j + 1)) ? 1.f : 0.f; }
    bf16_t* Yb = (bf16_t*)(p.ws + WS_Y); bf16_t* HB = (bf16_t*)(p.ws + WS_HB);
    bf16_t raw[9][4];
#define RW_LOAD(sbn) do { _Pragma("unroll") for (int i = 0; i < 9; ++i) { const int ti_ = (sbn) * 16 + ptb + i - 1; const bf16_t* rp_ = P + (size_t)(sg.row0 + (ti_ < 0 ? 0 : ti_)) * NIN; \
        raw[i][0] = rp_[C]; raw[i][1] = rp_[512 + C]; raw[i][2] = rp_[1024 + C]; raw[i][3] = rp_[1536 + lane]; } } while (0)
    RW_LOAD(0);
    for (int sb = 0; sb < sg.nsteps / 16; ++sb) {
        if (!(mode & 4)) {
#pragma unroll
            for (int i = 0; i < 8; ++i) { const float cur = bf2f(raw[i + 1][3]), prev = (sb * 16 + ptb + i == 0) ? pv_x : bf2f(raw[i][3]); float xv = cur + (prev - cur) * mu_x; if (lane < 32) xv = tanhf_(xv); bcs[i * 64 + lane] = xv; }
            float wl[8], al[8];
#pragma unroll
            for (int i = 0; i < 8; ++i) { wl[i] = w0c; al[i] = a0c; }
#pragma unroll 2
            for (int j4 = 0; j4 < 8; ++j4) {
                float wu[4], au[4];
#pragma unroll
                for (int e = 0; e < 4; ++e) { wu[e] = wup[(size_t)(j4 * 4 + e) * 512]; au[e] = aup[(size_t)(j4 * 4 + e) * 512]; }
#pragma unroll
                for (int i = 0; i < 8; ++i) {
                    const f32x4 t4 = *(const LAS f32x4*)(bcs + i * 64 + j4 * 4), x4 = *(const LAS f32x4*)(bcs + i * 64 + 32 + j4 * 4);
#pragma unroll
                    for (int e = 0; e < 4; ++e) { wl[i] += t4[e] * wu[e]; al[i] += x4[e] * au[e]; }
                }
            }
            float rr[8], kr[8], vr[8];
#pragma unroll
            for (int i = 0; i < 8; ++i) { const bool f0 = (sb * 16 + ptb + i == 0);
                const float cr = bf2f(raw[i + 1][0]), ck = bf2f(raw[i + 1][1]), cv = bf2f(raw[i + 1][2]);
                const float qr = f0 ? pv_r : bf2f(raw[i][0]), qk = f0 ? pv_k : bf2f(raw[i][1]), qv = f0 ? pv_v : bf2f(raw[i][2]);
                rr[i] = cr + (qr - cr) * mu_r; kr[i] = ck + (qk - ck) * mu_k; vr[i] = cv + (qv - cv) * mu_v; }
#pragma unroll
            for (int i = 0; i < 8; ++i) {
                const int ti = sb * 16 + ptb + i, row = sg.row0 + ti;
                const float r = rr[i], k = kr[i], v = vr[i];
                const float wlog = -softplusf_(-wl[i]) - 0.5f, dec = __expf(-__expf(wlog));
                const float a = sigmoidf_(al[i]);
                float kk = k * kkc; const float n2 = wave_sum(kk * kk); kk = kk / fmaxf(sqrtf(n2), 1e-12f);
                const float kmod = k * (1.0f + (a - 1.0f) * kac), kka = kk * a;
                const float bs = wave_sum(r * kmod * rkc);
                if (lane == 0) bonus[(size_t)row * 8 + hd] = bs;
                LAS float* st = stage + ((ptb + i) * 4 + phl) * RST;
                st[lane] = dec; st[64 + lane] = kk; st[128 + lane] = kka; st[192 + lane] = kmod; st[256 + lane] = r; st[320 + lane] = v;
            }
        }
        __syncthreads();
        if (sb + 1 < sg.nsteps / 16) RW_LOAD(sb + 1);
        if (!(mode & 8)) for (int tl = 0; tl < 16; ++tl) {
            const LAS float* st = stage + (tl * 4 + (wave & 3)) * RST;
            const int row = sg.row0 + sb * 16 + tl;
            f32x2 w2[8], kk2[8], ka2[8], r2[8];
            load16(st + ks * 16, w2); load16(st + 64 + ks * 16, kk2); load16(st + 128 + ks * 16, ka2); load16(st + 256 + ks * 16, r2);
            float sa[4];
#pragma unroll
            for (int r = 0; r < 4; ++r) { f32x2 acc = s[r][0] * kk2[0];
#pragma unroll
                for (int j = 1; j < 8; ++j) acc = s[r][j] * kk2[j] + acc;
                sa[r] = quad_sum(acc.x + acc.y); }
            float yo[4];
            if (!isH) {
#pragma unroll
                for (int r = 0; r < 4; ++r) { const f32x2 nsa = bc2(-sa[r]);
#pragma unroll
                    for (int j = 0; j < 8; ++j) s[r][j] = s[r][j] * w2[j] + nsa * ka2[j]; }
            } else {
                f32x2 km2[8]; load16(st + 192 + ks * 16, km2);
                const f32x4 v4 = *(const LAS f32x4*)(st + 320 + rg * 4);
#pragma unroll
                for (int r = 0; r < 4; ++r) { const f32x2 nsa = bc2(-sa[r]), vv = bc2(v4[r]);
#pragma unroll
                    for (int j = 0; j < 8; ++j) s[r][j] = (s[r][j] * w2[j] + nsa * ka2[j]) + vv * km2[j]; }
            }
#pragma unroll
            for (int r = 0; r < 4; ++r) { f32x2 acc = s[r][0] * r2[0];
#pragma unroll
                for (int j = 1; j < 8; ++j) acc = s[r][j] * r2[j] + acc;
                yo[r] = quad_sum(acc.x + acc.y); }
            if (ks == 0) {
                u32x2 w; w.x = cvt_pk_bf16(yo[0], yo[1]); w.y = cvt_pk_bf16(yo[2], yo[3]);
                if (!isH) *(u32x2*)(Yb + (size_t)row * 512 + rhd * 64 + rg * 4) = w;
                else *(u32x2*)(HB + (size_t)row * 1024 + rhd * 64 + rg * 4) = w;
            }
        }
        __syncthreads();
    }
    if (!isH) {
        bf16_t* Gf = (bf16_t*)(p.ws + WS_G) + (size_t)(ci * 8 + rhd) * 4096;
#pragma unroll
        for (int j = 0; j < 8; ++j)
#pragma unroll
            for (int h = 0; h < 2; ++h) {
                const int jj = 2 * j + h;
                u32x2 w; w.x = cvt_pk_bf16(h ? s[0][j].y : s[0][j].x, h ? s[1][j].y : s[1][j].x); w.y = cvt_pk_bf16(h ? s[2][j].y : s[2][j].x, h ? s[3][j].y : s[3][j].x);
                *(u32x2*)(Gf + (size_t)((ks * 2 + (rg >> 3)) * 64 + (rg & 3) * 16 + jj) * 8 + ((rg >> 2) & 1) * 4) = w;
            }
    } else {
        float* Hs = (float*)(p.ws + WS_HSR) + (size_t)(ci * 8 + rhd) * 4096;
#pragma unroll
        for (int r = 0; r < 4; ++r)
#pragma unroll
            for (int q = 0; q < 4; ++q) *(f32x4*)(Hs + (rg * 4 + r) * 64 + ks * 16 + q * 4) = (f32x4){s[r][2 * q].x, s[r][2 * q].y, s[r][2 * q + 1].x, s[r][2 * q + 1].y};
    }
}

constexpr int GST = 320;
__device__ __forceinline__ void gla_a_task(const Params& p, LAS unsigned char* lds, int tk) {
    const int tid = tid_opaque(), wave = tid >> 6, lane = tid & 63;
    const bf16_t* P = (const bf16_t*)(p.ws + WS_PACT) + BOFF;
    int row0, nsteps, ci;
    if (tk < 256) { row0 = tk * 64; nsteps = 64; ci = tk; } else { row0 = MPROMPT + (tk - 256) * 16; nsteps = 16; ci = tk; }
    LAS float* stage = (LAS float*)lds;
    LAS float* red = (LAS float*)(lds + 98304);
    const int hd = wave >> 1, half = wave & 1, rg = lane >> 2, ks = lane & 3;
    const int kc = hd * 64 + lane;
    float gku[16];
#pragma unroll
    for (int j = 0; j < 16; ++j) gku[j] = p.in[22][j * 256 + kc];
    const float gkb = p.in[23][kc];
    float lsum = 0.f;
    f32x2 s[4][8];
#pragma unroll
    for (int r = 0; r < 4; ++r)
#pragma unroll
        for (int j = 0; j < 8; ++j) s[r][j] = (f32x2){0.f, 0.f};
    bf16_t* HB = (bf16_t*)(p.ws + WS_HB);
    unsigned gxw; bf16_t graw[8][4];
#define GL_LOAD(sbn) do { gxw = *(const unsigned*)(P + (size_t)(row0 + (sbn) * 16 + half * 8 + (lane >> 3)) * NIN + 1024 + (lane & 7) * 2); \
        _Pragma("unroll") for (int i = 0; i < 8; ++i) { const bf16_t* pr_ = P + (size_t)(row0 + (sbn) * 16 + half * 8 + i) * NIN; graw[i][0] = pr_[256 + kc]; graw[i][1] = pr_[kc]; graw[i][2] = pr_[512 + hd * 128 + lane]; graw[i][3] = pr_[512 + hd * 128 + 64 + lane]; } } while (0)
    GL_LOAD(0);
    for (int sb = 0; sb < nsteps / 16; ++sb) {
        {
            LAS float* xg = (LAS float*)(lds + 81920) + wave * 128;
            { const int j2 = (lane & 7) * 2; xg[(lane >> 3) * 16 + j2] = __uint_as_float(gxw << 16); xg[(lane >> 3) * 16 + j2 + 1] = __uint_as_float(gxw & 0xffff0000u); }
            float kv[8], qv[8], v0[8], v1[8]; float bsub = 0.f;
#pragma unroll
            for (int i = 0; i < 8; ++i) { kv[i] = bf2f(graw[i][0]); qv[i] = bf2f(graw[i][1]) * 0.125f; v0[i] = bf2f(graw[i][2]); v1[i] = bf2f(graw[i][3]); }
#pragma unroll
            for (int i = 0; i < 8; ++i) {
                const int tl = half * 8 + i;
                float gl = gkb;
#pragma unroll
                for (int j4 = 0; j4 < 4; ++j4) { const f32x4 x4 = *(const LAS f32x4*)(xg + i * 16 + j4 * 4); gl += x4[0] * gku[j4 * 4] + x4[1] * gku[j4 * 4 + 1] + x4[2] * gku[j4 * 4 + 2] + x4[3] * gku[j4 * 4 + 3]; }
                const float la = -softplusf_(-gl) * (1.0f / 16.0f);
                lsum += la; bsub += la;
                LAS float* st = stage + (tl * 4 + hd) * GST;
                st[lane] = __expf(la); st[64 + lane] = kv[i]; st[128 + lane] = qv[i]; st[192 + lane] = v0[i]; st[256 + lane] = v1[i];
            }
            ((float*)(p.ws + WS_GBS))[(size_t)((((ci * 4 + sb) * 4 + hd) * 2 + half)) * 64 + lane] = bsub;
        }
        __syncthreads();
        if (sb + 1 < nsteps / 16) GL_LOAD(sb + 1);
        for (int tl = 0; tl < 16; ++tl) {
            const LAS float* st = stage + (tl * 4 + hd) * GST;
            const int row = row0 + sb * 16 + tl;
            f32x2 a2[8], k2[8], q2[8];
            load16(st + ks * 16, a2); load16(st + 64 + ks * 16, k2); load16(st + 128 + ks * 16, q2);
            const f32x4 v4 = *(const LAS f32x4*)(st + 192 + half * 64 + rg * 4);
            float zo[4];
#pragma unroll
            for (int r = 0; r < 4; ++r) { const f32x2 vv = bc2(v4[r]); f32x2 acc = (f32x2){0.f, 0.f};
#pragma unroll
                for (int j = 0; j < 8; ++j) { s[r][j] = s[r][j] * a2[j] + vv * k2[j]; acc = s[r][j] * q2[j] + acc; }
                zo[r] = quad_sum(acc.x + acc.y); }
            if (ks == 0) { u32x2 w; w.x = cvt_pk_bf16(zo[0], zo[1]); w.y = cvt_pk_bf16(zo[2], zo[3]);
                *(u32x2*)(HB + (size_t)row * 1024 + 512 + hd * 128 + half * 64 + rg * 4) = w; }
        }
        __syncthreads();
    }
    float* Hs = (float*)(p.ws + WS_HSG) + (size_t)(ci * 4 + hd) * 8192;
#pragma unroll
    for (int j = 0; j < 8; ++j) {
        *(f32x4*)(Hs + (ks * 16 + 2 * j) * 128 + half * 64 + rg * 4) = (f32x4){s[0][j].x, s[1][j].x, s[2][j].x, s[3][j].x};
        *(f32x4*)(Hs + (ks * 16 + 2 * j + 1) * 128 + half * 64 + rg * 4) = (f32x4){s[0][j].y, s[1][j].y, s[2][j].y, s[3][j].y};
    }
    red[wave * 64 + lane] = lsum;
    __syncthreads();
    if (half == 0) ((float*)(p.ws + WS_DECG))[(size_t)(ci * 4 + hd) * 64 + lane] = __expf(red[wave * 64 + lane] + red[(wave + 1) * 64 + lane]);
    __syncthreads();
}
__device__ __forceinline__ bf16x8 pack8(const float (&v)[8]);
typedef short bf16x4 __attribute__((ext_vector_type(4)));
typedef __bf16 bf16v2 __attribute__((ext_vector_type(2)));
__device__ __forceinline__ unsigned cvt_pk_native(float a, float b) { const f32x2 v = (f32x2){a, b}; const bf16v2 r = __builtin_convertvector(v, bf16v2); return __builtin_bit_cast(unsigned, r); }
__device__ __forceinline__ bf16x8 pack4z(float a, float b, float c, float d) { u32x4 w; w.x = cvt_pk_bf16(a, b); w.y = cvt_pk_bf16(c, d); w.z = 0u; w.w = 0u; return __builtin_bit_cast(bf16x8, w); }
__device__ __forceinline__ void gla_a_wave_task(const Params& p, LAS unsigned char* wl8, int ci, int row0, int nblk, int hd, int sel) {
    const int lane = tid_opaque() & 63, n = lane & 15, q = lane >> 4, kc = hd * 64 + lane;
    const bf16_t* P = (const bf16_t*)(p.ws + WS_PACT) + BOFF; bf16_t* HB = (bf16_t*)(p.ws + WS_HB);
    LAS float* XG = (LAS float*)wl8; LAS bf16_t* QT = (LAS bf16_t*)(wl8 + 1024); LAS bf16_t* KT = (LAS bf16_t*)(wl8 + 3328); LAS bf16_t* KTt = (LAS bf16_t*)(wl8 + 5632); LAS float* BETA = (LAS float*)(wl8 + 8704);
    float gku[16];
#pragma unroll
    for (int j = 0; j < 16; ++j) gku[j] = p.in[22][j * 256 + kc];
    const float gkb = p.in[23][kc];
    f32x4 H[4][8];
#pragma unroll
    for (int kt = 0; kt < 4; ++kt)
#pragma unroll
        for (int vt = 0; vt < 8; ++vt) H[kt][vt] = (f32x4){0.f, 0.f, 0.f, 0.f};
    float lsum = 0.f;
    for (int blk = 0; blk < nblk; ++blk) {
        const int rowb = row0 + blk * 16;
        { const int idx = lane * 4, tk = idx >> 4, j = idx & 15;
          const u32x2 xw = *(const u32x2*)(P + (size_t)(rowb + tk) * NIN + 1024 + j);
          *(LAS f32x4*)(XG + idx) = (f32x4){__uint_as_float(xw.x << 16), __uint_as_float(xw.x & 0xffff0000u), __uint_as_float(xw.y << 16), __uint_as_float(xw.y & 0xffff0000u)}; }
        unsigned qkr[16];
#pragma unroll
        for (int i = 0; i < 16; ++i) { const bf16_t* pr = P + (size_t)(rowb + i) * NIN; qkr[i] = (unsigned)pr[kc] | ((unsigned)pr[256 + kc] << 16); }
        float bsub = 0.f;
#pragma unroll
        for (int i = 0; i < 16; ++i) {
            float gl = gkb;
#pragma unroll
            for (int j4 = 0; j4 < 4; ++j4) { const f32x4 x4 = *(const LAS f32x4*)(XG + i * 16 + j4 * 4); gl += x4[0] * gku[j4 * 4] + x4[1] * gku[j4 * 4 + 1] + x4[2] * gku[j4 * 4 + 2] + x4[3] * gku[j4 * 4 + 3]; }
            bsub += -softplusf_(-gl) * (1.0f / 16.0f);
            const unsigned qk = cvt_pk_bf16(__uint_as_float(qkr[i] << 16) * 0.125f * __expf(bsub), __uint_as_float(qkr[i] & 0xffff0000u) * __expf(-bsub));
            QT[i * 72 + lane] = (bf16_t)(qk & 0xffffu); KT[i * 72 + lane] = (bf16_t)(qk >> 16); KTt[lane * 24 + i] = (bf16_t)(qk >> 16);
        }
        BETA[lane] = __expf(bsub); lsum += bsub;
        asm volatile("" ::: "memory");
        if (sel & 4) { float* gb = (float*)(p.ws + WS_GBS) + (size_t)(((ci * 4 + blk) * 4 + hd) * 2) * 64 + lane; gb[0] = bsub; gb[64] = 0.f; }
        u32x2 VP[8];
#pragma unroll
        for (int vt = 0; vt < 8; ++vt) { const bf16_t* vp = P + (size_t)(rowb + 4 * q) * NIN + 512 + hd * 128 + vt * 16 + n;
            VP[vt].x = (unsigned)vp[0] | ((unsigned)vp[NIN] << 16); VP[vt].y = (unsigned)vp[2 * NIN] | ((unsigned)vp[3 * NIN] << 16); }
#define VF(vt) __builtin_bit_cast(bf16x8, (u32x4){VP[vt].x, VP[vt].y, 0u, 0u})
        f32x4 sc = (f32x4){0.f, 0.f, 0.f, 0.f};
#pragma unroll
        for (int kh = 0; kh < 2; ++kh) sc = __builtin_amdgcn_mfma_f32_16x16x32_bf16(*(const LAS bf16x8*)(KT + n * 72 + kh * 32 + q * 8), *(const LAS bf16x8*)(QT + n * 72 + kh * 32 + q * 8), sc, 0, 0, 0);
        const bf16x8 SCB = pack4z(4 * q + 0 <= n ? sc[0] : 0.f, 4 * q + 1 <= n ? sc[1] : 0.f, 4 * q + 2 <= n ? sc[2] : 0.f, 4 * q + 3 <= n ? sc[3] : 0.f);
        bf16x8 QB[2];
#pragma unroll
        for (int kh = 0; kh < 2; ++kh) { const u32x2 a = __builtin_bit_cast(u32x2, *(const LAS bf16x4*)(QT + n * 72 + kh * 32 + 4 * q)), b = __builtin_bit_cast(u32x2, *(const LAS bf16x4*)(QT + n * 72 + kh * 32 + 16 + 4 * q));
            u32x4 w; w.x = a.x; w.y = a.y; w.z = b.x; w.w = b.y; QB[kh] = __builtin_bit_cast(bf16x8, w); }
#pragma unroll
        for (int vt = 0; vt < 8; ++vt) {
            f32x4 z = (f32x4){0.f, 0.f, 0.f, 0.f};
#pragma unroll
            for (int kh = 0; kh < 2; ++kh) { const float hv[8] = {H[2 * kh][vt][0], H[2 * kh][vt][1], H[2 * kh][vt][2], H[2 * kh][vt][3], H[2 * kh + 1][vt][0], H[2 * kh + 1][vt][1], H[2 * kh + 1][vt][2], H[2 * kh + 1][vt][3]};
                z = __builtin_amdgcn_mfma_f32_16x16x32_bf16(pack8(hv), QB[kh], z, 0, 0, 0); }
            z = __builtin_amdgcn_mfma_f32_16x16x32_bf16(VF(vt), SCB, z, 0, 0, 0);
            u32x2 w; w.x = cvt_pk_native(z[0], z[1]); w.y = cvt_pk_native(z[2], z[3]);
            if (sel & 1) *(u32x2*)(HB + (size_t)(rowb + n) * 1024 + 512 + hd * 128 + vt * 16 + 4 * q) = w;
        }
#pragma unroll
        for (int kt = 0; kt < 4; ++kt) {
            const u32x2 ka = __builtin_bit_cast(u32x2, *(const LAS bf16x4*)(KTt + (kt * 16 + n) * 24 + 4 * q));
            u32x4 kw; kw.x = ka.x; kw.y = ka.y; kw.z = 0u; kw.w = 0u; const bf16x8 KA = __builtin_bit_cast(bf16x8, kw);
            const f32x4 b4 = *(const LAS f32x4*)(BETA + kt * 16 + 4 * q);
#pragma unroll
            for (int vt = 0; vt < 8; ++vt) H[kt][vt] = __builtin_amdgcn_mfma_f32_16x16x32_bf16(KA, VF(vt), H[kt][vt], 0, 0, 0) * b4;
        }
    }
#undef VF
    float* Hs = (float*)(p.ws + WS_HSG) + (size_t)(ci * 4 + hd) * 8192;
#pragma unroll
    for (int kt = 0; kt < 4; ++kt)
#pragma unroll
        for (int vt = 0; vt < 8; ++vt)
#pragma unroll
            for (int i = 0; i < 4; ++i) if (sel & 2) Hs[(kt * 16 + 4 * q + i) * 128 + vt * 16 + n] = H[kt][vt][i];
    if (sel & 4) ((float*)(p.ws + WS_DECG))[(size_t)(ci * 4 + hd) * 64 + lane] = __expf(lsum);
}
__device__ __forceinline__ void phase_mix_a2(const Params& p, LAS unsigned char* lds, int sel) {
    const int wave = tid_opaque() >> 6, skip = gridDim.x >= 64 ? 32 : 0, ng = (int)gridDim.x - skip, nw = ng * 8;
    if ((int)blockIdx.x >= skip) for (int j = wave * ng + ((int)blockIdx.x - skip); j < 1088; j += nw) {
        int ci, row0, nblk, hd;
        if (j < 1024) { ci = j >> 2; row0 = ci * 64; nblk = 4; hd = j & 3; }
        else { const int r = j - 1024, sb = r >> 2; ci = 256 + sb; row0 = MPROMPT + sb * 16; nblk = 1; hd = r & 3; }
        gla_a_wave_task(p, lds + wave * 16384, ci, row0, nblk, hd, sel);
    }
}
__device__ __forceinline__ void phase_mix_a(const Params& p, LAS unsigned char* lds, int mask) {
    if (mask & 1) for (int t = blockIdx.x; t < 288; t += gridDim.x) rwkv_a_task(p, lds, t, mask);
    if (mask & 2) phase_mix_a2(p, lds, 7);
}

__device__ __forceinline__ void rwkv_scan_job(const Params& p, int head, int vt, int ci0, int nchunks, const float* S0, float* Sout, int dry) {
    const int lane = tid_opaque() & 63, n = lane & 15, q = lane >> 4, v = vt * 16 + n;
    f32x4 D[4];
#pragma unroll
    for (int jt = 0; jt < 4; ++jt) D[jt] = S0 ? *(const f32x4*)(S0 + v * 64 + jt * 16 + q * 4) : (f32x4){0.f, 0.f, 0.f, 0.f};
    for (int c = 0; c < nchunks; ++c) {
        const int ci = ci0 + c;
        float* HS = (float*)(p.ws + WS_HSR) + (size_t)(ci * 8 + head) * 4096;
        const bf16x8* Gf = (const bf16x8*)(p.ws + WS_G + (size_t)(ci * 8 + head) * 8192);
        f32x4 Hc[4]; bf16x8 A[4][2];
#pragma unroll
        for (int jt = 0; jt < 4; ++jt) { Hc[jt] = *(const f32x4*)(HS + v * 64 + jt * 16 + q * 4); A[jt][0] = Gf[(jt * 2 + 0) * 64 + lane]; A[jt][1] = Gf[(jt * 2 + 1) * 64 + lane]; }
#pragma unroll
        for (int jt = 0; jt < 4; ++jt) *(f32x4*)(HS + v * 64 + jt * 16 + q * 4) = dry ? Hc[jt] : D[jt];
        bf16x8 B[2];
#pragma unroll
        for (int kh = 0; kh < 2; ++kh) { u32x4 w; w.x = cvt_pk_native(D[2 * kh][0], D[2 * kh][1]); w.y = cvt_pk_native(D[2 * kh][2], D[2 * kh][3]);
            w.z = cvt_pk_native(D[2 * kh + 1][0], D[2 * kh + 1][1]); w.w = cvt_pk_native(D[2 * kh + 1][2], D[2 * kh + 1][3]); B[kh] = __builtin_bit_cast(bf16x8, w); }
#pragma unroll
        for (int jt = 0; jt < 4; ++jt) { f32x4 d = __builtin_amdgcn_mfma_f32_16x16x32_bf16(A[jt][0], B[0], Hc[jt], 0, 0, 0); D[jt] = __builtin_amdgcn_mfma_f32_16x16x32_bf16(A[jt][1], B[1], d, 0, 0, 0); }
    }
#pragma unroll
    for (int jt = 0; jt < 4; ++jt) *(f32x4*)(Sout + v * 64 + jt * 16 + q * 4) = D[jt];
}
constexpr int SC_SLOT = 12544, SC_NB = 8;
__device__ __forceinline__ void rwkv_scan_prompt(const Params& p, LAS unsigned char* lds, int head, int vt, int dry) {
    const int tid = tid_opaque(), wave = tid >> 6, lane = tid & 63, n = lane & 15, q = lane >> 4, v = vt * 16 + n;
    const unsigned char* Gb = p.ws + WS_G; unsigned char* Hb = p.ws + WS_HSR;
    u32x4 pfA[12], pfB[12];
    unsigned off0[12], hmask = 0u;
#pragma unroll
    for (int i = 0; i < 12; ++i) { const int qd = tid + 512 * i, cl = qd / 768, wi = qd % 768;
        off0[i] = wi < 512 ? (unsigned)(WS_G + (size_t)(cl * 8 + head) * 8192 + wi * 16) : (unsigned)(WS_HSR + ((size_t)(cl * 8 + head) * 4096 + vt * 1024) * 4 + (wi - 512) * 16);
        hmask |= (wi < 512 ? 0u : 1u) << i; }
#define SC_ISSUE(pf, batch) do { _Pragma("unroll") for (int i = 0; i < 12; ++i) { \
        const unsigned o_ = off0[i] + (unsigned)(batch) * ((unsigned)(SC_NB * 8 * 8192) << ((hmask >> i) & 1u)); pf[i] = *(const u32x4*)(p.ws + o_); } } while (0)
#define SC_COMMIT(pf) do { _Pragma("unroll") for (int i = 0; i < 12; ++i) { const int qd = tid + 512 * i, cl = qd / 768, wi = qd % 768; \
        const int dst = cl * SC_SLOT + (wi < 512 ? wi * 16 : 8192 + ((wi - 512) >> 4) * 272 + ((wi - 512) & 15) * 16); *(LAS u32x4*)(lds + dst) = pf[i]; } } while (0)
#define SC_COMPUTE(bb) do { if (wave == 0) { for (int cl = 0; cl < SC_NB; ++cl) { \
                const int ci = (bb) * SC_NB + cl; const LAS unsigned char* sl = lds + cl * SC_SLOT; \
                float* HS = (float*)Hb + (size_t)(ci * 8 + head) * 4096; \
                f32x4 Hc[4]; bf16x8 A[4][2]; \
                _Pragma("unroll") for (int jt = 0; jt < 4; ++jt) { Hc[jt] = *(const LAS f32x4*)(sl + 8192 + n * 272 + (jt * 4 + q) * 16); \
                    A[jt][0] = *(const LAS bf16x8*)(sl + ((jt * 2 + 0) * 64 + lane) * 16); A[jt][1] = *(const LAS bf16x8*)(sl + ((jt * 2 + 1) * 64 + lane) * 16); } \
                _Pragma("unroll") for (int jt = 0; jt < 4; ++jt) *(f32x4*)(HS + v * 64 + jt * 16 + q * 4) = dry ? Hc[jt] : D[jt]; \
                bf16x8 B[2]; \
                _Pragma("unroll") for (int kh = 0; kh < 2; ++kh) { u32x4 w; w.x = cvt_pk_native(D[2 * kh][0], D[2 * kh][1]); w.y = cvt_pk_native(D[2 * kh][2], D[2 * kh][3]); \
                    w.z = cvt_pk_native(D[2 * kh + 1][0], D[2 * kh + 1][1]); w.w = cvt_pk_native(D[2 * kh + 1][2], D[2 * kh + 1][3]); B[kh] = __builtin_bit_cast(bf16x8, w); } \
                _Pragma("unroll") for (int jt = 0; jt < 4; ++jt) { f32x4 d = __builtin_amdgcn_mfma_f32_16x16x32_bf16(A[jt][0], B[0], Hc[jt], 0, 0, 0); D[jt] = __builtin_amdgcn_mfma_f32_16x16x32_bf16(A[jt][1], B[1], d, 0, 0, 0); } \
            } } } while (0)
    f32x4 D[4];
#pragma unroll
    for (int jt = 0; jt < 4; ++jt) D[jt] = (f32x4){0.f, 0.f, 0.f, 0.f};
    constexpr int NBT = 128 / SC_NB;
    SC_ISSUE(pfA, 0); SC_COMMIT(pfA);
    __syncthreads();
    SC_ISSUE(pfA, 1); SC_ISSUE(pfB, 2);
    for (int b = 0; b < NBT; b += 2) {
        SC_COMPUTE(b);
        __syncthreads();
        SC_COMMIT(pfA);
        { const int nb_ = b + 3 < NBT ? b + 3 : NBT - 1; SC_ISSUE(pfA, nb_); }
        __syncthreads();
        SC_COMPUTE(b + 1);
        __syncthreads();
        SC_COMMIT(pfB);
        { const int nb_ = b + 4 < NBT ? b + 4 : NBT - 1; SC_ISSUE(pfB, nb_); }
        __syncthreads();
    }
#undef SC_COMPUTE
    if (wave == 0) {
        float* Sout = p.out + O_WKV_P + (size_t)head * 4096;
#pragma unroll
        for (int jt = 0; jt < 4; ++jt) *(f32x4*)(Sout + v * 64 + jt * 16 + q * 4) = D[jt];
    }
#undef SC_ISSUE
#undef SC_COMMIT
}
__device__ __forceinline__ void phase_scan(const Params& p, LAS unsigned char* lds, int dry) {
    const int tid = tid_opaque(), wave = tid >> 6, b = blockIdx.x;
    float* HSG = (float*)(p.ws + WS_HSG); const float* DEC = (const float*)(p.ws + WS_DECG);
    if (b < 32) rwkv_scan_prompt(p, lds, b >> 2, b & 3, dry);
    else if (b < 96) {
        const int e = (b - 32) * 512 + tid, hd = e >> 13, k = (e >> 7) & 63;
        float S = 0.f;
        for (int c = 0; c < 256; c += 32) {
            float t[32], d[32];
#pragma unroll
            for (int u = 0; u < 32; ++u) { t[u] = HSG[(size_t)(c + u) * 32768 + e]; d[u] = DEC[(size_t)((c + u) * 4 + hd) * 64 + k]; }
#pragma unroll
            for (int u = 0; u < 32; ++u) { HSG[(size_t)(c + u) * 32768 + e] = dry ? t[u] : S; S = S * d[u] + t[u]; }
        }
        p.out[O_GLA_P + e] = S;
    } else {
        const int nb = gridDim.x - 96, bb = b - 96;
        for (int j = bb * 8 + wave; j < 512; j += nb * 8) { const int sb = j >> 5, hd = (j >> 2) & 7, vt = j & 3;
            rwkv_scan_job(p, hd, vt, 128 + sb, 1, p.in[3] + (size_t)(sb * 8 + hd) * 4096, p.out + O_WKV_S + (size_t)(sb * 8 + hd) * 4096, dry); }
        for (int i = bb * 512 + tid; i < 16 * 8192; i += nb * 512) { const int sb = i >> 13, e = (i & 8191) * 4, hd = e >> 13, k = (e >> 7) & 63;
            const f32x4 S0 = *(const f32x4*)(p.in[4] + (size_t)sb * 32768 + e); float* hp = HSG + (size_t)(256 + sb) * 32768 + e;
            const f32x4 t = *(const f32x4*)hp; const float d = DEC[(size_t)((256 + sb) * 4 + hd) * 64 + k];
            *(f32x4*)hp = dry ? t : S0; *(f32x4*)(p.out + O_GLA_S + (size_t)sb * 32768 + e) = S0 * d + t; }
    }
}

struct RwkvCConst { bf16x8 GB[4][2]; float lw[4], lb[4], muv[4]; float mug[16]; };
__device__ __forceinline__ float row16_sum(float x) {
    x += __int_as_float(__builtin_amdgcn_update_dpp(0, __float_as_int(x), 0xB1, 0xF, 0xF, true));
    x += __int_as_float(__builtin_amdgcn_update_dpp(0, __float_as_int(x), 0x4E, 0xF, 0xF, true));
    x += __int_as_float(__builtin_amdgcn_update_dpp(0, __float_as_int(x), 0x124, 0xF, 0xF, true));
    x += __int_as_float(__builtin_amdgcn_update_dpp(0, __float_as_int(x), 0x128, 0xF, 0xF, true));
    return x;
}
__device__ __forceinline__ bf16x8 pack8(const float (&v)[8]) {
    u32x4 w; w.x = cvt_pk_bf16(v[0], v[1]); w.y = cvt_pk_bf16(v[2], v[3]); w.z = cvt_pk_bf16(v[4], v[5]); w.w = cvt_pk_bf16(v[6], v[7]); return __builtin_bit_cast(bf16x8, w);
}
__device__ __forceinline__ void unpack8(u32x4 w, float (&v)[8]) {
    v[0] = __uint_as_float(w.x << 16); v[1] = __uint_as_float(w.x & 0xffff0000u); v[2] = __uint_as_float(w.y << 16); v[3] = __uint_as_float(w.y & 0xffff0000u);
    v[4] = __uint_as_float(w.z << 16); v[5] = __uint_as_float(w.z & 0xffff0000u); v[6] = __uint_as_float(w.w << 16); v[7] = __uint_as_float(w.w & 0xffff0000u);
}
__device__ __forceinline__ void rwkv_c_const(const Params& p, int hd, RwkvCConst& K) {
    const int lane = tid_opaque() & 63, n = lane & 15, q = lane >> 4;
#pragma unroll
    for (int nt = 0; nt < 4; ++nt) {
        const int C = hd * 64 + nt * 16 + n;
        K.lw[nt] = p.in[20][C]; K.lb[nt] = p.in[21][C]; K.muv[nt] = p.in[11][1024 + C];
#pragma unroll
        for (int kh = 0; kh < 2; ++kh) { float g[8];
#pragma unroll
            for (int e = 0; e < 8; ++e) g[e] = p.in[16][(size_t)(kh * 32 + q * 8 + e) * 512 + C];
            K.GB[nt][kh] = pack8(g); }
    }
#pragma unroll
    for (int kh = 0; kh < 2; ++kh)
#pragma unroll
        for (int e = 0; e < 8; ++e) K.mug[kh * 8 + e] = p.in[11][1600 + kh * 32 + q * 8 + e];
}
__device__ __forceinline__ void rwkv_c_task(const Params& p, const RwkvCConst& K, int ci, int tok0, int hd, const Seg& sg, int dry) {
    const int lane = tid_opaque() & 63, n = lane & 15, q = lane >> 4;
    const bf16_t* P = (const bf16_t*)(p.ws + WS_PACT);
    const bf16_t* Yb = (const bf16_t*)(p.ws + WS_Y); bf16_t* HB = (bf16_t*)(p.ws + WS_HB);
    const float* Ss = (const float*)(p.ws + WS_HSR) + (size_t)(ci * 8 + hd) * 4096;
    const float* bonus = (const float*)(p.ws + WS_BONUS);
    const int rowb = sg.row0 + tok0;
    bf16x8 SB[4][2]; float bo[4]; bf16_t zr[4][4], cr_[4][4]; float pv0[4];
#pragma unroll
    for (int nt = 0; nt < 4; ++nt)
#pragma unroll
        for (int kh = 0; kh < 2; ++kh) {
            const float* sp = Ss + (nt * 16 + n) * 64 + kh * 32 + q * 8;
            const f32x4 s0 = *(const f32x4*)sp, s1 = *(const f32x4*)(sp + 4);
            const float sv[8] = {s0[0], s0[1], s0[2], s0[3], s1[0], s1[1], s1[2], s1[3]};
            SB[nt][kh] = pack8(sv);
        }
#pragma unroll
    for (int i = 0; i < 4; ++i) bo[i] = bonus[(size_t)(rowb + q * 4 + i) * 8 + hd];
#pragma unroll
    for (int nt = 0; nt < 4; ++nt) {
        const int C = hd * 64 + nt * 16 + n;
        const bool first = (tok0 + q * 4 == 0) && sg.prevkind != 1;
        pv0[nt] = bf2f(P[(size_t)(rowb + q * 4 - (first ? 0 : 1)) * NIN + 1024 + C]);
        if (first) pv0[nt] = sg.prevkind == 2 ? sg.prevptr[1024 + C] : 0.f;
#pragma unroll
        for (int i = 0; i < 4; ++i) { const int row = rowb + q * 4 + i; zr[nt][i] = HB[(size_t)row * 1024 + C]; cr_[nt][i] = P[(size_t)row * NIN + 1024 + C]; }
    }
    bf16x8 AY[2], AG[2];
    {
        const bool first = (tok0 + n == 0) && sg.prevkind != 1;
        const bf16_t* cr = P + (size_t)(rowb + n) * NIN + 1600 + q * 8;
        const bf16_t* pr = P + (size_t)(rowb + n - (first ? 0 : 1)) * NIN + 1600 + q * 8;
#pragma unroll
        for (int kh = 0; kh < 2; ++kh) {
            AY[kh] = *(const bf16x8*)(Yb + (size_t)(rowb + n) * 512 + hd * 64 + kh * 32 + q * 8);
            float c8[8], p8[8];
            unpack8(*(const u32x4*)(cr + kh * 32), c8); unpack8(*(const u32x4*)(pr + kh * 32), p8);
            if (first) {
#pragma unroll
                for (int e = 0; e < 8; ++e) p8[e] = sg.prevkind == 2 ? sg.prevptr[1600 + kh * 32 + q * 8 + e] : 0.f;
            }
#pragma unroll
            for (int e = 0; e < 8; ++e) c8[e] = sigmoidf_(c8[e] + (p8[e] - c8[e]) * K.mug[kh * 8 + e]);
            AG[kh] = pack8(c8);
        }
    }
    f32x4 D[4], G[4];
#pragma unroll
    for (int nt = 0; nt < 4; ++nt) {
        f32x4 d = (f32x4){0.f, 0.f, 0.f, 0.f}, g = (f32x4){0.f, 0.f, 0.f, 0.f};
#pragma unroll
        for (int kh = 0; kh < 2; ++kh) {
            d = __builtin_amdgcn_mfma_f32_16x16x32_bf16(AY[kh], SB[nt][kh], d, 0, 0, 0);
            g = __builtin_amdgcn_mfma_f32_16x16x32_bf16(AG[kh], K.GB[nt][kh], g, 0, 0, 0);
        }
        D[nt] = d; G[nt] = g;
    }
    float o[4][4], vv[4][4];
#pragma unroll
    for (int nt = 0; nt < 4; ++nt) {
        float pv = pv0[nt];
#pragma unroll
        for (int i = 0; i < 4; ++i) {
            o[nt][i] = D[nt][i] + bf2f(zr[nt][i]);
            const float cv = bf2f(cr_[nt][i]);
            vv[nt][i] = cv + (pv - cv) * K.muv[nt]; pv = cv;
        }
    }
#pragma unroll
    for (int i = 0; i < 4; ++i) {
        const float mean = row16_sum((o[0][i] + o[1][i]) + (o[2][i] + o[3][i])) * (1.0f / 64.0f);
        float d2 = 0.f;
#pragma unroll
        for (int nt = 0; nt < 4; ++nt) { o[nt][i] -= mean; d2 += o[nt][i] * o[nt][i]; }
        const float rs = rsqrtf(row16_sum(d2) * (1.0f / 64.0f) + 64e-5f);
#pragma unroll
        for (int nt = 0; nt < 4; ++nt) {
            const int C = hd * 64 + nt * 16 + n;
            const float res = (o[nt][i] * rs * K.lw[nt] + K.lb[nt] + bo[i] * vv[nt][i]) * G[nt][i];
            const unsigned rb = cvt_pk_bf16(res, 0.f);
            bf16_t* dp = dry ? (bf16_t*)(p.ws + WS_DUMMY) + (size_t)blockIdx.x * 512 + threadIdx.x : HB + (size_t)(rowb + q * 4 + i) * 1024 + C;
            *dp = (bf16_t)(rb & 0xffffu);
        }
    }
}
__device__ __forceinline__ void gla_c_task(const Params& p, LAS float* wl, int ci, int row0, int rd, int hd, int dry) {
    const int lane = tid_opaque() & 63, n = lane & 15, q = lane >> 4, kc = hd * 64 + lane;
    const bf16_t* P = (const bf16_t*)(p.ws + WS_PACT) + BOFF; bf16_t* HB = (bf16_t*)(p.ws + WS_HB);
    const float* Ss = (const float*)(p.ws + WS_HSG) + (size_t)(ci * 4 + hd) * 8192;
    LAS float* XG = wl; LAS bf16_t* QT = (LAS bf16_t*)(wl + 256);
    const int rowb = row0 + rd * 16;
    float gku[16];
#pragma unroll
    for (int j = 0; j < 16; ++j) gku[j] = p.in[22][j * 256 + kc];
    const float gkb = p.in[23][kc];
    float bsum = 0.f;
    for (int sb = 0; sb < rd; ++sb) { const float* g = (const float*)(p.ws + WS_GBS) + (size_t)(((ci * 4 + sb) * 4 + hd) * 2) * 64 + lane; bsum += g[0]; bsum += g[64]; }
    { const int idx = lane * 4, tk = idx >> 4, j = idx & 15;
      const u32x2 xw = *(const u32x2*)(P + (size_t)(rowb + tk) * NIN + 1024 + j);
      *(LAS f32x4*)(XG + idx) = (f32x4){__uint_as_float(xw.x << 16), __uint_as_float(xw.x & 0xffff0000u), __uint_as_float(xw.y << 16), __uint_as_float(xw.y & 0xffff0000u)}; }
    float qv[16];
#pragma unroll
    for (int i = 0; i < 16; ++i) qv[i] = bf2f(P[(size_t)(rowb + i) * NIN + kc]) * 0.125f;
    bf16x8 B[8][2];
#pragma unroll
    for (int nt = 0; nt < 8; ++nt)
#pragma unroll
        for (int kh = 0; kh < 2; ++kh) { float sv[8];
#pragma unroll
            for (int e = 0; e < 8; ++e) sv[e] = Ss[(size_t)(kh * 32 + q * 8 + e) * 128 + nt * 16 + n];
            B[nt][kh] = pack8(sv); }
    bf16_t zr[4][8], gr[4][8]; float ng[8];
#pragma unroll
    for (int nt = 0; nt < 8; ++nt) ng[nt] = p.in[24][nt * 16 + n];
#pragma unroll
    for (int i = 0; i < 4; ++i) {
        const int row = rowb + q * 4 + i;
#pragma unroll
        for (int nt = 0; nt < 8; ++nt) { zr[i][nt] = HB[(size_t)row * 1024 + 512 + hd * 128 + nt * 16 + n]; gr[i][nt] = P[(size_t)row * NIN + 1040 + hd * 128 + nt * 16 + n]; }
    }
    __builtin_amdgcn_sched_barrier(0);
#pragma unroll
    for (int i = 0; i < 16; ++i) {
        float gl = gkb;
#pragma unroll
        for (int j4 = 0; j4 < 4; ++j4) { const f32x4 x4 = *(const LAS f32x4*)(XG + i * 16 + j4 * 4); gl += x4[0] * gku[j4 * 4] + x4[1] * gku[j4 * 4 + 1] + x4[2] * gku[j4 * 4 + 2] + x4[3] * gku[j4 * 4 + 3]; }
        bsum += -softplusf_(-gl) * (1.0f / 16.0f);
        QT[i * 72 + lane] = (bf16_t)(cvt_pk_bf16(qv[i] * __expf(bsum), 0.f) & 0xffffu);
    }
    bf16x8 A[2];
#pragma unroll
    for (int kh = 0; kh < 2; ++kh) A[kh] = *(const LAS bf16x8*)(QT + n * 72 + kh * 32 + q * 8);
    f32x4 D[8];
#pragma unroll
    for (int nt = 0; nt < 8; ++nt) {
        f32x4 d = (f32x4){0.f, 0.f, 0.f, 0.f};
#pragma unroll
        for (int kh = 0; kh < 2; ++kh) d = __builtin_amdgcn_mfma_f32_16x16x32_bf16(A[kh], B[nt][kh], d, 0, 0, 0);
        D[nt] = d;
    }
#pragma unroll
    for (int i = 0; i < 4; ++i) {
        const int row = rowb + q * 4 + i;
        bf16_t* ob = HB + (size_t)row * 1024 + 512 + hd * 128 + n;
        float o[8], ss = 0.f;
#pragma unroll
        for (int nt = 0; nt < 8; ++nt) { o[nt] = D[nt][i] + bf2f(zr[i][nt]); ss += o[nt] * o[nt]; }
        const float rs = rsqrtf(row16_sum(ss) * (1.0f / 128.0f) + 1e-6f);
#pragma unroll
        for (int nt = 0; nt < 8; ++nt) {
            const float g = bf2f(gr[i][nt]);
            const unsigned rb = cvt_pk_bf16(o[nt] * rs * ng[nt] * g * sigmoidf_(g), 0.f);
            bf16_t* dp = dry ? (bf16_t*)(p.ws + WS_DUMMY) + (size_t)blockIdx.x * 512 + threadIdx.x : ob + nt * 16;
            *dp = (bf16_t)(rb & 0xffffu);
        }
    }
}
__device__ __forceinline__ void phase_mix_c(const Params& p, LAS unsigned char* lds, int dry, int mask) {
    const int wave = tid_opaque() >> 6, widx = wave * (int)gridDim.x + (int)blockIdx.x, nw = gridDim.x * 8;
    LAS float* wl = (LAS float*)(lds + wave * 16384);
    if (mask & 1) for (int j = widx; j < 4160; j += nw) {
        int ci, row0, rd, hd;
        if (j < 4096) { ci = j >> 4; row0 = ci * 64; rd = (j >> 2) & 3; hd = j & 3; }
        else { const int r = j - 4096, sb = r >> 2; ci = 256 + sb; row0 = MPROMPT + sb * 16; rd = 0; hd = r & 3; }
        gla_c_task(p, wl, ci, row0, rd, hd, dry);
    }
    const int jb = (widx + 4160) % nw, js = nw, je = 8320;
    RwkvCConst KC; rwkv_c_const(p, jb & 7, KC);
    if (mask & 2) for (int j = jb; j < je; j += js) {
        Seg sg; int ci, tok0, hd;
        if (j < 8192) { const int c = j >> 6; ci = c; tok0 = ((j >> 3) & 7) * 16; hd = j & 7; sg.row0 = c * 128; sg.nsteps = 128; sg.prevkind = c == 0 ? 0 : 1; sg.prevptr = nullptr; }
        else { const int r = j - 8192, sb = r >> 3; ci = 128 + sb; tok0 = 0; hd = r & 7; sg.row0 = MPROMPT + sb * 16; sg.nsteps = 16; sg.prevkind = 2; sg.prevptr = p.in[2] + (size_t)sb * ACOLS; }
        rwkv_c_task(p, KC, ci, tok0, hd, sg, dry);
    }
}
__global__ void __launch_bounds__(512, 2) fwd_megakernel(Params p) {
    extern __shared__ __attribute__((aligned(16))) unsigned char shm[];
    LAS unsigned char* lds = (LAS unsigned char*)shm;
    cg::grid_group grid = cg::this_grid();
    float* ssq = (float*)(p.ws + WS_SSQ);
    bf16_t* HB = (bf16_t*)(p.ws + WS_HB); bf16_t* HB2 = (bf16_t*)(p.ws + WS_HB2); bf16_t* PACT = (bf16_t*)(p.ws + WS_PACT);
    float* XRES = p.out;
    float* PART = (float*)(p.ws + WS_HSR);
#if BARRIER_KIND == 0
#define GSYNC() grid.sync()
#elif BARRIER_KIND == 1
#define GSYNC() xcd_barrier(xb)
#else
    unsigned bar_round = 0;
    const unsigned bar_g = blockIdx.x & 7u, bar_gsize = (gridDim.x + 7u - bar_g) >> 3, bar_ngrp = gridDim.x < 8u ? gridDim.x : 8u;
#define GSYNC() do { asm volatile("s_waitcnt vmcnt(0)" ::: "memory"); __syncthreads(); if (threadIdx.x == 0) { size_t off_ = WS_BAR + 3520 * 4; asm volatile("" : "+s"(off_)); unsigned* cnt_ = (unsigned*)(p.ws + off_); ++bar_round; \
        __builtin_amdgcn_fence(__ATOMIC_RELEASE, "agent"); \
        const unsigned old_ = __hip_atomic_fetch_add(cnt_ + 64 * (1 + bar_g), 1u, __ATOMIC_RELAXED, __HIP_MEMORY_SCOPE_AGENT); \
        if (old_ + 1u == bar_gsize * bar_round) __hip_atomic_fetch_add(cnt_, 1u, __ATOMIC_RELAXED, __HIP_MEMORY_SCOPE_AGENT); \
        while (__hip_atomic_load(cnt_, __ATOMIC_RELAXED, __HIP_MEMORY_SCOPE_AGENT) < bar_round * bar_ngrp) __builtin_amdgcn_s_sleep(2); \
        __builtin_amdgcn_fence(__ATOMIC_ACQUIRE, "agent"); asm volatile("s_waitcnt vmcnt(0)" ::: "memory"); } __syncthreads(); } while (0)
#endif
#define REPS(k) (1 + (DUP_PHASE == (k) ? DUP_N : 0))
#define PHASE(k, ...) for (int rep_ = 0; rep_ < REPS(k); ++rep_) { int dry = rep_ < REPS(k) - 1; asm volatile("" : "+s"(dry)); __VA_ARGS__ GSYNC(); }
    if (p.ws == nullptr) grid.sync();
    for (int rep_ = 0; rep_ < REPS(0); ++rep_) { phase_convert(p, lds, 2, (int)blockIdx.x, (int)gridDim.x); GSYNC(); }
    if (threadIdx.x == 0) *(LAS u32x4*)(lds + 131072) = (u32x4){0u, 0u, 0u, 0u};
    __syncthreads();
#if BARRIER_KIND == 1
    const XcdBarrier xb = xcd_barrier_post((unsigned*)(p.ws + WS_BAR), (volatile LAS unsigned*)(lds + 131072));
#endif
    PHASE(1, { EpiSwiglu E; E.O = PACT; E.ssq = ssq; E.nparts = 0; run_gemm(lds, HB, (const bf16_t*)(p.ws + WS_W1GU), 5632, 1024, E); })
    PHASE(2, { const EpiResid E{p.in[0], 0.5f, p.in[1], 0, XRES, HB, ssq + 16 * MROWS, PART}; run_gemm_split(lds, PACT, (const bf16_t*)(p.ws + WS_W1D), FF, E); })
    split_fixup(PART, 11, p.in[1], XRES, HB, ssq + 16 * MROWS, 0.5f, 0, nullptr); GSYNC();
    PHASE(3, { EpiP E; E.P = PACT; E.ssq = ssq + 16 * MROWS; E.out = p.out; run_gemm(lds, HB, (const bf16_t*)(p.ws + WS_WIN), NINP, 1024, E); })
    PHASE(4, { int mask = dry ? DUP_MASK : 3; asm volatile("" : "+s"(mask)); phase_mix_a(p, lds, mask); })
#if GLA2_SEL >= 0
    { int sel = GLA2_SEL; asm volatile("" : "+s"(sel)); phase_mix_a2(p, lds, sel); GSYNC(); }
#endif
    PHASE(5, phase_scan(p, lds, dry);)
    PHASE(6, { int mask = dry ? DUP_MASK : 3; asm volatile("" : "+s"(mask)); phase_mix_c(p, lds, dry, mask); })
    PHASE(7, { const EpiResid E{XRES, 1.0f, XRES + (size_t)MPROMPT * DM, dry, XRES, HB2, ssq + 32 * MROWS, PART}; run_gemm_split(lds, HB, (const bf16_t*)(p.ws + WS_WOUT), 1024, E); })
    split_fixup(PART, 4, XRES + (size_t)MPROMPT * DM, XRES, HB2, ssq + 32 * MROWS, 1.0f, 0, nullptr); GSYNC();
    PHASE(8, { EpiSwiglu E; E.O = PACT; E.ssq = ssq + 32 * MROWS; E.nparts = 16; run_gemm(lds, HB2, (const bf16_t*)(p.ws + WS_W2GU), 5632, 1024, E); })
    PHASE(9, { const EpiResid E{XRES, 0.5f, XRES + (size_t)MPROMPT * DM, dry, XRES, nullptr, ssq + 48 * MROWS, PART}; run_gemm_split(lds, PACT, (const bf16_t*)(p.ws + WS_W2D), FF, E); })
    split_fixup(PART, 11, XRES + (size_t)MPROMPT * DM, XRES, nullptr, ssq + 48 * MROWS, 0.5f, 0, p.in[30]);
#if DUP_PHASE == 11
    for (int rep_ = 0; rep_ < 10 * DUP_N; ++rep_) GSYNC();
#endif
    for (int rep_ = 0; rep_ < REPS(10); ++rep_) { int dry = rep_ < REPS(10) - 1; asm volatile("" : "+s"(dry)); phase_final_norm(p, dry); if (dry) GSYNC(); }
}

extern "C" void kernel_launch(void* const* d_in, const int* in_sizes, int n_in, void* d_out, int out_size, void* d_ws, size_t ws_size, hipStream_t stream) {
    static int grid = 0;
    if (grid == 0) {
        if (n_in != 31 || (size_t)out_size != O_END || ws_size < WS_END) { fprintf(stderr, "kernel_launch: unexpected sizes n_in %d out %d ws %zu (need %zu)\n", n_in, out_size, ws_size, (size_t)WS_END); grid = -1; return; }
        int dev = 0, cus = 0, per_cu = 0;
        hipGetDevice(&dev); hipDeviceGetAttribute(&cus, hipDeviceAttributeMultiprocessorCount, dev);
        if (hipFuncSetAttribute((const void*)fwd_megakernel, hipFuncAttributeMaxDynamicSharedMemorySize, LDS_BYTES) != hipSuccess) { fprintf(stderr, "kernel_launch: hipFuncSetAttribute failed\n"); grid = -1; return; }
        if (hipOccupancyMaxActiveBlocksPerMultiprocessor(&per_cu, (const void*)fwd_megakernel, 512, LDS_BYTES) != hipSuccess || per_cu < 1) { fprintf(stderr, "kernel_launch: occupancy query says %d\n", per_cu); per_cu = 1; }
        (void)hipGetLastError();
        grid = cus;
    }
    if (grid < 0) return;
    if (hipMemsetAsync((unsigned char*)d_ws + WS_BAR, 0, 16384, stream) != hipSuccess) { fprintf(stderr, "kernel_launch: memset failed\n"); return; }
    Params p{};
    for (int i = 0; i < 31; ++i) p.in[i] = (const float*)d_in[i];
    p.out = (float*)d_out; p.ws = (unsigned char*)d_ws;
    void* args[] = {&p};
    hipError_t e = hipLaunchCooperativeKernel((const void*)fwd_megakernel, dim3(grid), dim3(512), args, LDS_BYTES, stream);
    if (e != hipSuccess) fprintf(stderr, "cooperative launch failed: %s (grid %d)\n", hipGetErrorString(e), grid);
}
```

```cpp
#include <hip/hip_runtime.h>
#include <hip/hip_cooperative_groups.h>
#include <cstdio>
namespace cg = cooperative_groups;
#define BARRIER_KIND 2
#define GLA2_SEL -1
#ifndef DUP_PHASE
#define DUP_PHASE -1
#define DUP_N 1
#define DUP_MASK 3
#endif
namespace pg8 {
#define PG8_LAS __attribute__((address_space(3)))
typedef unsigned short bf16_t;
typedef short bf16x8 __attribute__((ext_vector_type(8)));
typedef float f32x4 __attribute__((ext_vector_type(4)));
typedef unsigned u32x4 __attribute__((ext_vector_type(4)));
constexpr int BM = 256, BK = 64, HALF = 128, HTB = HALF * BK * 2  , STAGE_BYTES = 8 * HTB, NXCD = 8, WGM = 8;

__host__ __device__ __forceinline__ int lds_byte(int r, int c) { const int st = (r >> 4) * 2 + (c >> 5), rr = r & 15, cc = c & 31, ob = rr * 64 + cc * 2; return st * 1024 + (ob ^ (((ob >> 9) & 1) << 5)); }
__host__ __device__ __forceinline__ void stage_rc(int b, int& R, int& C) { const int st = b / 1024, sb = b % 1024, swz = sb ^ (((sb >> 9) & 1) << 5); R = (st >> 1) * 16 + swz / 64; C = (st & 1) * 32 + (swz % 64) / 2; }
__host__ __device__ __forceinline__ int perm32(int rho) { const int n = rho >> 4, i = rho & 15; return 8 * (i >> 2) + 4 * n + (i & 3); }

struct Unit { int pm, pn, k0, nkt, part; };
struct Gemm { const bf16_t* A; const bf16_t* Bt; int M, N, K; };

struct StaticOrder {
    int nM, nN, nwg, G, c, nkt;
    __host__ __device__ void init(int M, int N, int G_, int c_, int K_ = 0) { nM = M / BM; nN = N / BM; nwg = nM * nN; G = G_; c = c_; nkt = K_ / BK; }
    __host__ __device__ bool next(int i, Unit& u) const {
        const long L = (long)i * G + c; if (L >= nwg) return false;
        int wgid = (int)L; { const int q = nwg / NXCD, r = nwg % NXCD, xcd = wgid % NXCD, off = wgid / NXCD; wgid = (xcd < r ? xcd * (q + 1) : r * (q + 1) + (xcd - r) * q) + off; }
        const int nig = WGM * nN, gid = wgid / nig, fm = gid * WGM, gsz = (nM - fm) < WGM ? (nM - fm) : WGM;
        u.pm = fm + ((wgid % nig) % gsz); u.pn = (wgid % nig) / gsz; u.k0 = 0; u.nkt = nkt; u.part = -1; return true;
    }
    __device__ __forceinline__ void a_ready(const Unit&) const {}
    __device__ __forceinline__ void done(const Unit&) const {}
};
__device__ __forceinline__ unsigned cvt_pk_bf16(float lo, float hi) { unsigned r; asm volatile("v_cvt_pk_bf16_f32 %0, %1, %2" : "=v"(r) : "v"(lo), "v"(hi)); return r; }

template <class Epi, class Sched, bool STAMP = false>
__device__ __forceinline__ void gemm_phase(PG8_LAS unsigned char* lds, const Gemm g, const Sched& S, const Epi& E, unsigned long long* stamps) {
    int tid_ = threadIdx.x; asm volatile("" : "+v"(tid_)); const int tid = tid_, wid = __builtin_amdgcn_readfirstlane(tid >> 6), lane = tid & 63, wr = wid >> 2, wc = wid & 3, fr = lane & 15, fq = lane >> 4;
    const int K = g.K;
    int ts_lo = 0, ts_hi = 0, nts = 0; const unsigned long long rt_entry = STAMP ? (unsigned long long)wall_clock64() : 0ull;
#define PG8_STAMP() do { if (STAMP && wid == 0 && nts < 64) { const unsigned long long _c = (unsigned long long)clock64(); \
        ts_lo = (lane == nts) ? (int)(unsigned)_c : ts_lo; ts_hi = (lane == nts) ? (int)(unsigned)(_c >> 32) : ts_hi; ++nts; } } while (0)
    PG8_STAMP();
    unsigned voffA[2], voffB[2];
#pragma unroll
    for (int i = 0; i < 2; ++i) { int R, C; stage_rc(tid * 16 + i * 8192, R, C); const int Rb = Epi::PERM ? ((R & ~31) + perm32(R & 31)) : R;
        voffA[i] = (unsigned)(R * K + C) * 2u; voffB[i] = (unsigned)(Rb * K + C) * 2u; }
    const size_t kstep = (size_t)(BK * 2);
    const size_t hstep = (size_t)HALF * K * 2;
    const size_t tstep = 2 * hstep;
    const unsigned ldsw = (unsigned)wid * 1024u;
    const int aoff = lds_byte(wr * 64 + fr, fq * 8), boff = lds_byte(wc * 32 + fr, fq * 8);
#define PG8_SA(b, h) (((b) * 2 + (h)) * HTB)
#define PG8_SB(b, h) ((4 + (b) * 2 + (h)) * HTB)
#define PG8_STAGE(bufoff, gbase, voff) do { _Pragma("unroll") for (int _i = 0; _i < 2; ++_i) \
        __builtin_amdgcn_global_load_lds((const unsigned*)((const char*)(gbase) + (voff)[_i]), (PG8_LAS unsigned*)(lds + (bufoff) + ldsw + _i * 8192), 16, 0, 0); } while (0)
#define PG8_LDA(dst, b, h) do { _Pragma("unroll") for (int m = 0; m < 4; ++m) _Pragma("unroll") for (int k = 0; k < 2; ++k) dst[m][k] = *(const PG8_LAS bf16x8*)(lds + PG8_SA(b, h) + aoff + m * 2048 + k * 1024); } while (0)
#define PG8_LDB(dst, b, h) do { _Pragma("unroll") for (int n = 0; n < 2; ++n) _Pragma("unroll") for (int k = 0; k < 2; ++k) dst[n][k] = *(const PG8_LAS bf16x8*)(lds + PG8_SB(b, h) + boff + n * 2048 + k * 1024); } while (0)
#define PG8_MMA(ai, bj, At, Bt) do { __builtin_amdgcn_s_setprio(1); _Pragma("unroll") for (int m = 0; m < 4; ++m) _Pragma("unroll") for (int n = 0; n < 2; ++n) _Pragma("unroll") for (int k = 0; k < 2; ++k) \
        acc[ai][bj][m][n] = __builtin_amdgcn_mfma_f32_16x16x32_bf16(Bt[n][k], At[m][k], acc[ai][bj][m][n], 0, 0, 0); __builtin_amdgcn_s_setprio(0); } while (0)
#define PG8_WAIT_V(n) asm volatile("s_waitcnt vmcnt(" #n ")" ::: "memory")
#define PG8_WAIT_L(n) asm volatile("s_waitcnt lgkmcnt(" #n ")" ::: "memory")
#define PG8_BAR __builtin_amdgcn_s_barrier()
#define PG8_SCHED __builtin_amdgcn_sched_barrier(0)
    Unit cur, nxt; int ui = 0;
    if (!S.next(0, cur)) return;
    f32x4 acc[2][2][4][2];
#pragma unroll
    for (int a = 0; a < 2; ++a)
#pragma unroll
        for (int b = 0; b < 2; ++b)
#pragma unroll
            for (int m = 0; m < 4; ++m)
#pragma unroll
                for (int n = 0; n < 2; ++n) acc[a][b][m][n] = (f32x4){0.f, 0.f, 0.f, 0.f};
    bf16x8 At[4][2], B0[2][2], B1[2][2];
    const char* cA = (const char*)g.A + (size_t)cur.pm * tstep + (size_t)cur.k0 * kstep; const char* cB = (const char*)g.Bt + (size_t)cur.pn * tstep + (size_t)cur.k0 * kstep;
    S.a_ready(cur);
    float pre[8]; E.prefetch(cur, wr, fr, pre);
    PG8_STAGE(PG8_SB(0, 0), cB, voffB); PG8_STAGE(PG8_SA(0, 0), cA, voffA); PG8_STAGE(PG8_SB(0, 1), cB + hstep, voffB); PG8_STAGE(PG8_SA(0, 1), cA + hstep, voffA);
    if (wr == 1) PG8_BAR;
    PG8_WAIT_V(4); PG8_BAR;
    PG8_STAGE(PG8_SB(1, 0), cB + kstep, voffB); PG8_STAGE(PG8_SA(1, 0), cA + kstep, voffA); PG8_STAGE(PG8_SB(1, 1), cB + hstep + kstep, voffB);
    PG8_WAIT_V(6); PG8_BAR;
    PG8_STAMP();
    for (;;) {
        const bool has_next = S.next(ui + 1, nxt);
        const char* nA = has_next ? (const char*)g.A + (size_t)nxt.pm * tstep + (size_t)nxt.k0 * kstep : cA; const char* nB = has_next ? (const char*)g.Bt + (size_t)nxt.pn * tstep + (size_t)nxt.k0 * kstep : cB;
        const int nt = cur.nkt;
        for (int t = 0; t < nt; t += 2) {
            const bool last = (t == nt - 2);
            const char* a1 = cA + (size_t)(t + 1) * kstep;
            const char* a2 = last ? nA : cA + (size_t)(t + 2) * kstep; const char* b2 = last ? nB : cB + (size_t)(t + 2) * kstep;
            const char* a3 = a2 + kstep; const char* b3 = b2 + kstep;
            if (last && has_next) S.a_ready(nxt);
            PG8_LDB(B0, 0, 0); PG8_SCHED; PG8_LDA(At, 0, 0); PG8_STAGE(PG8_SA(1, 1), a1 + hstep, voffA);
            PG8_WAIT_L(8); PG8_BAR; PG8_WAIT_L(0); PG8_MMA(0, 0, At, B0); PG8_BAR; PG8_SCHED;
            PG8_LDB(B1, 0, 1); PG8_STAGE(PG8_SB(0, 0), b2, voffB);
            PG8_BAR; PG8_WAIT_L(0); PG8_MMA(0, 1, At, B1); PG8_BAR;
            PG8_LDA(At, 0, 1); PG8_STAGE(PG8_SA(0, 0), a2, voffA);
            PG8_BAR; PG8_WAIT_L(0); PG8_MMA(1, 0, At, B0); PG8_BAR; PG8_SCHED;
            PG8_STAGE(PG8_SB(0, 1), b2 + hstep, voffB);
            PG8_WAIT_V(6); PG8_BAR; PG8_MMA(1, 1, At, B1); PG8_BAR;
            PG8_LDB(B0, 1, 0); PG8_SCHED; PG8_LDA(At, 1, 0); PG8_STAGE(PG8_SA(0, 1), a2 + hstep, voffA);
            PG8_WAIT_L(8); PG8_BAR; PG8_WAIT_L(0); PG8_MMA(0, 0, At, B0); PG8_BAR; PG8_SCHED;
            PG8_LDB(B1, 1, 1); PG8_STAGE(PG8_SB(1, 0), b3, voffB);
            PG8_BAR; PG8_WAIT_L(0); PG8_MMA(0, 1, At, B1); PG8_BAR;
            PG8_LDA(At, 1, 1); PG8_STAGE(PG8_SA(1, 0), a3, voffA);
            PG8_BAR; PG8_WAIT_L(0); PG8_MMA(1, 0, At, B0); PG8_BAR; PG8_SCHED;
            PG8_STAGE(PG8_SB(1, 1), b3 + hstep, voffB);
            PG8_WAIT_V(6); PG8_BAR; PG8_MMA(1, 1, At, B1); PG8_BAR;
        }
        PG8_STAMP();
        if constexpr (!Epi::AFTER_DRAIN) { E(acc, cur, wr, wc, fr, fq, pre); S.done(cur); }
        PG8_STAMP();
        if (!has_next) break;
#pragma unroll
        for (int a = 0; a < 2; ++a)
#pragma unroll
            for (int b = 0; b < 2; ++b)
#pragma unroll
                for (int m = 0; m < 4; ++m)
#pragma unroll
                    for (int n = 0; n < 2; ++n) acc[a][b][m][n] = (f32x4){0.f, 0.f, 0.f, 0.f};
        cur = nxt; cA = nA; cB = nB; ++ui; E.prefetch(cur, wr, fr, pre);
    }
    PG8_WAIT_V(0);
    if (wr == 0) PG8_BAR;
    PG8_BAR;
    if constexpr (Epi::AFTER_DRAIN) { E.fused(acc, cur, wr, wc, fr, fq, lds, wid, lane); S.done(cur); }
    PG8_STAMP();
    if (STAMP && wid == 0) { stamps[lane] = lane < nts ? (((unsigned long long)(unsigned)ts_hi << 32) | (unsigned)ts_lo) : 0ull;
        if (lane == 62) stamps[62] = rt_entry; if (lane == 63) stamps[63] = (unsigned long long)wall_clock64(); }
#undef PG8_STAMP
#undef PG8_SA
#undef PG8_SB
#undef PG8_STAGE
#undef PG8_LDA
#undef PG8_LDB
#undef PG8_MMA
#undef PG8_WAIT_V
#undef PG8_WAIT_L
#undef PG8_BAR
#undef PG8_SCHED
}
}
#define LAS PG8_LAS
#define XB_TMO      128
#define XB_XCNT(j)  (256  + 64 * (j))
#define XB_XSUB(j)  (1280 + 64 * (j))
#define XB_XGEN(j)  (2304 + 64 * (j))
#define XB_TOP      3328
#define XB_TOPGEN   3392
#define XCD_BAR_WORDS 3456
#define XB_SPIN_CAP (1u << 18)

__device__ __forceinline__ unsigned xb_ld(unsigned* p)              { return __hip_atomic_load(p, __ATOMIC_RELAXED, __HIP_MEMORY_SCOPE_AGENT); }
__device__ __forceinline__ unsigned xb_add(unsigned* p, unsigned v) { return __hip_atomic_fetch_add(p, v, __ATOMIC_RELAXED, __HIP_MEMORY_SCOPE_AGENT); }
__device__ __forceinline__ unsigned xb_xcc_id() { return (unsigned)__builtin_amdgcn_s_getreg((3 << 11) | 20) & 0xFu; }
#define XB_SPIN(cond, bar) do { unsigned _sp = 0; while (cond) { __builtin_amdgcn_s_sleep(1); \
    if ((++_sp & 255u) == 0u) { if (xb_ld(&(bar)[XB_TMO])) break; if (_sp > XB_SPIN_CAP) { atomicAdd(&(bar)[XB_TMO], 1u); break; } } } } while (0)

struct XcdBarrier {
    unsigned* bar; unsigned x;
    volatile LAS unsigned* st;
};

__device__ __forceinline__ XcdBarrier xcd_barrier_post(unsigned* bar, volatile LAS unsigned* st) {
    XcdBarrier b; b.bar = bar; b.x = xb_xcc_id(); b.st = st;
    if (threadIdx.x == 0) (void)xb_add(&bar[XB_XCNT(b.x)], 1u);
    return b;
}
__device__ __forceinline__ void xcd_barrier_complete(unsigned* bar, unsigned x, unsigned& nloc, unsigned& nx) {
    const unsigned G = gridDim.x * gridDim.y * gridDim.z;
    unsigned sum, cnt, mine, sp = 0u;
    for (;;) {
        sum = 0u; cnt = 0u; mine = 0u;
#pragma unroll
        for (unsigned j = 0; j < 16; ++j) { const unsigned c = xb_ld(&bar[XB_XCNT(j)]); sum += c; cnt += (c > 0u) ? 1u : 0u; mine = (j == x) ? c : mine; }
        if (sum == G) break;
        __builtin_amdgcn_s_sleep(1);
        if ((++sp & 255u) == 0u) { if (xb_ld(&bar[XB_TMO])) break; if (sp > XB_SPIN_CAP) { atomicAdd(&bar[XB_TMO], 1u); break; } }
    }
    nloc = mine > 0u ? mine : 1u; nx = cnt > 0u ? cnt : 1u;
}

__device__ __forceinline__ void xcd_barrier(const XcdBarrier& b) {
    asm volatile("s_waitcnt vmcnt(0)" ::: "memory");
    __syncthreads();
    if (threadIdx.x == 0) {
        unsigned* bar = b.bar;
        __builtin_amdgcn_s_waitcnt(0);
        unsigned nloc = b.st[0], nx = b.st[1];
        if (nloc == 0u) { xcd_barrier_complete(bar, b.x, nloc, nx); b.st[0] = nloc; b.st[1] = nx; }
        const unsigned old = xb_add(&bar[XB_XSUB(b.x)], 1u);
        const unsigned gen = old / nloc;
        if (old + 1u == (gen + 1u) * nloc) {
            __builtin_amdgcn_fence(__ATOMIC_RELEASE, "agent");
            asm volatile("s_waitcnt vmcnt(0)" ::: "memory");
            const unsigned og = xb_add(&bar[XB_TOP], 1u);
            const unsigned tg = og / nx;
            if (og + 1u == (tg + 1u) * nx) xb_add(&bar[XB_TOPGEN], 1u);
            else XB_SPIN(xb_ld(&bar[XB_TOPGEN]) == tg, bar);
            __builtin_amdgcn_fence(__ATOMIC_ACQUIRE, "agent");
            xb_add(&bar[XB_XGEN(b.x)], 1u);
            asm volatile("s_waitcnt vmcnt(0)" ::: "memory");
        } else {
            XB_SPIN(xb_ld(&bar[XB_XGEN(b.x)]) == gen, bar);
            __builtin_amdgcn_fence(__ATOMIC_ACQUIRE, "agent");
            asm volatile("s_waitcnt vmcnt(0)" ::: "memory");
        }
    }
    __syncthreads();
}

using pg8::bf16_t; using pg8::bf16x8; using pg8::f32x4; using pg8::u32x4; using pg8::Unit; using pg8::cvt_pk_bf16;

typedef float f32x2 __attribute__((ext_vector_type(2)));
typedef unsigned u32x2 __attribute__((ext_vector_type(2)));

constexpr int MROWS = 16640, MPROMPT = 16384, DM = 1024, FF = 2816, NIN = 3216, NINP = 3328, ACOLS = 1664, BOFF = 1664;
constexpr int NSAMP = 16, SAMP_T = 16;
constexpr size_t O_Y = 0, O_SHIFT_P = 17039360, O_WKV_P = 17041024, O_GLA_P = 17073792, O_SHIFT_S = 17106560, O_WKV_S = 17133184, O_GLA_S = 17657472, O_END = 18181760;
constexpr size_t al256(size_t x) { return (x + 255) & ~(size_t)255; }
constexpr size_t WS_W1GU = 0;
constexpr size_t WS_W1D  = WS_W1GU + (size_t)5632 * 1024 * 2;
constexpr size_t WS_WIN  = WS_W1D + (size_t)1024 * 2816 * 2;
constexpr size_t WS_WOUT = WS_WIN + (size_t)NINP * 1024 * 2;
constexpr size_t WS_W2GU = WS_WOUT + (size_t)1024 * 1024 * 2;
constexpr size_t WS_W2D  = WS_W2GU + (size_t)5632 * 1024 * 2;
constexpr size_t WS_SSQ  = WS_W2D + (size_t)1024 * 2816 * 2;
constexpr size_t SSQ_BYTES = (size_t)16 * MROWS * 4;
constexpr size_t WS_HB   = WS_SSQ + 4 * SSQ_BYTES;
constexpr size_t WS_PACT = WS_HB + (size_t)MROWS * 1024 * 2;
constexpr size_t WS_G    = WS_PACT + (size_t)MROWS * NIN * 2;
constexpr size_t WS_HSR  = WS_G + (size_t)144 * 8 * 8192;
constexpr size_t WS_HSG  = WS_HSR + (size_t)144 * 8 * 16384;
constexpr size_t WS_DECG = WS_HSG + (size_t)272 * 4 * 32768;
constexpr size_t WS_BONUS= WS_DECG + (size_t)272 * 4 * 64 * 4;
constexpr size_t WS_BAR  = WS_BONUS + (size_t)MROWS * 8 * 4;
constexpr size_t WS_DUMMY= WS_BAR + 16384;
constexpr size_t WS_GBS  = WS_DUMMY + ((size_t)1 << 20);
constexpr size_t WS_RSTD = WS_GBS + (size_t)272 * 4 * 4 * 2 * 64 * 4;
constexpr size_t WS_END  = WS_RSTD + (size_t)2 * MROWS * 4;
constexpr size_t WS_Y    = WS_W1GU;
constexpr size_t WS_HB2  = WS_HSG;
static_assert((size_t)MROWS * 512 * 2 <= WS_WOUT, "Y overlay");
static_assert((size_t)MROWS * 1024 * 2 <= (size_t)272 * 4 * 32768, "HB2 overlay");
constexpr int LDS_BYTES = 131072 + 16;

struct Params { const float* in[31]; float* out; unsigned char* ws; };

__device__ __forceinline__ float rstd_of(const float* ssq, int nparts, int row) {
    float s = 0.f;
    for (int p = 0; p < nparts; ++p) s += ssq[(size_t)p * MROWS + row];
    return rsqrtf(s * (1.0f / 1024.0f) + 1e-6f);
}
__device__ __forceinline__ int tid_opaque() { int t = threadIdx.x; asm volatile("" : "+v"(t)); return t; }
__device__ __forceinline__ float sigmoidf_(float x) { return __builtin_amdgcn_rcpf(1.0f + __expf(-x)); }

struct EpiSwiglu {
    static constexpr bool PERM = true, AFTER_DRAIN = false;
    bf16_t* O; const float* rstd; int nparts;
    __device__ __forceinline__ void prefetch(const Unit& u, int wr, int fr, float (&pre)[8]) const {
        if (nparts) {
#pragma unroll
            for (int ai = 0; ai < 2; ++ai)
#pragma unroll
                for (int m = 0; m < 4; ++m) pre[ai * 4 + m] = rstd[u.pm * 256 + wr * 64 + fr + ai * 128 + m * 16];
        }
    }
    __device__ __forceinline__ void operator()(const f32x4 (&acc)[2][2][4][2], const Unit& u, int wr, int wc, int fr, int fq, const float (&pre)[8]) const {
        const int row0 = u.pm * 256 + wr * 64 + fr, col0 = u.pn * 128 + wc * 32 + 8 * fq;
#pragma unroll
        for (int ai = 0; ai < 2; ++ai)
#pragma unroll
            for (int m = 0; m < 4; ++m) {
                const int row = row0 + ai * 128 + m * 16; const float rs = nparts ? pre[ai * 4 + m] : 1.0f;
                float a[8];
#pragma unroll
                for (int n = 0; n < 2; ++n)
#pragma unroll
                    for (int j = 0; j < 4; ++j) { const float g = acc[ai][0][m][n][j] * rs, up = acc[ai][1][m][n][j] * rs; a[n * 4 + j] = g * sigmoidf_(g) * up; }
                u32x4 w; w.x = cvt_pk_bf16(a[0], a[1]); w.y = cvt_pk_bf16(a[2], a[3]); w.z = cvt_pk_bf16(a[4], a[5]); w.w = cvt_pk_bf16(a[6], a[7]);
                *(u32x4*)(O + (size_t)row * FF + col0) = w;
            }
    }
};
struct EpiResid {
    static constexpr bool PERM = true, AFTER_DRAIN = false;
    const float* xoldA; float scale; const float* xoldB; int dry; float* xnew; bf16_t* xb; float* ssq; float* part;
    __device__ __forceinline__ void prefetch(const Unit&, int, int, float (&)[8]) const {}
    __device__ __forceinline__ void operator()(const f32x4 (&acc)[2][2][4][2], const Unit& u, int wr, int wc, int fr, int fq, const float (&)[8]) const {
        const int row0 = u.pm * 256 + wr * 64 + fr, col0 = u.pn * 256 + wc * 32 + 8 * fq;
        float sc_ = scale; asm volatile("" : "+v"(sc_)); const f32x4 sc4 = (f32x4){sc_, sc_, sc_, sc_};
        if (u.part >= 0) {
            float* pb = part + ((size_t)(u.part * 4 + u.pn) * 256 + wr * 64 + fr) * 256 + wc * 32 + 8 * fq;
#pragma unroll
            for (int ai = 0; ai < 2; ++ai)
#pragma unroll
                for (int m = 0; m < 4; ++m)
#pragma unroll
                    for (int bj = 0; bj < 2; ++bj) { float* q = pb + (size_t)(ai * 128 + m * 16) * 256 + bj * 128; *(f32x4*)q = acc[ai][bj][m][0]; *(f32x4*)(q + 4) = acc[ai][bj][m][1]; }
        } else
#pragma unroll
        for (int ai = 0; ai < 2; ++ai)
#pragma unroll
            for (int m = 0; m < 4; ++m) {
                const int row = row0 + ai * 128 + m * 16;
                const float* xo = row < MPROMPT ? xoldA + (size_t)row * DM : xoldB + (size_t)(row - MPROMPT) * DM;
                float sq = 0.f;
#pragma unroll
                for (int bj = 0; bj < 2; ++bj) {
                    const int col = col0 + bj * 128;
                    f32x4 v0 = *(const f32x4*)(xo + col), v1 = *(const f32x4*)(xo + col + 4);
                    if (!dry) { v0 += acc[ai][bj][m][0] * sc4; v1 += acc[ai][bj][m][1] * sc4; }
                    *(f32x4*)(xnew + (size_t)row * DM + col) = v0; *(f32x4*)(xnew + (size_t)row * DM + col + 4) = v1;
                    if (xb) { u32x4 w; w.x = cvt_pk_bf16(v0[0], v0[1]); w.y = cvt_pk_bf16(v0[2], v0[3]); w.z = cvt_pk_bf16(v1[0], v1[1]); w.w = cvt_pk_bf16(v1[2], v1[3]);
                        *(u32x4*)(xb + (size_t)row * DM + col) = w; }
                    sq += (v0[0] * v0[0] + v0[1] * v0[1]) + (v0[2] * v0[2] + v0[3] * v0[3]) + (v1[0] * v1[0] + v1[1] * v1[1]) + (v1[2] * v1[2] + v1[3] * v1[3]);
                }
                sq += __shfl_xor(sq, 16); sq += __shfl_xor(sq, 32);
                if (fq == 0) ssq[(size_t)(u.pn * 4 + wc) * MROWS + row] = sq;
            }
    }
};
struct EpiP {
    static constexpr bool PERM = true, AFTER_DRAIN = false;
    bf16_t* P; const float* rstd; float* out;
    __device__ __forceinline__ void prefetch(const Unit& u, int wr, int fr, float (&pre)[8]) const {
#pragma unroll
        for (int ai = 0; ai < 2; ++ai)
#pragma unroll
            for (int m = 0; m < 4; ++m) pre[ai * 4 + m] = rstd[u.pm * 256 + wr * 64 + fr + ai * 128 + m * 16];
    }
    __device__ __forceinline__ void operator()(const f32x4 (&acc)[2][2][4][2], const Unit& u, int wr, int wc, int fr, int fq, const float (&pre)[8]) const {
        const int row0 = u.pm * 256 + wr * 64 + fr, col0 = u.pn * 256 + wc * 32 + 8 * fq;
#pragma unroll
        for (int ai = 0; ai < 2; ++ai)
#pragma unroll
            for (int m = 0; m < 4; ++m) {
                const int row = row0 + ai * 128 + m * 16; const float rs = pre[ai * 4 + m];
                float* dst = nullptr;
                if (row == MPROMPT - 1) dst = out + O_SHIFT_P;
                else if (row >= MPROMPT && ((row - MPROMPT) & 15) == 15) dst = out + O_SHIFT_S + (size_t)((row - MPROMPT) >> 4) * ACOLS;
#pragma unroll
                for (int bj = 0; bj < 2; ++bj) {
                    const int col = col0 + bj * 128;
                    if (col < NIN) {
                        const f32x4 v0 = acc[ai][bj][m][0] * rs, v1 = acc[ai][bj][m][1] * rs;
                        u32x4 w; w.x = cvt_pk_bf16(v0[0], v0[1]); w.y = cvt_pk_bf16(v0[2], v0[3]); w.z = cvt_pk_bf16(v1[0], v1[1]); w.w = cvt_pk_bf16(v1[2], v1[3]);
                        *(u32x4*)(P + (size_t)row * NIN + col) = w;
                        if (dst && col < ACOLS) { *(f32x4*)(dst + col) = v0; *(f32x4*)(dst + col + 4) = v1; }
                    }
                }
            }
    }
};
template <class Epi>
__device__ __forceinline__ void run_gemm(LAS unsigned char* lds, const bf16_t* A, const bf16_t* Bt, int N, int K, const Epi& E) {
    pg8::Gemm g; g.A = A; g.Bt = Bt; g.M = MROWS; g.N = N; g.K = K;
    pg8::StaticOrder S; S.init(MROWS, N, (int)gridDim.x, (int)blockIdx.x, K);
    pg8::gemm_phase<Epi, pg8::StaticOrder, false>(lds, g, S, E, nullptr);
}
struct SplitOrder {
    pg8::StaticOrder S; int nsmall, c;
    __device__ void init(int G, int c_, int K) { S.init(MPROMPT, 1024, G, c_, K); c = c_; nsmall = 4 * (K / 256); }
    __device__ bool next(int i, Unit& u) const {
        if (i == 0) return S.next(0, u);
        if (i == 1 && c < nsmall) { u.pm = MPROMPT / 256; u.pn = c & 3; u.part = c >> 2; u.k0 = u.part * 4; u.nkt = 4; return true; }
        return false;
    }
    __device__ __forceinline__ void a_ready(const Unit&) const {}
    __device__ __forceinline__ void done(const Unit&) const {}
};
template <class Epi>
__device__ __forceinline__ void run_gemm_split(LAS unsigned char* lds, const bf16_t* A, const bf16_t* Bt, int K, const Epi& E) {
    pg8::Gemm g; g.A = A; g.Bt = Bt; g.M = MROWS; g.N = 1024; g.K = K;
    SplitOrder S; S.init((int)gridDim.x, (int)blockIdx.x, K);
    pg8::gemm_phase<Epi, SplitOrder, false>(lds, g, S, E, nullptr);
}
__device__ __forceinline__ void split_fixup(const float* part, int nsplit, const float* xold, float* xnew, bf16_t* xb, float* ssq, float scale, int dry, const float* fin_g, float* rstd_out) {
    const int tid = tid_opaque(), wave = tid >> 6, lane = tid & 63;
    for (int r = blockIdx.x * 8 + wave; r < 256; r += gridDim.x * 8) {
        const int row = MPROMPT + r; float sq = 0.f; f32x4 v[4];
#pragma unroll
        for (int i = 0; i < 4; ++i) {
            const int col = i * 256 + lane * 4;
            f32x4 a = (f32x4){0.f, 0.f, 0.f, 0.f};
            for (int ks = 0; ks < nsplit; ++ks) a += *(const f32x4*)(part + ((size_t)(ks * 4 + i) * 256 + r) * 256 + lane * 4);
            v[i] = *(const f32x4*)(xold + (size_t)r * DM + col);
            if (!dry) v[i] += a * (f32x4){scale, scale, scale, scale};
            sq += (v[i][0] * v[i][0] + v[i][1] * v[i][1]) + (v[i][2] * v[i][2] + v[i][3] * v[i][3]);
        }
#pragma unroll
        for (int o = 32; o > 0; o >>= 1) sq += __shfl_xor(sq, o);
        const float rs = rsqrtf(sq * (1.0f / 1024.0f) + 1e-6f);
#pragma unroll
        for (int i = 0; i < 4; ++i) {
            const int col = i * 256 + lane * 4;
            if (fin_g) v[i] = v[i] * rs * *(const f32x4*)(fin_g + col);
            *(f32x4*)(xnew + (size_t)row * DM + col) = v[i];
            if (xb) { u32x2 w; w.x = cvt_pk_bf16(v[i][0], v[i][1]); w.y = cvt_pk_bf16(v[i][2], v[i][3]); *(u32x2*)(xb + (size_t)row * DM + col) = w; }
        }
        if (lane < 16) ssq[(size_t)lane * MROWS + row] = lane == 0 ? sq : 0.f;
        if (lane == 0 && rstd_out) rstd_out[row] = rs;
    }
    if (rstd_out) for (int row = blockIdx.x * 512 + tid; row < MPROMPT; row += gridDim.x * 512) rstd_out[row] = rstd_of(ssq, 16, row);
}
struct CvtJob { const float* src; const float* gain; bf16_t* dst; int ldsrc, nvalid, k0, ns0, K, nd0; };
__device__ __forceinline__ void cvt_decode(const Params& p, int tidx, CvtJob& J) {
    if (tidx < 2816) {
        const int f = tidx / 1408, r = tidx % 1408, nb = r / 16, kb = r % 16, pn = nb >> 2, bj = (nb >> 1) & 1, h = nb & 1;
        J.src = f == 0 ? (bj ? p.in[7] : p.in[6]) : (bj ? p.in[28] : p.in[27]); J.gain = f == 0 ? nullptr : p.in[26]; J.dst = (bf16_t*)(p.ws + (f == 0 ? WS_W1GU : WS_W2GU));
        J.ldsrc = FF; J.nvalid = FF; J.k0 = kb * 64; J.ns0 = pn * 128 + h * 64; J.K = 1024; J.nd0 = nb * 64;
    } else if (tidx < 4224) {
        const int f = (tidx - 2816) / 704, r = (tidx - 2816) % 704, nb = r / 44, kb = r % 44;
        J.src = f == 0 ? p.in[8] : p.in[29]; J.gain = nullptr; J.dst = (bf16_t*)(p.ws + (f == 0 ? WS_W1D : WS_W2D)); J.ldsrc = 1024; J.nvalid = 1024; J.k0 = kb * 64; J.ns0 = nb * 64; J.K = FF; J.nd0 = nb * 64;
    } else if (tidx < 5056) {
        const int r = tidx - 4224, nb = r / 16, kb = r % 16;
        J.src = p.in[10]; J.gain = p.in[9]; J.dst = (bf16_t*)(p.ws + WS_WIN); J.ldsrc = NIN; J.nvalid = NIN; J.k0 = kb * 64; J.ns0 = nb * 64; J.K = 1024; J.nd0 = nb * 64;
    } else {
        const int r = tidx - 5056, nb = r / 16, kb = r % 16;
        J.src = p.in[25]; J.gain = nullptr; J.dst = (bf16_t*)(p.ws + WS_WOUT); J.ldsrc = 1024; J.nvalid = 1024; J.k0 = kb * 64; J.ns0 = nb * 64; J.K = 1024; J.nd0 = nb * 64;
    }
}
__device__ __forceinline__ int cvt_remap(int i, int late) {
    if (late == 2) return i;
    if (!late) return i < 1408 ? i : (i < 2112 ? i + 1408 : i + 2112);
    return i < 1408 ? i + 1408 : (i < 2112 ? i + 2112 : i + 2944);
}
__device__ __forceinline__ void phase_convert(const Params& p, LAS unsigned char* lds, int late, int wb, int nb) {
    LAS float* tiles = (LAS float*)lds;
    bf16_t* ws16 = (bf16_t*)p.ws;
    const int t = tid_opaque(), ntiles = late == 2 ? 5312 : (late ? 2368 : 2944);
    for (int base = wb; base < ntiles; base += 4 * nb) {
        f32x4 v[4][2]; float gq[4][2];
#pragma unroll
        for (int u = 0; u < 4; ++u) {
            const int tidx = base + u * nb;
            if (tidx < ntiles) { CvtJob J; cvt_decode(p, cvt_remap(tidx, late), J);
#pragma unroll
                for (int h = 0; h < 2; ++h) { const int i = (t >> 4) + h * 32, j4 = (t & 15) * 4;
                    v[u][h] = (f32x4){0.f, 0.f, 0.f, 0.f};
                    if (J.ns0 + j4 < J.nvalid) v[u][h] = *(const f32x4*)(J.src + (size_t)(J.k0 + i) * J.ldsrc + J.ns0 + j4);
                    gq[u][h] = J.gain ? J.gain[J.k0 + i] : 1.0f; } }
        }
#pragma unroll
        for (int u = 0; u < 4; ++u)
            if (base + u * nb < ntiles) {
#pragma unroll
                for (int h = 0; h < 2; ++h) { const int i = (t >> 4) + h * 32, j4 = (t & 15) * 4;
#pragma unroll
                    for (int e = 0; e < 4; ++e) tiles[u * 4160 + i * 65 + j4 + e] = v[u][h][e] * gq[u][h]; } }
        __syncthreads();
#pragma unroll
        for (int u = 0; u < 4; ++u) {
            const int tidx = base + u * nb;
            if (tidx < ntiles) { CvtJob J; cvt_decode(p, cvt_remap(tidx, late), J);
                const int j = t >> 3, ks = (t & 7) * 8; float a[8];
#pragma unroll
                for (int e = 0; e < 8; ++e) a[e] = tiles[u * 4160 + (ks + e) * 65 + j];
                u32x4 w; w.x = cvt_pk_bf16(a[0], a[1]); w.y = cvt_pk_bf16(a[2], a[3]); w.z = cvt_pk_bf16(a[4], a[5]); w.w = cvt_pk_bf16(a[6], a[7]);
                *(u32x4*)(J.dst + (size_t)(J.nd0 + j) * J.K + J.k0 + ks) = w; }
        }
        __syncthreads();
    }
    (void)ws16;
    if (late == 1) return;
    const int tid = tid_opaque(), wave = tid >> 6, lane = tid & 63;
    float* ssq0 = (float*)(p.ws + WS_SSQ);
    bf16_t* hb = (bf16_t*)(p.ws + WS_HB);
    for (int row = blockIdx.x * 8 + wave; row < MROWS; row += gridDim.x * 8) {
        const float* x = row < MPROMPT ? p.in[0] + (size_t)row * DM : p.in[1] + (size_t)(row - MPROMPT) * DM;
        float sq = 0.f; f32x4 v[4];
#pragma unroll
        for (int i = 0; i < 4; ++i) { v[i] = *(const f32x4*)(x + i * 256 + lane * 4); sq += (v[i][0] * v[i][0] + v[i][1] * v[i][1]) + (v[i][2] * v[i][2] + v[i][3] * v[i][3]); }
#pragma unroll
        for (int o = 32; o > 0; o >>= 1) sq += __shfl_xor(sq, o);
        const float rs = rsqrtf(sq * (1.0f / 1024.0f) + 1e-6f);
#pragma unroll
        for (int i = 0; i < 4; ++i) {
            const f32x4 h = v[i] * rs * *(const f32x4*)(p.in[5] + i * 256 + lane * 4);
            u32x2 w; w.x = cvt_pk_bf16(h[0], h[1]); w.y = cvt_pk_bf16(h[2], h[3]);
            *(u32x2*)(hb + (size_t)row * DM + i * 256 + lane * 4) = w;
        }
    }
}
__device__ __forceinline__ void phase_final_norm(const Params& p, int dry) {
    const int tid = tid_opaque(), wave = tid >> 6, lane = tid & 63;
    const float* ssq3 = (const float*)(p.ws + WS_SSQ + 3 * SSQ_BYTES);
    const float* g = p.in[30];
    for (int row = blockIdx.x * 8 + wave; row < MPROMPT; row += gridDim.x * 8) {
        const float rs = rstd_of(ssq3, 16, row);
        float* x = p.out + (size_t)row * DM;
#pragma unroll
        for (int i = 0; i < 4; ++i) {
            const f32x4 v = *(const f32x4*)(x + i * 256 + lane * 4), gg = *(const f32x4*)(g + i * 256 + lane * 4);
            *(f32x4*)(x + i * 256 + lane * 4) = dry ? v : v * rs * gg;
        }
    }
}
__device__ __forceinline__ float bf2f(bf16_t b) { return __uint_as_float(((unsigned)b) << 16); }
__device__ __forceinline__ float quad_sum(float x) {
    x += __int_as_float(__builtin_amdgcn_update_dpp(0, __float_as_int(x), 0xB1, 0xF, 0xF, true));
    x += __int_as_float(__builtin_amdgcn_update_dpp(0, __float_as_int(x), 0x4E, 0xF, 0xF, true));
    return x;
}
__device__ __forceinline__ float wave_sum(float x) {
    x += __int_as_float(__builtin_amdgcn_update_dpp(0, __float_as_int(x), 0xB1, 0xF, 0xF, true));
    x += __int_as_float(__builtin_amdgcn_update_dpp(0, __float_as_int(x), 0x4E, 0xF, 0xF, true));
    x += __int_as_float(__builtin_amdgcn_update_dpp(0, __float_as_int(x), 0x124, 0xF, 0xF, true));
    x += __int_as_float(__builtin_amdgcn_update_dpp(0, __float_as_int(x), 0x128, 0xF, 0xF, true));
    const int xi = __float_as_int(x);
    return (__int_as_float(__builtin_amdgcn_readlane(xi, 0)) + __int_as_float(__builtin_amdgcn_readlane(xi, 16))) + (__int_as_float(__builtin_amdgcn_readlane(xi, 32)) + __int_as_float(__builtin_amdgcn_readlane(xi, 48)));
}
__device__ __forceinline__ float softplusf_(float x) { return fmaxf(x, 0.f) + __logf(1.0f + __expf(-fabsf(x))); }
__device__ __forceinline__ float tanhf_(float x) { return 1.0f - 2.0f * __builtin_amdgcn_rcpf(1.0f + __expf(2.0f * x)); }
__device__ __forceinline__ f32x2 lo2(f32x4 v) { return __builtin_shufflevector(v, v, 0, 1); }
__device__ __forceinline__ f32x2 hi2(f32x4 v) { return __builtin_shufflevector(v, v, 2, 3); }
__device__ __forceinline__ f32x2 bc2(float x) { return (f32x2){x, x}; }

struct Seg { int row0, nsteps, prevkind; const float* prevptr; };
__device__ __forceinline__ float seg_prev0(const bf16_t* P, const Seg& sg, int col) {
    float prev = 0.f;
    if (sg.prevkind == 1) prev = bf2f(P[(size_t)(sg.row0 - 1) * NIN + col]);
    else if (sg.prevkind == 2) prev = sg.prevptr[col];
    return prev;
}
__device__ __forceinline__ float xs_lerp(const bf16_t* P, const Seg& sg, int i, int col, float mu, float prev0) {
    const float cur = bf2f(P[(size_t)(sg.row0 + i) * NIN + col]);
    const float pr = bf2f(P[(size_t)(sg.row0 + (i > 0 ? i - 1 : 0)) * NIN + col]);
    const float prev = i == 0 ? prev0 : pr;
    return cur + (prev - cur) * mu;
}
__device__ __forceinline__ void load16(const LAS float* src, f32x2 (&d)[8]) {
    const LAS f32x4* s4 = (const LAS f32x4*)src;
#pragma unroll
    for (int i = 0; i < 4; ++i) { const f32x4 v = s4[i]; d[2 * i] = lo2(v); d[2 * i + 1] = hi2(v); }
}

constexpr int RST = 384;
__device__ __forceinline__ void rwkv_a_task(const Params& p, LAS unsigned char* lds, int tk, int mode) {
    const int tid = tid_opaque(), wave = tid >> 6, lane = tid & 63;
    const bf16_t* P = (const bf16_t*)(p.ws + WS_PACT);
    Seg sg; int ci, g;
    if (tk < 256) { const int c = tk >> 1; g = tk & 1; sg.row0 = c * 128; sg.nsteps = 128; sg.prevkind = c == 0 ? 0 : 1; sg.prevptr = nullptr; ci = c; }
    else { const int b = (tk - 256) >> 1; g = (tk - 256) & 1; sg.row0 = MPROMPT + b * 16; sg.nsteps = 16; sg.prevkind = 2; sg.prevptr = p.in[2] + (size_t)b * ACOLS; ci = 128 + b; }
    LAS float* stage = (LAS float*)lds;
    LAS float* bcs = (LAS float*)(lds + 98304) + wave * 512;
    const float* mu = p.in[11];
    const int phl = wave & 3, ptb = (wave >> 2) * 8, hd = g * 4 + phl, C = hd * 64 + lane;
    const float mu_r = mu[C], mu_k = mu[512 + C], mu_v = mu[1024 + C], mu_x = mu[1536 + lane];
    const float w0c = p.in[12][C], a0c = p.in[14][C], kkc = p.in[17][C], kac = p.in[18][C], rkc = p.in[19][C];
    const float pv_r = seg_prev0(P, sg, C), pv_k = seg_prev0(P, sg, 512 + C), pv_v = seg_prev0(P, sg, 1024 + C), pv_x = seg_prev0(P, sg, 1536 + lane);
    const float* wup = p.in[13] + C; const float* aup = p.in[15] + C;
    float* bonus = (float*)(p.ws + WS_BONUS);
    const bool isH = wave >= 4; const int rhd = g * 4 + (wave & 3), rg = lane >> 2, ks = lane & 3;
    f32x2 s[4][8];
#pragma unroll
    for (int r = 0; r < 4; ++r)
#pragma unroll
        for (int j = 0; j < 8; ++j) { s[r][j].x = (!isH && (rg * 4 + r == ks * 16 + 2 * j)) ? 1.f : 0.f; s[r][j].y = (!isH && (rg * 4 + r == ks * 16 + 2 * j + 1)) ? 1.f : 0.f; }
    bf16_t* Yb = (bf16_t*)(p.ws + WS_Y); bf16_t* HB = (bf16_t*)(p.ws + WS_HB);
    bf16_t raw[9][4];
#define RW_LOAD(sbn) do { _Pragma("unroll") for (int i = 0; i < 9; ++i) { const int ti_ = (sbn) * 16 + ptb + i - 1; const bf16_t* rp_ = P + (size_t)(sg.row0 + (ti_ < 0 ? 0 : ti_)) * NIN; \
        raw[i][0] = rp_[C]; raw[i][1] = rp_[512 + C]; raw[i][2] = rp_[1024 + C]; raw[i][3] = rp_[1536 + lane]; } } while (0)
    RW_LOAD(0);
    for (int sb = 0; sb < sg.nsteps / 16; ++sb) {
        if (!(mode & 4)) {
#pragma unroll
            for (int i = 0; i < 8; ++i) { const float cur = bf2f(raw[i + 1][3]), prev = (sb * 16 + ptb + i == 0) ? pv_x : bf2f(raw[i][3]); float xv = cur + (prev - cur) * mu_x; if (lane < 32) xv = tanhf_(xv); bcs[i * 64 + lane] = xv; }
            float wl[8], al[8];
#pragma unroll
            for (int i = 0; i < 8; ++i) { wl[i] = w0c; al[i] = a0c; }
#pragma unroll 2
            for (int j4 = 0; j4 < 8; ++j4) {
                float wu[4], au[4];
#pragma unroll
                for (int e = 0; e < 4; ++e) { wu[e] = wup[(size_t)(j4 * 4 + e) * 512]; au[e] = aup[(size_t)(j4 * 4 + e) * 512]; }
#pragma unroll
                for (int i = 0; i < 8; ++i) {
                    const f32x4 t4 = *(const LAS f32x4*)(bcs + i * 64 + j4 * 4), x4 = *(const LAS f32x4*)(bcs + i * 64 + 32 + j4 * 4);
#pragma unroll
                    for (int e = 0; e < 4; ++e) { wl[i] += t4[e] * wu[e]; al[i] += x4[e] * au[e]; }
                }
            }
            float rr[8], kr[8], vr[8];
#pragma unroll
            for (int i = 0; i < 8; ++i) { const bool f0 = (sb * 16 + ptb + i == 0);
                const float cr = bf2f(raw[i + 1][0]), ck = bf2f(raw[i + 1][1]), cv = bf2f(raw[i + 1][2]);
                const float qr = f0 ? pv_r : bf2f(raw[i][0]), qk = f0 ? pv_k : bf2f(raw[i][1]), qv = f0 ? pv_v : bf2f(raw[i][2]);
                rr[i] = cr + (qr - cr) * mu_r; kr[i] = ck + (qk - ck) * mu_k; vr[i] = cv + (qv - cv) * mu_v; }
#pragma unroll
            for (int i = 0; i < 8; ++i) {
                const int ti = sb * 16 + ptb + i, row = sg.row0 + ti;
                const float r = rr[i], k = kr[i], v = vr[i];
                const float wlog = -softplusf_(-wl[i]) - 0.5f, dec = __expf(-__expf(wlog));
                const float a = sigmoidf_(al[i]);
                float kk = k * kkc; const float n2 = wave_sum(kk * kk); kk = kk / fmaxf(sqrtf(n2), 1e-12f);
                const float kmod = k * (1.0f + (a - 1.0f) * kac), kka = kk * a;
                const float bs = wave_sum(r * kmod * rkc);
                if (lane == 0) bonus[(size_t)row * 8 + hd] = bs;
                LAS float* st = stage + ((ptb + i) * 4 + phl) * RST;
                st[lane] = dec; st[64 + lane] = kk; st[128 + lane] = kka; st[192 + lane] = kmod; st[256 + lane] = r; st[320 + lane] = v;
            }
        }
        __syncthreads();
        if (sb + 1 < sg.nsteps / 16) RW_LOAD(sb + 1);
        if (!(mode & 8)) for (int tl = 0; tl < 16; ++tl) {
            const LAS float* st = stage + (tl * 4 + (wave & 3)) * RST;
            const int row = sg.row0 + sb * 16 + tl;
            f32x2 w2[8], kk2[8], ka2[8], r2[8];
            load16(st + ks * 16, w2); load16(st + 64 + ks * 16, kk2); load16(st + 128 + ks * 16, ka2); load16(st + 256 + ks * 16, r2);
            float sa[4];
#pragma unroll
            for (int r = 0; r < 4; ++r) { f32x2 acc = s[r][0] * kk2[0];
#pragma unroll
                for (int j = 1; j < 8; ++j) acc = s[r][j] * kk2[j] + acc;
                sa[r] = quad_sum(acc.x + acc.y); }
            float yo[4];
            if (!isH) {
#pragma unroll
                for (int r = 0; r < 4; ++r) { const f32x2 nsa = bc2(-sa[r]);
#pragma unroll
                    for (int j = 0; j < 8; ++j) s[r][j] = s[r][j] * w2[j] + nsa * ka2[j]; }
            } else {
                f32x2 km2[8]; load16(st + 192 + ks * 16, km2);
                const f32x4 v4 = *(const LAS f32x4*)(st + 320 + rg * 4);
#pragma unroll
                for (int r = 0; r < 4; ++r) { const f32x2 nsa = bc2(-sa[r]), vv = bc2(v4[r]);
#pragma unroll
                    for (int j = 0; j < 8; ++j) s[r][j] = (s[r][j] * w2[j] + nsa * ka2[j]) + vv * km2[j]; }
            }
#pragma unroll
            for (int r = 0; r < 4; ++r) { f32x2 acc = s[r][0] * r2[0];
#pragma unroll
                for (int j = 1; j < 8; ++j) acc = s[r][j] * r2[j] + acc;
                yo[r] = quad_sum(acc.x + acc.y); }
            if (ks == 0) {
                u32x2 w; w.x = cvt_pk_bf16(yo[0], yo[1]); w.y = cvt_pk_bf16(yo[2], yo[3]);
                if (!isH) *(u32x2*)(Yb + (size_t)row * 512 + rhd * 64 + rg * 4) = w;
                else *(u32x2*)(HB + (size_t)row * 1024 + rhd * 64 + rg * 4) = w;
            }
        }
        __syncthreads();
    }
    if (!isH) {
        bf16_t* Gf = (bf16_t*)(p.ws + WS_G) + (size_t)(ci * 8 + rhd) * 4096;
#pragma unroll
        for (int j = 0; j < 8; ++j)
#pragma unroll
            for (int h = 0; h < 2; ++h) {
                const int jj = 2 * j + h;
                u32x2 w; w.x = cvt_pk_bf16(h ? s[0][j].y : s[0][j].x, h ? s[1][j].y : s[1][j].x); w.y = cvt_pk_bf16(h ? s[2][j].y : s[2][j].x, h ? s[3][j].y : s[3][j].x);
                *(u32x2*)(Gf + (size_t)((ks * 2 + (rg >> 3)) * 64 + (rg & 3) * 16 + jj) * 8 + ((rg >> 2) & 1) * 4) = w;
            }
    } else {
        float* Hs = (float*)(p.ws + WS_HSR) + (size_t)(ci * 8 + rhd) * 4096;
#pragma unroll
        for (int r = 0; r < 4; ++r)
#pragma unroll
            for (int q = 0; q < 4; ++q) *(f32x4*)(Hs + (rg * 4 + r) * 64 + ks * 16 + q * 4) = (f32x4){s[r][2 * q].x, s[r][2 * q].y, s[r][2 * q + 1].x, s[r][2 * q + 1].y};
    }
}

constexpr int GST = 320;
__device__ __forceinline__ void gla_a_task(const Params& p, LAS unsigned char* lds, int tk) {
    const int tid = tid_opaque(), wave = tid >> 6, lane = tid & 63;
    const bf16_t* P = (const bf16_t*)(p.ws + WS_PACT) + BOFF;
    int row0, nsteps, ci;
    if (tk < 256) { row0 = tk * 64; nsteps = 64; ci = tk; } else { row0 = MPROMPT + (tk - 256) * 16; nsteps = 16; ci = tk; }
    LAS float* stage = (LAS float*)lds;
    LAS float* red = (LAS float*)(lds + 98304);
    const int hd = wave >> 1, half = wave & 1, rg = lane >> 2, ks = lane & 3;
    const int kc = hd * 64 + lane;
    float gku[16];
#pragma unroll
    for (int j = 0; j < 16; ++j) gku[j] = p.in[22][j * 256 + kc];
    const float gkb = p.in[23][kc];
    float lsum = 0.f;
    f32x2 s[4][8];
#pragma unroll
    for (int r = 0; r < 4; ++r)
#pragma unroll
        for (int j = 0; j < 8; ++j) s[r][j] = (f32x2){0.f, 0.f};
    bf16_t* HB = (bf16_t*)(p.ws + WS_HB);
    unsigned gxw; bf16_t graw[8][4];
#define GL_LOAD(sbn) do { gxw = *(const unsigned*)(P + (size_t)(row0 + (sbn) * 16 + half * 8 + (lane >> 3)) * NIN + 1024 + (lane & 7) * 2); \
        _Pragma("unroll") for (int i = 0; i < 8; ++i) { const bf16_t* pr_ = P + (size_t)(row0 + (sbn) * 16 + half * 8 + i) * NIN; graw[i][0] = pr_[256 + kc]; graw[i][1] = pr_[kc]; graw[i][2] = pr_[512 + hd * 128 + lane]; graw[i][3] = pr_[512 + hd * 128 + 64 + lane]; } } while (0)
    GL_LOAD(0);
    for (int sb = 0; sb < nsteps / 16; ++sb) {
        {
            LAS float* xg = (LAS float*)(lds + 81920) + wave * 128;
            { const int j2 = (lane & 7) * 2; xg[(lane >> 3) * 16 + j2] = __uint_as_float(gxw << 16); xg[(lane >> 3) * 16 + j2 + 1] = __uint_as_float(gxw & 0xffff0000u); }
            float kv[8], qv[8], v0[8], v1[8]; float bsub = 0.f;
#pragma unroll
            for (int i = 0; i < 8; ++i) { kv[i] = bf2f(graw[i][0]); qv[i] = bf2f(graw[i][1]) * 0.125f; v0[i] = bf2f(graw[i][2]); v1[i] = bf2f(graw[i][3]); }
#pragma unroll
            for (int i = 0; i < 8; ++i) {
                const int tl = half * 8 + i;
                float gl = gkb;
#pragma unroll
                for (int j4 = 0; j4 < 4; ++j4) { const f32x4 x4 = *(const LAS f32x4*)(xg + i * 16 + j4 * 4); gl += x4[0] * gku[j4 * 4] + x4[1] * gku[j4 * 4 + 1] + x4[2] * gku[j4 * 4 + 2] + x4[3] * gku[j4 * 4 + 3]; }
                const float la = -softplusf_(-gl) * (1.0f / 16.0f);
                lsum += la; bsub += la;
                LAS float* st = stage + (tl * 4 + hd) * GST;
                st[lane] = __expf(la); st[64 + lane] = kv[i]; st[128 + lane] = qv[i]; st[192 + lane] = v0[i]; st[256 + lane] = v1[i];
            }
            ((float*)(p.ws + WS_GBS))[(size_t)((((ci * 4 + sb) * 4 + hd) * 2 + half)) * 64 + lane] = bsub;
        }
        __syncthreads();
        if (sb + 1 < nsteps / 16) GL_LOAD(sb + 1);
        for (int tl = 0; tl < 16; ++tl) {
            const LAS float* st = stage + (tl * 4 + hd) * GST;
            const int row = row0 + sb * 16 + tl;
            f32x2 a2[8], k2[8], q2[8];
            load16(st + ks * 16, a2); load16(st + 64 + ks * 16, k2); load16(st + 128 + ks * 16, q2);
            const f32x4 v4 = *(const LAS f32x4*)(st + 192 + half * 64 + rg * 4);
            float zo[4];
#pragma unroll
            for (int r = 0; r < 4; ++r) { const f32x2 vv = bc2(v4[r]); f32x2 acc = (f32x2){0.f, 0.f};
#pragma unroll
                for (int j = 0; j < 8; ++j) { s[r][j] = s[r][j] * a2[j] + vv * k2[j]; acc = s[r][j] * q2[j] + acc; }
                zo[r] = quad_sum(acc.x + acc.y); }
            if (ks == 0) { u32x2 w; w.x = cvt_pk_bf16(zo[0], zo[1]); w.y = cvt_pk_bf16(zo[2], zo[3]);
                *(u32x2*)(HB + (size_t)row * 1024 + 512 + hd * 128 + half * 64 + rg * 4) = w; }
        }
        __syncthreads();
    }
    float* Hs = (float*)(p.ws + WS_HSG) + (size_t)(ci * 4 + hd) * 8192;
#pragma unroll
    for (int j = 0; j < 8; ++j) {
        *(f32x4*)(Hs + (ks * 16 + 2 * j) * 128 + half * 64 + rg * 4) = (f32x4){s[0][j].x, s[1][j].x, s[2][j].x, s[3][j].x};
        *(f32x4*)(Hs + (ks * 16 + 2 * j + 1) * 128 + half * 64 + rg * 4) = (f32x4){s[0][j].y, s[1][j].y, s[2][j].y, s[3][j].y};
    }
    red[wave * 64 + lane] = lsum;
    __syncthreads();
    if (half == 0) ((float*)(p.ws + WS_DECG))[(size_t)(ci * 4 + hd) * 64 + lane] = __expf(red[wave * 64 + lane] + red[(wave + 1) * 64 + lane]);
    __syncthreads();
}
__device__ __forceinline__ bf16x8 pack8(const float (&v)[8]);
typedef short bf16x4 __attribute__((ext_vector_type(4)));
typedef __bf16 bf16v2 __attribute__((ext_vector_type(2)));
__device__ __forceinline__ unsigned cvt_pk_native(float a, float b) { const f32x2 v = (f32x2){a, b}; const bf16v2 r = __builtin_convertvector(v, bf16v2); return __builtin_bit_cast(unsigned, r); }
__device__ __forceinline__ bf16x8 pack4z(float a, float b, float c, float d) { u32x4 w; w.x = cvt_pk_bf16(a, b); w.y = cvt_pk_bf16(c, d); w.z = 0u; w.w = 0u; return __builtin_bit_cast(bf16x8, w); }
__device__ __forceinline__ void gla_a_wave_task(const Params& p, LAS unsigned char* wl8, int ci, int row0, int nblk, int hd, int sel) {
    const int lane = tid_opaque() & 63, n = lane & 15, q = lane >> 4, kc = hd * 64 + lane;
    const bf16_t* P = (const bf16_t*)(p.ws + WS_PACT) + BOFF; bf16_t* HB = (bf16_t*)(p.ws + WS_HB);
    LAS float* XG = (LAS float*)wl8; LAS bf16_t* QT = (LAS bf16_t*)(wl8 + 1024); LAS bf16_t* KT = (LAS bf16_t*)(wl8 + 3328); LAS bf16_t* KTt = (LAS bf16_t*)(wl8 + 5632); LAS float* BETA = (LAS float*)(wl8 + 8704);
    float gku[16];
#pragma unroll
    for (int j = 0; j < 16; ++j) gku[j] = p.in[22][j * 256 + kc];
    const float gkb = p.in[23][kc];
    f32x4 H[4][8];
#pragma unroll
    for (int kt = 0; kt < 4; ++kt)
#pragma unroll
        for (int vt = 0; vt < 8; ++vt) H[kt][vt] = (f32x4){0.f, 0.f, 0.f, 0.f};
    float lsum = 0.f;
    for (int blk = 0; blk < nblk; ++blk) {
        const int rowb = row0 + blk * 16;
        { const int idx = lane * 4, tk = idx >> 4, j = idx & 15;
          const u32x2 xw = *(const u32x2*)(P + (size_t)(rowb + tk) * NIN + 1024 + j);
          *(LAS f32x4*)(XG + idx) = (f32x4){__uint_as_float(xw.x << 16), __uint_as_float(xw.x & 0xffff0000u), __uint_as_float(xw.y << 16), __uint_as_float(xw.y & 0xffff0000u)}; }
        unsigned qkr[16];
#pragma unroll
        for (int i = 0; i < 16; ++i) { const bf16_t* pr = P + (size_t)(rowb + i) * NIN; qkr[i] = (unsigned)pr[kc] | ((unsigned)pr[256 + kc] << 16); }
        float bsub = 0.f;
#pragma unroll
        for (int i = 0; i < 16; ++i) {
            float gl = gkb;
#pragma unroll
            for (int j4 = 0; j4 < 4; ++j4) { const f32x4 x4 = *(const LAS f32x4*)(XG + i * 16 + j4 * 4); gl += x4[0] * gku[j4 * 4] + x4[1] * gku[j4 * 4 + 1] + x4[2] * gku[j4 * 4 + 2] + x4[3] * gku[j4 * 4 + 3]; }
            bsub += -softplusf_(-gl) * (1.0f / 16.0f);
            const unsigned qk = cvt_pk_bf16(__uint_as_float(qkr[i] << 16) * 0.125f * __expf(bsub), __uint_as_float(qkr[i] & 0xffff0000u) * __expf(-bsub));
            QT[i * 72 + lane] = (bf16_t)(qk & 0xffffu); KT[i * 72 + lane] = (bf16_t)(qk >> 16); KTt[lane * 24 + i] = (bf16_t)(qk >> 16);
        }
        BETA[lane] = __expf(bsub); lsum += bsub;
        asm volatile("" ::: "memory");
        if (sel & 4) { float* gb = (float*)(p.ws + WS_GBS) + (size_t)(((ci * 4 + blk) * 4 + hd) * 2) * 64 + lane; gb[0] = bsub; gb[64] = 0.f; }
        u32x2 VP[8];
#pragma unroll
        for (int vt = 0; vt < 8; ++vt) { const bf16_t* vp = P + (size_t)(rowb + 4 * q) * NIN + 512 + hd * 128 + vt * 16 + n;
            VP[vt].x = (unsigned)vp[0] | ((unsigned)vp[NIN] << 16); VP[vt].y = (unsigned)vp[2 * NIN] | ((unsigned)vp[3 * NIN] << 16); }
#define VF(vt) __builtin_bit_cast(bf16x8, (u32x4){VP[vt].x, VP[vt].y, 0u, 0u})
        f32x4 sc = (f32x4){0.f, 0.f, 0.f, 0.f};
#pragma unroll
        for (int kh = 0; kh < 2; ++kh) sc = __builtin_amdgcn_mfma_f32_16x16x32_bf16(*(const LAS bf16x8*)(KT + n * 72 + kh * 32 + q * 8), *(const LAS bf16x8*)(QT + n * 72 + kh * 32 + q * 8), sc, 0, 0, 0);
        const bf16x8 SCB = pack4z(4 * q + 0 <= n ? sc[0] : 0.f, 4 * q + 1 <= n ? sc[1] : 0.f, 4 * q + 2 <= n ? sc[2] : 0.f, 4 * q + 3 <= n ? sc[3] : 0.f);
        bf16x8 QB[2];
#pragma unroll
        for (int kh = 0; kh < 2; ++kh) { const u32x2 a = __builtin_bit_cast(u32x2, *(const LAS bf16x4*)(QT + n * 72 + kh * 32 + 4 * q)), b = __builtin_bit_cast(u32x2, *(const LAS bf16x4*)(QT + n * 72 + kh * 32 + 16 + 4 * q));
            u32x4 w; w.x = a.x; w.y = a.y; w.z = b.x; w.w = b.y; QB[kh] = __builtin_bit_cast(bf16x8, w); }
#pragma unroll
        for (int vt = 0; vt < 8; ++vt) {
            f32x4 z = (f32x4){0.f, 0.f, 0.f, 0.f};
#pragma unroll
            for (int kh = 0; kh < 2; ++kh) { const float hv[8] = {H[2 * kh][vt][0], H[2 * kh][vt][1], H[2 * kh][vt][2], H[2 * kh][vt][3], H[2 * kh + 1][vt][0], H[2 * kh + 1][vt][1], H[2 * kh + 1][vt][2], H[2 * kh + 1][vt][3]};
                z = __builtin_amdgcn_mfma_f32_16x16x32_bf16(pack8(hv), QB[kh], z, 0, 0, 0); }
            z = __builtin_amdgcn_mfma_f32_16x16x32_bf16(VF(vt), SCB, z, 0, 0, 0);
            u32x2 w; w.x = cvt_pk_native(z[0], z[1]); w.y = cvt_pk_native(z[2], z[3]);
            if (sel & 1) *(u32x2*)(HB + (size_t)(rowb + n) * 1024 + 512 + hd * 128 + vt * 16 + 4 * q) = w;
        }
#pragma unroll
        for (int kt = 0; kt < 4; ++kt) {
            const u32x2 ka = __builtin_bit_cast(u32x2, *(const LAS bf16x4*)(KTt + (kt * 16 + n) * 24 + 4 * q));
            u32x4 kw; kw.x = ka.x; kw.y = ka.y; kw.z = 0u; kw.w = 0u; const bf16x8 KA = __builtin_bit_cast(bf16x8, kw);
            const f32x4 b4 = *(const LAS f32x4*)(BETA + kt * 16 + 4 * q);
#pragma unroll
            for (int vt = 0; vt < 8; ++vt) H[kt][vt] = __builtin_amdgcn_mfma_f32_16x16x32_bf16(KA, VF(vt), H[kt][vt], 0, 0, 0) * b4;
        }
    }
#undef VF
    float* Hs = (float*)(p.ws + WS_HSG) + (size_t)(ci * 4 + hd) * 8192;
#pragma unroll
    for (int kt = 0; kt < 4; ++kt)
#pragma unroll
        for (int vt = 0; vt < 8; ++vt)
#pragma unroll
            for (int i = 0; i < 4; ++i) if (sel & 2) Hs[(kt * 16 + 4 * q + i) * 128 + vt * 16 + n] = H[kt][vt][i];
    if (sel & 4) ((float*)(p.ws + WS_DECG))[(size_t)(ci * 4 + hd) * 64 + lane] = __expf(lsum);
}
__device__ __forceinline__ void phase_mix_a2(const Params& p, LAS unsigned char* lds, int sel) {
    const int wave = tid_opaque() >> 6, skip = gridDim.x >= 64 ? 32 : 0, ng = (int)gridDim.x - skip, nw = ng * 8;
    if ((int)blockIdx.x >= skip) for (int j = wave * ng + ((int)blockIdx.x - skip); j < 1088; j += nw) {
        int ci, row0, nblk, hd;
        if (j < 1024) { ci = j >> 2; row0 = ci * 64; nblk = 4; hd = j & 3; }
        else { const int r = j - 1024, sb = r >> 2; ci = 256 + sb; row0 = MPROMPT + sb * 16; nblk = 1; hd = r & 3; }
        gla_a_wave_task(p, lds + wave * 16384, ci, row0, nblk, hd, sel);
    }
}
__device__ __forceinline__ void phase_mix_a(const Params& p, LAS unsigned char* lds, int mask) {
    if (mask & 1) for (int t = blockIdx.x; t < 288; t += gridDim.x) rwkv_a_task(p, lds, t, mask);
    if (mask & 2) phase_mix_a2(p, lds, 7);
}

__device__ __forceinline__ void rwkv_scan_job(const Params& p, int head, int vt, int ci0, int nchunks, const float* S0, float* Sout, int dry) {
    const int lane = tid_opaque() & 63, n = lane & 15, q = lane >> 4, v = vt * 16 + n;
    f32x4 D[4];
#pragma unroll
    for (int jt = 0; jt < 4; ++jt) D[jt] = S0 ? *(const f32x4*)(S0 + v * 64 + jt * 16 + q * 4) : (f32x4){0.f, 0.f, 0.f, 0.f};
    for (int c = 0; c < nchunks; ++c) {
        const int ci = ci0 + c;
        float* HS = (float*)(p.ws + WS_HSR) + (size_t)(ci * 8 + head) * 4096;
        const bf16x8* Gf = (const bf16x8*)(p.ws + WS_G + (size_t)(ci * 8 + head) * 8192);
        f32x4 Hc[4]; bf16x8 A[4][2];
#pragma unroll
        for (int jt = 0; jt < 4; ++jt) { Hc[jt] = *(const f32x4*)(HS + v * 64 + jt * 16 + q * 4); A[jt][0] = Gf[(jt * 2 + 0) * 64 + lane]; A[jt][1] = Gf[(jt * 2 + 1) * 64 + lane]; }
#pragma unroll
        for (int jt = 0; jt < 4; ++jt) *(f32x4*)(HS + v * 64 + jt * 16 + q * 4) = dry ? Hc[jt] : D[jt];
        bf16x8 B[2];
#pragma unroll
        for (int kh = 0; kh < 2; ++kh) { u32x4 w; w.x = cvt_pk_native(D[2 * kh][0], D[2 * kh][1]); w.y = cvt_pk_native(D[2 * kh][2], D[2 * kh][3]);
            w.z = cvt_pk_native(D[2 * kh + 1][0], D[2 * kh + 1][1]); w.w = cvt_pk_native(D[2 * kh + 1][2], D[2 * kh + 1][3]); B[kh] = __builtin_bit_cast(bf16x8, w); }
#pragma unroll
        for (int jt = 0; jt < 4; ++jt) { f32x4 d = __builtin_amdgcn_mfma_f32_16x16x32_bf16(A[jt][0], B[0], Hc[jt], 0, 0, 0); D[jt] = __builtin_amdgcn_mfma_f32_16x16x32_bf16(A[jt][1], B[1], d, 0, 0, 0); }
    }
#pragma unroll
    for (int jt = 0; jt < 4; ++jt) *(f32x4*)(Sout + v * 64 + jt * 16 + q * 4) = D[jt];
}
constexpr int SC_SLOT = 12544, SC_NB = 8;
__device__ __forceinline__ void rwkv_scan_prompt(const Params& p, LAS unsigned char* lds, int head, int vt, int dry) {
    const int tid = tid_opaque(), wave = tid >> 6, lane = tid & 63, n = lane & 15, q = lane >> 4, v = vt * 16 + n;
    const unsigned char* Gb = p.ws + WS_G; unsigned char* Hb = p.ws + WS_HSR;
    u32x4 pfA[12], pfB[12];
    unsigned off0[12], hmask = 0u;
#pragma unroll
    for (int i = 0; i < 12; ++i) { const int qd = tid + 512 * i, cl = qd / 768, wi = qd % 768;
        off0[i] = wi < 512 ? (unsigned)(WS_G + (size_t)(cl * 8 + head) * 8192 + wi * 16) : (unsigned)(WS_HSR + ((size_t)(cl * 8 + head) * 4096 + vt * 1024) * 4 + (wi - 512) * 16);
        hmask |= (wi < 512 ? 0u : 1u) << i; }
#define SC_ISSUE(pf, batch) do { _Pragma("unroll") for (int i = 0; i < 12; ++i) { \
        const unsigned o_ = off0[i] + (unsigned)(batch) * ((unsigned)(SC_NB * 8 * 8192) << ((hmask >> i) & 1u)); pf[i] = *(const u32x4*)(p.ws + o_); } } while (0)
#define SC_COMMIT(pf) do { _Pragma("unroll") for (int i = 0; i < 12; ++i) { const int qd = tid + 512 * i, cl = qd / 768, wi = qd % 768; \
        const int dst = cl * SC_SLOT + (wi < 512 ? wi * 16 : 8192 + ((wi - 512) >> 4) * 272 + ((wi - 512) & 15) * 16); *(LAS u32x4*)(lds + dst) = pf[i]; } } while (0)
#define SC_COMPUTE(bb) do { if (wave == 0) { for (int cl = 0; cl < SC_NB; ++cl) { \
                const int ci = (bb) * SC_NB + cl; const LAS unsigned char* sl = lds + cl * SC_SLOT; \
                float* HS = (float*)Hb + (size_t)(ci * 8 + head) * 4096; \
                f32x4 Hc[4]; bf16x8 A[4][2]; \
                _Pragma("unroll") for (int jt = 0; jt < 4; ++jt) { Hc[jt] = *(const LAS f32x4*)(sl + 8192 + n * 272 + (jt * 4 + q) * 16); \
                    A[jt][0] = *(const LAS bf16x8*)(sl + ((jt * 2 + 0) * 64 + lane) * 16); A[jt][1] = *(const LAS bf16x8*)(sl + ((jt * 2 + 1) * 64 + lane) * 16); } \
                _Pragma("unroll") for (int jt = 0; jt < 4; ++jt) *(f32x4*)(HS + v * 64 + jt * 16 + q * 4) = dry ? Hc[jt] : D[jt]; \
                bf16x8 B[2]; \
                _Pragma("unroll") for (int kh = 0; kh < 2; ++kh) { u32x4 w; w.x = cvt_pk_native(D[2 * kh][0], D[2 * kh][1]); w.y = cvt_pk_native(D[2 * kh][2], D[2 * kh][3]); \
                    w.z = cvt_pk_native(D[2 * kh + 1][0], D[2 * kh + 1][1]); w.w = cvt_pk_native(D[2 * kh + 1][2], D[2 * kh + 1][3]); B[kh] = __builtin_bit_cast(bf16x8, w); } \
                _Pragma("unroll") for (int jt = 0; jt < 4; ++jt) { f32x4 d = __builtin_amdgcn_mfma_f32_16x16x32_bf16(A[jt][0], B[0], Hc[jt], 0, 0, 0); D[jt] = __builtin_amdgcn_mfma_f32_16x16x32_bf16(A[jt][1], B[1], d, 0, 0, 0); } \
            } } } while (0)
    f32x4 D[4];
#pragma unroll
    for (int jt = 0; jt < 4; ++jt) D[jt] = (f32x4){0.f, 0.f, 0.f, 0.f};
    constexpr int NBT = 128 / SC_NB;
    SC_ISSUE(pfA, 0); SC_COMMIT(pfA);
    __syncthreads();
    SC_ISSUE(pfA, 1); SC_ISSUE(pfB, 2);
    for (int b = 0; b < NBT; b += 2) {
        SC_COMPUTE(b);
        __syncthreads();
        SC_COMMIT(pfA);
        { const int nb_ = b + 3 < NBT ? b + 3 : NBT - 1; SC_ISSUE(pfA, nb_); }
        __syncthreads();
        SC_COMPUTE(b + 1);
        __syncthreads();
        SC_COMMIT(pfB);
        { const int nb_ = b + 4 < NBT ? b + 4 : NBT - 1; SC_ISSUE(pfB, nb_); }
        __syncthreads();
    }
#undef SC_COMPUTE
    if (wave == 0) {
        float* Sout = p.out + O_WKV_P + (size_t)head * 4096;
#pragma unroll
        for (int jt = 0; jt < 4; ++jt) *(f32x4*)(Sout + v * 64 + jt * 16 + q * 4) = D[jt];
    }
#undef SC_ISSUE
#undef SC_COMMIT
}
__device__ __forceinline__ void phase_scan(const Params& p, LAS unsigned char* lds, int dry) {
    const int tid = tid_opaque(), wave = tid >> 6, b = blockIdx.x;
    float* HSG = (float*)(p.ws + WS_HSG); const float* DEC = (const float*)(p.ws + WS_DECG);
    if (b < 32) rwkv_scan_prompt(p, lds, b >> 2, b & 3, dry);
    else if (b < 96) {
        const int e = (b - 32) * 512 + tid, hd = e >> 13, k = (e >> 7) & 63;
        float S = 0.f;
        for (int c = 0; c < 256; c += 32) {
            float t[32], d[32];
#pragma unroll
            for (int u = 0; u < 32; ++u) { t[u] = HSG[(size_t)(c + u) * 32768 + e]; d[u] = DEC[(size_t)((c + u) * 4 + hd) * 64 + k]; }
#pragma unroll
            for (int u = 0; u < 32; ++u) { HSG[(size_t)(c + u) * 32768 + e] = dry ? t[u] : S; S = S * d[u] + t[u]; }
        }
        p.out[O_GLA_P + e] = S;
    } else {
        const int nb = gridDim.x - 96, bb = b - 96;
        for (int j = bb * 8 + wave; j < 512; j += nb * 8) { const int sb = j >> 5, hd = (j >> 2) & 7, vt = j & 3;
            rwkv_scan_job(p, hd, vt, 128 + sb, 1, p.in[3] + (size_t)(sb * 8 + hd) * 4096, p.out + O_WKV_S + (size_t)(sb * 8 + hd) * 4096, dry); }
        for (int i = bb * 512 + tid; i < 16 * 8192; i += nb * 512) { const int sb = i >> 13, e = (i & 8191) * 4, hd = e >> 13, k = (e >> 7) & 63;
            const f32x4 S0 = *(const f32x4*)(p.in[4] + (size_t)sb * 32768 + e); float* hp = HSG + (size_t)(256 + sb) * 32768 + e;
            const f32x4 t = *(const f32x4*)hp; const float d = DEC[(size_t)((256 + sb) * 4 + hd) * 64 + k];
            *(f32x4*)hp = dry ? t : S0; *(f32x4*)(p.out + O_GLA_S + (size_t)sb * 32768 + e) = S0 * d + t; }
    }
}

struct RwkvCConst { bf16x8 GB[4][2]; float lw[4], lb[4], muv[4]; float mug[16]; };
__device__ __forceinline__ float row16_sum(float x) {
    x += __int_as_float(__builtin_amdgcn_update_dpp(0, __float_as_int(x), 0xB1, 0xF, 0xF, true));
    x += __int_as_float(__builtin_amdgcn_update_dpp(0, __float_as_int(x), 0x4E, 0xF, 0xF, true));
    x += __int_as_float(__builtin_amdgcn_update_dpp(0, __float_as_int(x), 0x124, 0xF, 0xF, true));
    x += __int_as_float(__builtin_amdgcn_update_dpp(0, __float_as_int(x), 0x128, 0xF, 0xF, true));
    return x;
}
__device__ __forceinline__ bf16x8 pack8(const float (&v)[8]) {
    u32x4 w; w.x = cvt_pk_bf16(v[0], v[1]); w.y = cvt_pk_bf16(v[2], v[3]); w.z = cvt_pk_bf16(v[4], v[5]); w.w = cvt_pk_bf16(v[6], v[7]); return __builtin_bit_cast(bf16x8, w);
}
__device__ __forceinline__ void unpack8(u32x4 w, float (&v)[8]) {
    v[0] = __uint_as_float(w.x << 16); v[1] = __uint_as_float(w.x & 0xffff0000u); v[2] = __uint_as_float(w.y << 16); v[3] = __uint_as_float(w.y & 0xffff0000u);
    v[4] = __uint_as_float(w.z << 16); v[5] = __uint_as_float(w.z & 0xffff0000u); v[6] = __uint_as_float(w.w << 16); v[7] = __uint_as_float(w.w & 0xffff0000u);
}
__device__ __forceinline__ void rwkv_c_const(const Params& p, int hd, RwkvCConst& K) {
    const int lane = tid_opaque() & 63, n = lane & 15, q = lane >> 4;
#pragma unroll
    for (int nt = 0; nt < 4; ++nt) {
        const int C = hd * 64 + nt * 16 + n;
        K.lw[nt] = p.in[20][C]; K.lb[nt] = p.in[21][C]; K.muv[nt] = p.in[11][1024 + C];
#pragma unroll
        for (int kh = 0; kh < 2; ++kh) { float g[8];
#pragma unroll
            for (int e = 0; e < 8; ++e) g[e] = p.in[16][(size_t)(kh * 32 + q * 8 + e) * 512 + C];
            K.GB[nt][kh] = pack8(g); }
    }
#pragma unroll
    for (int kh = 0; kh < 2; ++kh)
#pragma unroll
        for (int e = 0; e < 8; ++e) K.mug[kh * 8 + e] = p.in[11][1600 + kh * 32 + q * 8 + e];
}
__device__ __forceinline__ void rwkv_c_task(const Params& p, const RwkvCConst& K, int ci, int tok0, int hd, const Seg& sg, int dry) {
    const int lane = tid_opaque() & 63, n = lane & 15, q = lane >> 4;
    const bf16_t* P = (const bf16_t*)(p.ws + WS_PACT);
    const bf16_t* Yb = (const bf16_t*)(p.ws + WS_Y); bf16_t* HB = (bf16_t*)(p.ws + WS_HB);
    const float* Ss = (const float*)(p.ws + WS_HSR) + (size_t)(ci * 8 + hd) * 4096;
    const float* bonus = (const float*)(p.ws + WS_BONUS);
    const int rowb = sg.row0 + tok0;
    bf16x8 SB[4][2]; float bo[4]; bf16_t zr[4][4], cr_[4][4]; float pv0[4];
#pragma unroll
    for (int nt = 0; nt < 4; ++nt)
#pragma unroll
        for (int kh = 0; kh < 2; ++kh) {
            const float* sp = Ss + (nt * 16 + n) * 64 + kh * 32 + q * 8;
            const f32x4 s0 = *(const f32x4*)sp, s1 = *(const f32x4*)(sp + 4);
            const float sv[8] = {s0[0], s0[1], s0[2], s0[3], s1[0], s1[1], s1[2], s1[3]};
            SB[nt][kh] = pack8(sv);
        }
#pragma unroll
    for (int i = 0; i < 4; ++i) bo[i] = bonus[(size_t)(rowb + q * 4 + i) * 8 + hd];
#pragma unroll
    for (int nt = 0; nt < 4; ++nt) {
        const int C = hd * 64 + nt * 16 + n;
        const bool first = (tok0 + q * 4 == 0) && sg.prevkind != 1;
        pv0[nt] = bf2f(P[(size_t)(rowb + q * 4 - (first ? 0 : 1)) * NIN + 1024 + C]);
        if (first) pv0[nt] = sg.prevkind == 2 ? sg.prevptr[1024 + C] : 0.f;
#pragma unroll
        for (int i = 0; i < 4; ++i) { const int row = rowb + q * 4 + i; zr[nt][i] = HB[(size_t)row * 1024 + C]; cr_[nt][i] = P[(size_t)row * NIN + 1024 + C]; }
    }
    bf16x8 AY[2], AG[2];
    {
        const bool first = (tok0 + n == 0) && sg.prevkind != 1;
        const bf16_t* cr = P + (size_t)(rowb + n) * NIN + 1600 + q * 8;
        const bf16_t* pr = P + (size_t)(rowb + n - (first ? 0 : 1)) * NIN + 1600 + q * 8;
#pragma unroll
        for (int kh = 0; kh < 2; ++kh) {
            AY[kh] = *(const bf16x8*)(Yb + (size_t)(rowb + n) * 512 + hd * 64 + kh * 32 + q * 8);
            float c8[8], p8[8];
            unpack8(*(const u32x4*)(cr + kh * 32), c8); unpack8(*(const u32x4*)(pr + kh * 32), p8);
            if (first) {
#pragma unroll
                for (int e = 0; e < 8; ++e) p8[e] = sg.prevkind == 2 ? sg.prevptr[1600 + kh * 32 + q * 8 + e] : 0.f;
            }
#pragma unroll
            for (int e = 0; e < 8; ++e) c8[e] = sigmoidf_(c8[e] + (p8[e] - c8[e]) * K.mug[kh * 8 + e]);
            AG[kh] = pack8(c8);
        }
    }
    f32x4 D[4], G[4];
#pragma unroll
    for (int nt = 0; nt < 4; ++nt) {
        f32x4 d = (f32x4){0.f, 0.f, 0.f, 0.f}, g = (f32x4){0.f, 0.f, 0.f, 0.f};
#pragma unroll
        for (int kh = 0; kh < 2; ++kh) {
            d = __builtin_amdgcn_mfma_f32_16x16x32_bf16(AY[kh], SB[nt][kh], d, 0, 0, 0);
            g = __builtin_amdgcn_mfma_f32_16x16x32_bf16(AG[kh], K.GB[nt][kh], g, 0, 0, 0);
        }
        D[nt] = d; G[nt] = g;
    }
    float o[4][4], vv[4][4];
#pragma unroll
    for (int nt = 0; nt < 4; ++nt) {
        float pv = pv0[nt];
#pragma unroll
        for (int i = 0; i < 4; ++i) {
            o[nt][i] = D[nt][i] + bf2f(zr[nt][i]);
            const float cv = bf2f(cr_[nt][i]);
            vv[nt][i] = cv + (pv - cv) * K.muv[nt]; pv = cv;
        }
    }
#pragma unroll
    for (int i = 0; i < 4; ++i) {
        const float mean = row16_sum((o[0][i] + o[1][i]) + (o[2][i] + o[3][i])) * (1.0f / 64.0f);
        float d2 = 0.f;
#pragma unroll
        for (int nt = 0; nt < 4; ++nt) { o[nt][i] -= mean; d2 += o[nt][i] * o[nt][i]; }
        const float rs = rsqrtf(row16_sum(d2) * (1.0f / 64.0f) + 64e-5f);
#pragma unroll
        for (int nt = 0; nt < 4; ++nt) {
            const int C = hd * 64 + nt * 16 + n;
            const float res = (o[nt][i] * rs * K.lw[nt] + K.lb[nt] + bo[i] * vv[nt][i]) * G[nt][i];
            const unsigned rb = cvt_pk_bf16(res, 0.f);
            bf16_t* dp = dry ? (bf16_t*)(p.ws + WS_DUMMY) + (size_t)blockIdx.x * 512 + threadIdx.x : HB + (size_t)(rowb + q * 4 + i) * 1024 + C;
            *dp = (bf16_t)(rb & 0xffffu);
        }
    }
}
__device__ __forceinline__ void gla_c_task(const Params& p, LAS float* wl, int ci, int row0, int rd, int hd, int dry) {
    const int lane = tid_opaque() & 63, n = lane & 15, q = lane >> 4, kc = hd * 64 + lane;
    const bf16_t* P = (const bf16_t*)(p.ws + WS_PACT) + BOFF; bf16_t* HB = (bf16_t*)(p.ws + WS_HB);
    const float* Ss = (const float*)(p.ws + WS_HSG) + (size_t)(ci * 4 + hd) * 8192;
    LAS float* XG = wl; LAS bf16_t* QT = (LAS bf16_t*)(wl + 256);
    const int rowb = row0 + rd * 16;
    float gku[16];
#pragma unroll
    for (int j = 0; j < 16; ++j) gku[j] = p.in[22][j * 256 + kc];
    const float gkb = p.in[23][kc];
    float bsum = 0.f;
    for (int sb = 0; sb < rd; ++sb) { const float* g = (const float*)(p.ws + WS_GBS) + (size_t)(((ci * 4 + sb) * 4 + hd) * 2) * 64 + lane; bsum += g[0]; bsum += g[64]; }
    { const int idx = lane * 4, tk = idx >> 4, j = idx & 15;
      const u32x2 xw = *(const u32x2*)(P + (size_t)(rowb + tk) * NIN + 1024 + j);
      *(LAS f32x4*)(XG + idx) = (f32x4){__uint_as_float(xw.x << 16), __uint_as_float(xw.x & 0xffff0000u), __uint_as_float(xw.y << 16), __uint_as_float(xw.y & 0xffff0000u)}; }
    float qv[16];
#pragma unroll
    for (int i = 0; i < 16; ++i) qv[i] = bf2f(P[(size_t)(rowb + i) * NIN + kc]) * 0.125f;
    bf16x8 B[8][2];
#pragma unroll
    for (int nt = 0; nt < 8; ++nt)
#pragma unroll
        for (int kh = 0; kh < 2; ++kh) { float sv[8];
#pragma unroll
            for (int e = 0; e < 8; ++e) sv[e] = Ss[(size_t)(kh * 32 + q * 8 + e) * 128 + nt * 16 + n];
            B[nt][kh] = pack8(sv); }
    bf16_t zr[4][8], gr[4][8]; float ng[8];
#pragma unroll
    for (int nt = 0; nt < 8; ++nt) ng[nt] = p.in[24][nt * 16 + n];
#pragma unroll
    for (int i = 0; i < 4; ++i) {
        const int row = rowb + q * 4 + i;
#pragma unroll
        for (int nt = 0; nt < 8; ++nt) { zr[i][nt] = HB[(size_t)row * 1024 + 512 + hd * 128 + nt * 16 + n]; gr[i][nt] = P[(size_t)row * NIN + 1040 + hd * 128 + nt * 16 + n]; }
    }
    __builtin_amdgcn_sched_barrier(0);
#pragma unroll
    for (int i = 0; i < 16; ++i) {
        float gl = gkb;
#pragma unroll
        for (int j4 = 0; j4 < 4; ++j4) { const f32x4 x4 = *(const LAS f32x4*)(XG + i * 16 + j4 * 4); gl += x4[0] * gku[j4 * 4] + x4[1] * gku[j4 * 4 + 1] + x4[2] * gku[j4 * 4 + 2] + x4[3] * gku[j4 * 4 + 3]; }
        bsum += -softplusf_(-gl) * (1.0f / 16.0f);
        QT[i * 72 + lane] = (bf16_t)(cvt_pk_bf16(qv[i] * __expf(bsum), 0.f) & 0xffffu);
    }
    bf16x8 A[2];
#pragma unroll
    for (int kh = 0; kh < 2; ++kh) A[kh] = *(const LAS bf16x8*)(QT + n * 72 + kh * 32 + q * 8);
    f32x4 D[8];
#pragma unroll
    for (int nt = 0; nt < 8; ++nt) {
        f32x4 d = (f32x4){0.f, 0.f, 0.f, 0.f};
#pragma unroll
        for (int kh = 0; kh < 2; ++kh) d = __builtin_amdgcn_mfma_f32_16x16x32_bf16(A[kh], B[nt][kh], d, 0, 0, 0);
        D[nt] = d;
    }
#pragma unroll
    for (int i = 0; i < 4; ++i) {
        const int row = rowb + q * 4 + i;
        bf16_t* ob = HB + (size_t)row * 1024 + 512 + hd * 128 + n;
        float o[8], ss = 0.f;
#pragma unroll
        for (int nt = 0; nt < 8; ++nt) { o[nt] = D[nt][i] + bf2f(zr[i][nt]); ss += o[nt] * o[nt]; }
        const float rs = rsqrtf(row16_sum(ss) * (1.0f / 128.0f) + 1e-6f);
#pragma unroll
        for (int nt = 0; nt < 8; ++nt) {
            const float g = bf2f(gr[i][nt]);
            const unsigned rb = cvt_pk_bf16(o[nt] * rs * ng[nt] * g * sigmoidf_(g), 0.f);
            bf16_t* dp = dry ? (bf16_t*)(p.ws + WS_DUMMY) + (size_t)blockIdx.x * 512 + threadIdx.x : ob + nt * 16;
            *dp = (bf16_t)(rb & 0xffffu);
        }
    }
}
__device__ __forceinline__ void phase_mix_c(const Params& p, LAS unsigned char* lds, int dry, int mask) {
    const int wave = tid_opaque() >> 6, widx = wave * (int)gridDim.x + (int)blockIdx.x, nw = gridDim.x * 8;
    LAS float* wl = (LAS float*)(lds + wave * 16384);
    if (mask & 1) for (int j = widx; j < 4160; j += nw) {
        int ci, row0, rd, hd;
        if (j < 4096) { ci = j >> 4; row0 = ci * 64; rd = (j >> 2) & 3; hd = j & 3; }
        else { const int r = j - 4096, sb = r >> 2; ci = 256 + sb; row0 = MPROMPT + sb * 16; rd = 0; hd = r & 3; }
        gla_c_task(p, wl, ci, row0, rd, hd, dry);
    }
    const int jb = (widx + 4160) % nw, js = nw, je = 8320;
    RwkvCConst KC; rwkv_c_const(p, jb & 7, KC);
    if (mask & 2) for (int j = jb; j < je; j += js) {
        Seg sg; int ci, tok0, hd;
        if (j < 8192) { const int c = j >> 6; ci = c; tok0 = ((j >> 3) & 7) * 16; hd = j & 7; sg.row0 = c * 128; sg.nsteps = 128; sg.prevkind = c == 0 ? 0 : 1; sg.prevptr = nullptr; }
        else { const int r = j - 8192, sb = r >> 3; ci = 128 + sb; tok0 = 0; hd = r & 7; sg.row0 = MPROMPT + sb * 16; sg.nsteps = 16; sg.prevkind = 2; sg.prevptr = p.in[2] + (size_t)sb * ACOLS; }
        rwkv_c_task(p, KC, ci, tok0, hd, sg, dry);
    }
}
__global__ void __launch_bounds__(512, 2) fwd_megakernel(Params p) {
    extern __shared__ __attribute__((aligned(16))) unsigned char shm[];
    LAS unsigned char* lds = (LAS unsigned char*)shm;
    cg::grid_group grid = cg::this_grid();
    float* ssq = (float*)(p.ws + WS_SSQ);
    bf16_t* HB = (bf16_t*)(p.ws + WS_HB); bf16_t* HB2 = (bf16_t*)(p.ws + WS_HB2); bf16_t* PACT = (bf16_t*)(p.ws + WS_PACT);
    float* XRES = p.out;
    float* RSTD = (float*)(p.ws + WS_RSTD);
    float* PART = (float*)(p.ws + WS_HSR);
#if BARRIER_KIND == 0
#define GSYNC() grid.sync()
#elif BARRIER_KIND == 1
#define GSYNC() xcd_barrier(xb)
#else
    unsigned bar_round = 0;
    const unsigned bar_g = blockIdx.x & 7u, bar_gsize = (gridDim.x + 7u - bar_g) >> 3, bar_ngrp = gridDim.x < 8u ? gridDim.x : 8u;
#define GSYNC() do { asm volatile("s_waitcnt vmcnt(0)" ::: "memory"); __syncthreads(); if (threadIdx.x == 0) { size_t off_ = WS_BAR + 3520 * 4; asm volatile("" : "+s"(off_)); unsigned* cnt_ = (unsigned*)(p.ws + off_); ++bar_round; \
        __builtin_amdgcn_fence(__ATOMIC_RELEASE, "agent"); \
        const unsigned old_ = __hip_atomic_fetch_add(cnt_ + 64 * (1 + bar_g), 1u, __ATOMIC_RELAXED, __HIP_MEMORY_SCOPE_AGENT); \
        if (old_ + 1u == bar_gsize * bar_round) __hip_atomic_fetch_add(cnt_, 1u, __ATOMIC_RELAXED, __HIP_MEMORY_SCOPE_AGENT); \
        while (__hip_atomic_load(cnt_, __ATOMIC_RELAXED, __HIP_MEMORY_SCOPE_AGENT) < bar_round * bar_ngrp) __builtin_amdgcn_s_sleep(2); \
        __builtin_amdgcn_fence(__ATOMIC_ACQUIRE, "agent"); asm volatile("s_waitcnt vmcnt(0)" ::: "memory"); } __syncthreads(); } while (0)
#endif
#define REPS(k) (1 + (DUP_PHASE == (k) ? DUP_N : 0))
#define PHASE(k, ...) for (int rep_ = 0; rep_ < REPS(k); ++rep_) { int dry = rep_ < REPS(k) - 1; asm volatile("" : "+s"(dry)); __VA_ARGS__ GSYNC(); }
    if (p.ws == nullptr) grid.sync();
    for (int rep_ = 0; rep_ < REPS(0); ++rep_) { phase_convert(p, lds, 2, (int)blockIdx.x, (int)gridDim.x); GSYNC(); }
    if (threadIdx.x == 0) *(LAS u32x4*)(lds + 131072) = (u32x4){0u, 0u, 0u, 0u};
    __syncthreads();
#if BARRIER_KIND == 1
    const XcdBarrier xb = xcd_barrier_post((unsigned*)(p.ws + WS_BAR), (volatile LAS unsigned*)(lds + 131072));
#endif
    PHASE(1, { EpiSwiglu E; E.O = PACT; E.rstd = nullptr; E.nparts = 0; run_gemm(lds, HB, (const bf16_t*)(p.ws + WS_W1GU), 5632, 1024, E); })
    PHASE(2, { const EpiResid E{p.in[0], 0.5f, p.in[1], 0, XRES, HB, ssq + 16 * MROWS, PART}; run_gemm_split(lds, PACT, (const bf16_t*)(p.ws + WS_W1D), FF, E); })
    split_fixup(PART, 11, p.in[1], XRES, HB, ssq + 16 * MROWS, 0.5f, 0, nullptr, RSTD); GSYNC();
    PHASE(3, { EpiP E; E.P = PACT; E.rstd = RSTD; E.out = p.out; run_gemm(lds, HB, (const bf16_t*)(p.ws + WS_WIN), NINP, 1024, E); })
    PHASE(4, { int mask = dry ? DUP_MASK : 3; asm volatile("" : "+s"(mask)); phase_mix_a(p, lds, mask); })
#if GLA2_SEL >= 0
    { int sel = GLA2_SEL; asm volatile("" : "+s"(sel)); phase_mix_a2(p, lds, sel); GSYNC(); }
#endif
    PHASE(5, phase_scan(p, lds, dry);)
    PHASE(6, { int mask = dry ? DUP_MASK : 3; asm volatile("" : "+s"(mask)); phase_mix_c(p, lds, dry, mask); })
    PHASE(7, { const EpiResid E{XRES, 1.0f, XRES + (size_t)MPROMPT * DM, dry, XRES, HB2, ssq + 32 * MROWS, PART}; run_gemm_split(lds, HB, (const bf16_t*)(p.ws + WS_WOUT), 1024, E); })
    split_fixup(PART, 4, XRES + (size_t)MPROMPT * DM, XRES, HB2, ssq + 32 * MROWS, 1.0f, 0, nullptr, RSTD + MROWS); GSYNC();
    PHASE(8, { EpiSwiglu E; E.O = PACT; E.rstd = RSTD + MROWS; E.nparts = 1; run_gemm(lds, HB2, (const bf16_t*)(p.ws + WS_W2GU), 5632, 1024, E); })
    PHASE(9, { const EpiResid E{XRES, 0.5f, XRES + (size_t)MPROMPT * DM, dry, XRES, nullptr, ssq + 48 * MROWS, PART}; run_gemm_split(lds, PACT, (const bf16_t*)(p.ws + WS_W2D), FF, E); })
    split_fixup(PART, 11, XRES + (size_t)MPROMPT * DM, XRES, nullptr, ssq + 48 * MROWS, 0.5f, 0, p.in[30], nullptr);
#if DUP_PHASE == 11
    for (int rep_ = 0; rep_ < 10 * DUP_N; ++rep_) GSYNC();
#endif
    for (int rep_ = 0; rep_ < REPS(10); ++rep_) { int dry = rep_ < REPS(10) - 1; asm volatile("" : "+s"(dry)); phase_final_norm(p, dry); if (dry) GSYNC(); }
}

extern "C" void kernel_launch(void* const* d_in, const int* in_sizes, int n_in, void* d_out, int out_size, void* d_ws, size_t ws_size, hipStream_t stream) {
    static int grid = 0;
    if (grid == 0) {
        if (n_in != 31 || (size_t)out_size != O_END || ws_size < WS_END) { fprintf(stderr, "kernel_launch: unexpected sizes n_in %d out %d ws %zu (need %zu)\n", n_in, out_size, ws_size, (size_t)WS_END); grid = -1; return; }
        int dev = 0, cus = 0, per_cu = 0;
        hipGetDevice(&dev); hipDeviceGetAttribute(&cus, hipDeviceAttributeMultiprocessorCount, dev);
        if (hipFuncSetAttribute((const void*)fwd_megakernel, hipFuncAttributeMaxDynamicSharedMemorySize, LDS_BYTES) != hipSuccess) { fprintf(stderr, "kernel_launch: hipFuncSetAttribute failed\n"); grid = -1; return; }
        if (hipOccupancyMaxActiveBlocksPerMultiprocessor(&per_cu, (const void*)fwd_megakernel, 512, LDS_BYTES) != hipSuccess || per_cu < 1) { fprintf(stderr, "kernel_launch: occupancy query says %d\n", per_cu); per_cu = 1; }
        (void)hipGetLastError();
        grid = cus;
    }
    if (grid < 0) return;
    if (hipMemsetAsync((unsigned char*)d_ws + WS_BAR, 0, 16384, stream) != hipSuccess) { fprintf(stderr, "kernel_launch: memset failed\n"); return; }
    Params p{};
    for (int i = 0; i < 31; ++i) p.in[i] = (const float*)d_in[i];
    p.out = (float*)d_out; p.ws = (unsigned char*)d_ws;
    void* args[] = {&p};
    hipError_t e = hipLaunchCooperativeKernel((const void*)fwd_megakernel, dim3(grid), dim3(512), args, LDS_BYTES, stream);
    if (e != hipSuccess) fprintf(stderr, "cooperative launch failed: %s (grid %d)\n", hipGetErrorString(e), grid);
}
```

```cpp
#include <hip/hip_runtime.h>
#include <hip/hip_cooperative_groups.h>
#include <cstdio>
namespace cg = cooperative_groups;
#define BARRIER_KIND 2
#define GLA2_SEL -1
#ifndef DUP_PHASE
#define DUP_PHASE -1
#define DUP_N 1
#define DUP_MASK 3
#endif
namespace pg8 {
#define PG8_LAS __attribute__((address_space(3)))
typedef unsigned short bf16_t;
typedef short bf16x8 __attribute__((ext_vector_type(8)));
typedef float f32x4 __attribute__((ext_vector_type(4)));
typedef unsigned u32x4 __attribute__((ext_vector_type(4)));
constexpr int BM = 256, BK = 64, HALF = 128, HTB = HALF * BK * 2  , STAGE_BYTES = 8 * HTB, NXCD = 8, WGM = 8;

__host__ __device__ __forceinline__ int lds_byte(int r, int c) { const int st = (r >> 4) * 2 + (c >> 5), rr = r & 15, cc = c & 31, ob = rr * 64 + cc * 2; return st * 1024 + (ob ^ (((ob >> 9) & 1) << 5)); }
__host__ __device__ __forceinline__ void stage_rc(int b, int& R, int& C) { const int st = b / 1024, sb = b % 1024, swz = sb ^ (((sb >> 9) & 1) << 5); R = (st >> 1) * 16 + swz / 64; C = (st & 1) * 32 + (swz % 64) / 2; }
__host__ __device__ __forceinline__ int perm32(int rho) { const int n = rho >> 4, i = rho & 15; return 8 * (i >> 2) + 4 * n + (i & 3); }

struct Unit { int pm, pn, k0, nkt, part; };
struct Gemm { const bf16_t* A; const bf16_t* Bt; int M, N, K; };

struct StaticOrder {
    int nM, nN, nwg, G, c, nkt;
    __host__ __device__ void init(int M, int N, int G_, int c_, int K_ = 0) { nM = M / BM; nN = N / BM; nwg = nM * nN; G = G_; c = c_; nkt = K_ / BK; }
    __host__ __device__ bool next(int i, Unit& u) const {
        const long L = (long)i * G + c; if (L >= nwg) return false;
        int wgid = (int)L; { const int q = nwg / NXCD, r = nwg % NXCD, xcd = wgid % NXCD, off = wgid / NXCD; wgid = (xcd < r ? xcd * (q + 1) : r * (q + 1) + (xcd - r) * q) + off; }
        const int nig = WGM * nN, gid = wgid / nig, fm = gid * WGM, gsz = (nM - fm) < WGM ? (nM - fm) : WGM;
        u.pm = fm + ((wgid % nig) % gsz); u.pn = (wgid % nig) / gsz; u.k0 = 0; u.nkt = nkt; u.part = -1; return true;
    }
    __device__ __forceinline__ void a_ready(const Unit&) const {}
    __device__ __forceinline__ void done(const Unit&) const {}
};
__device__ __forceinline__ unsigned cvt_pk_bf16(float lo, float hi) { unsigned r; asm volatile("v_cvt_pk_bf16_f32 %0, %1, %2" : "=v"(r) : "v"(lo), "v"(hi)); return r; }

template <class Epi, class Sched, bool STAMP = false>
__device__ __forceinline__ void gemm_phase(PG8_LAS unsigned char* lds, const Gemm g, const Sched& S, const Epi& E, unsigned long long* stamps) {
    int tid_ = threadIdx.x; asm volatile("" : "+v"(tid_)); const int tid = tid_, wid = __builtin_amdgcn_readfirstlane(tid >> 6), lane = tid & 63, wr = wid >> 2, wc = wid & 3, fr = lane & 15, fq = lane >> 4;
    const int K = g.K;
    int ts_lo = 0, ts_hi = 0, nts = 0; const unsigned long long rt_entry = STAMP ? (unsigned long long)wall_clock64() : 0ull;
#define PG8_STAMP() do { if (STAMP && wid == 0 && nts < 64) { const unsigned long long _c = (unsigned long long)clock64(); \
        ts_lo = (lane == nts) ? (int)(unsigned)_c : ts_lo; ts_hi = (lane == nts) ? (int)(unsigned)(_c >> 32) : ts_hi; ++nts; } } while (0)
    PG8_STAMP();
    unsigned voffA[2], voffB[2];
#pragma unroll
    for (int i = 0; i < 2; ++i) { int R, C; stage_rc(tid * 16 + i * 8192, R, C); const int Rb = Epi::PERM ? ((R & ~31) + perm32(R & 31)) : R;
        voffA[i] = (unsigned)(R * K + C) * 2u; voffB[i] = (unsigned)(Rb * K + C) * 2u; }
    const size_t kstep = (size_t)(BK * 2);
    const size_t hstep = (size_t)HALF * K * 2;
    const size_t tstep = 2 * hstep;
    const unsigned ldsw = (unsigned)wid * 1024u;
    const int aoff = lds_byte(wr * 64 + fr, fq * 8), boff = lds_byte(wc * 32 + fr, fq * 8);
#define PG8_SA(b, h) (((b) * 2 + (h)) * HTB)
#define PG8_SB(b, h) ((4 + (b) * 2 + (h)) * HTB)
#define PG8_STAGE(bufoff, gbase, voff) do { _Pragma("unroll") for (int _i = 0; _i < 2; ++_i) \
        __builtin_amdgcn_global_load_lds((const unsigned*)((const char*)(gbase) + (voff)[_i]), (PG8_LAS unsigned*)(lds + (bufoff) + ldsw + _i * 8192), 16, 0, 0); } while (0)
#define PG8_LDA(dst, b, h) do { _Pragma("unroll") for (int m = 0; m < 4; ++m) _Pragma("unroll") for (int k = 0; k < 2; ++k) dst[m][k] = *(const PG8_LAS bf16x8*)(lds + PG8_SA(b, h) + aoff + m * 2048 + k * 1024); } while (0)
#define PG8_LDB(dst, b, h) do { _Pragma("unroll") for (int n = 0; n < 2; ++n) _Pragma("unroll") for (int k = 0; k < 2; ++k) dst[n][k] = *(const PG8_LAS bf16x8*)(lds + PG8_SB(b, h) + boff + n * 2048 + k * 1024); } while (0)
#define PG8_MMA(ai, bj, At, Bt) do { __builtin_amdgcn_s_setprio(1); _Pragma("unroll") for (int m = 0; m < 4; ++m) _Pragma("unroll") for (int n = 0; n < 2; ++n) _Pragma("unroll") for (int k = 0; k < 2; ++k) \
        acc[ai][bj][m][n] = __builtin_amdgcn_mfma_f32_16x16x32_bf16(Bt[n][k], At[m][k], acc[ai][bj][m][n], 0, 0, 0); __builtin_amdgcn_s_setprio(0); } while (0)
#define PG8_WAIT_V(n) asm volatile("s_waitcnt vmcnt(" #n ")" ::: "memory")
#define PG8_WAIT_L(n) asm volatile("s_waitcnt lgkmcnt(" #n ")" ::: "memory")
#define PG8_BAR __builtin_amdgcn_s_barrier()
#define PG8_SCHED __builtin_amdgcn_sched_barrier(0)
    Unit cur, nxt; int ui = 0;
    if (!S.next(0, cur)) return;
    f32x4 acc[2][2][4][2];
#pragma unroll
    for (int a = 0; a < 2; ++a)
#pragma unroll
        for (int b = 0; b < 2; ++b)
#pragma unroll
            for (int m = 0; m < 4; ++m)
#pragma unroll
                for (int n = 0; n < 2; ++n) acc[a][b][m][n] = (f32x4){0.f, 0.f, 0.f, 0.f};
    bf16x8 At[4][2], B0[2][2], B1[2][2];
    const char* cA = (const char*)g.A + (size_t)cur.pm * tstep + (size_t)cur.k0 * kstep; const char* cB = (const char*)g.Bt + (size_t)cur.pn * tstep + (size_t)cur.k0 * kstep;
    S.a_ready(cur);
    float pre[8]; E.prefetch(cur, wr, fr, pre);
    PG8_STAGE(PG8_SB(0, 0), cB, voffB); PG8_STAGE(PG8_SA(0, 0), cA, voffA); PG8_STAGE(PG8_SB(0, 1), cB + hstep, voffB); PG8_STAGE(PG8_SA(0, 1), cA + hstep, voffA);
    if (wr == 1) PG8_BAR;
    PG8_WAIT_V(4); PG8_BAR;
    PG8_STAGE(PG8_SB(1, 0), cB + kstep, voffB); PG8_STAGE(PG8_SA(1, 0), cA + kstep, voffA); PG8_STAGE(PG8_SB(1, 1), cB + hstep + kstep, voffB);
    PG8_WAIT_V(6); PG8_BAR;
    PG8_STAMP();
    for (;;) {
        const bool has_next = S.next(ui + 1, nxt);
        const char* nA = has_next ? (const char*)g.A + (size_t)nxt.pm * tstep + (size_t)nxt.k0 * kstep : cA; const char* nB = has_next ? (const char*)g.Bt + (size_t)nxt.pn * tstep + (size_t)nxt.k0 * kstep : cB;
        const int nt = cur.nkt;
        for (int t = 0; t < nt; t += 2) {
            const bool last = (t == nt - 2);
            const char* a1 = cA + (size_t)(t + 1) * kstep;
            const char* a2 = last ? nA : cA + (size_t)(t + 2) * kstep; const char* b2 = last ? nB : cB + (size_t)(t + 2) * kstep;
            const char* a3 = a2 + kstep; const char* b3 = b2 + kstep;
            if (last && has_next) S.a_ready(nxt);
            PG8_LDB(B0, 0, 0); PG8_SCHED; PG8_LDA(At, 0, 0); PG8_STAGE(PG8_SA(1, 1), a1 + hstep, voffA);
            PG8_WAIT_L(8); PG8_BAR; PG8_WAIT_L(0); PG8_MMA(0, 0, At, B0); PG8_BAR; PG8_SCHED;
            PG8_LDB(B1, 0, 1); PG8_STAGE(PG8_SB(0, 0), b2, voffB);
            PG8_BAR; PG8_WAIT_L(0); PG8_MMA(0, 1, At, B1); PG8_BAR;
            PG8_LDA(At, 0, 1); PG8_STAGE(PG8_SA(0, 0), a2, voffA);
            PG8_BAR; PG8_WAIT_L(0); PG8_MMA(1, 0, At, B0); PG8_BAR; PG8_SCHED;
            PG8_STAGE(PG8_SB(0, 1), b2 + hstep, voffB);
            PG8_WAIT_V(6); PG8_BAR; PG8_MMA(1, 1, At, B1); PG8_BAR;
            PG8_LDB(B0, 1, 0); PG8_SCHED; PG8_LDA(At, 1, 0); PG8_STAGE(PG8_SA(0, 1), a2 + hstep, voffA);
            PG8_WAIT_L(8); PG8_BAR; PG8_WAIT_L(0); PG8_MMA(0, 0, At, B0); PG8_BAR; PG8_SCHED;
            PG8_LDB(B1, 1, 1); PG8_STAGE(PG8_SB(1, 0), b3, voffB);
            PG8_BAR; PG8_WAIT_L(0); PG8_MMA(0, 1, At, B1); PG8_BAR;
            PG8_LDA(At, 1, 1); PG8_STAGE(PG8_SA(1, 0), a3, voffA);
            PG8_BAR; PG8_WAIT_L(0); PG8_MMA(1, 0, At, B0); PG8_BAR; PG8_SCHED;
            PG8_STAGE(PG8_SB(1, 1), b3 + hstep, voffB);
            PG8_WAIT_V(6); PG8_BAR; PG8_MMA(1, 1, At, B1); PG8_BAR;
        }
        PG8_STAMP();
        if constexpr (!Epi::AFTER_DRAIN) { E(acc, cur, wr, wc, fr, fq, pre); S.done(cur); }
        PG8_STAMP();
        if (!has_next) break;
#pragma unroll
        for (int a = 0; a < 2; ++a)
#pragma unroll
            for (int b = 0; b < 2; ++b)
#pragma unroll
                for (int m = 0; m < 4; ++m)
#pragma unroll
                    for (int n = 0; n < 2; ++n) acc[a][b][m][n] = (f32x4){0.f, 0.f, 0.f, 0.f};
        cur = nxt; cA = nA; cB = nB; ++ui; E.prefetch(cur, wr, fr, pre);
    }
    PG8_WAIT_V(0);
    if (wr == 0) PG8_BAR;
    PG8_BAR;
    if constexpr (Epi::AFTER_DRAIN) { E.fused(acc, cur, wr, wc, fr, fq, lds, wid, lane); S.done(cur); }
    PG8_STAMP();
    if (STAMP && wid == 0) { stamps[lane] = lane < nts ? (((unsigned long long)(unsigned)ts_hi << 32) | (unsigned)ts_lo) : 0ull;
        if (lane == 62) stamps[62] = rt_entry; if (lane == 63) stamps[63] = (unsigned long long)wall_clock64(); }
#undef PG8_STAMP
#undef PG8_SA
#undef PG8_SB
#undef PG8_STAGE
#undef PG8_LDA
#undef PG8_LDB
#undef PG8_MMA
#undef PG8_WAIT_V
#undef PG8_WAIT_L
#undef PG8_BAR
#undef PG8_SCHED
}
}
#define LAS PG8_LAS
#define XB_TMO      128
#define XB_XCNT(j)  (256  + 64 * (j))
#define XB_XSUB(j)  (1280 + 64 * (j))
#define XB_XGEN(j)  (2304 + 64 * (j))
#define XB_TOP      3328
#define XB_TOPGEN   3392
#define XCD_BAR_WORDS 3456
#define XB_SPIN_CAP (1u << 18)

__device__ __forceinline__ unsigned xb_ld(unsigned* p)              { return __hip_atomic_load(p, __ATOMIC_RELAXED, __HIP_MEMORY_SCOPE_AGENT); }
__device__ __forceinline__ unsigned xb_add(unsigned* p, unsigned v) { return __hip_atomic_fetch_add(p, v, __ATOMIC_RELAXED, __HIP_MEMORY_SCOPE_AGENT); }
__device__ __forceinline__ unsigned xb_xcc_id() { return (unsigned)__builtin_amdgcn_s_getreg((3 << 11) | 20) & 0xFu; }
#define XB_SPIN(cond, bar) do { unsigned _sp = 0; while (cond) { __builtin_amdgcn_s_sleep(1); \
    if ((++_sp & 255u) == 0u) { if (xb_ld(&(bar)[XB_TMO])) break; if (_sp > XB_SPIN_CAP) { atomicAdd(&(bar)[XB_TMO], 1u); break; } } } } while (0)

struct XcdBarrier {
    unsigned* bar; unsigned x;
    volatile LAS unsigned* st;
};

__device__ __forceinline__ XcdBarrier xcd_barrier_post(unsigned* bar, volatile LAS unsigned* st) {
    XcdBarrier b; b.bar = bar; b.x = xb_xcc_id(); b.st = st;
    if (threadIdx.x == 0) (void)xb_add(&bar[XB_XCNT(b.x)], 1u);
    return b;
}
__device__ __forceinline__ void xcd_barrier_complete(unsigned* bar, unsigned x, unsigned& nloc, unsigned& nx) {
    const unsigned G = gridDim.x * gridDim.y * gridDim.z;
    unsigned sum, cnt, mine, sp = 0u;
    for (;;) {
        sum = 0u; cnt = 0u; mine = 0u;
#pragma unroll
        for (unsigned j = 0; j < 16; ++j) { const unsigned c = xb_ld(&bar[XB_XCNT(j)]); sum += c; cnt += (c > 0u) ? 1u : 0u; mine = (j == x) ? c : mine; }
        if (sum == G) break;
        __builtin_amdgcn_s_sleep(1);
        if ((++sp & 255u) == 0u) { if (xb_ld(&bar[XB_TMO])) break; if (sp > XB_SPIN_CAP) { atomicAdd(&bar[XB_TMO], 1u); break; } }
    }
    nloc = mine > 0u ? mine : 1u; nx = cnt > 0u ? cnt : 1u;
}

__device__ __forceinline__ void xcd_barrier(const XcdBarrier& b) {
    asm volatile("s_waitcnt vmcnt(0)" ::: "memory");
    __syncthreads();
    if (threadIdx.x == 0) {
        unsigned* bar = b.bar;
        __builtin_amdgcn_s_waitcnt(0);
        unsigned nloc = b.st[0], nx = b.st[1];
        if (nloc == 0u) { xcd_barrier_complete(bar, b.x, nloc, nx); b.st[0] = nloc; b.st[1] = nx; }
        const unsigned old = xb_add(&bar[XB_XSUB(b.x)], 1u);
        const unsigned gen = old / nloc;
        if (old + 1u == (gen + 1u) * nloc) {
            __builtin_amdgcn_fence(__ATOMIC_RELEASE, "agent");
            asm volatile("s_waitcnt vmcnt(0)" ::: "memory");
            const unsigned og = xb_add(&bar[XB_TOP], 1u);
            const unsigned tg = og / nx;
            if (og + 1u == (tg + 1u) * nx) xb_add(&bar[XB_TOPGEN], 1u);
            else XB_SPIN(xb_ld(&bar[XB_TOPGEN]) == tg, bar);
            __builtin_amdgcn_fence(__ATOMIC_ACQUIRE, "agent");
            xb_add(&bar[XB_XGEN(b.x)], 1u);
            asm volatile("s_waitcnt vmcnt(0)" ::: "memory");
        } else {
            XB_SPIN(xb_ld(&bar[XB_XGEN(b.x)]) == gen, bar);
            __builtin_amdgcn_fence(__ATOMIC_ACQUIRE, "agent");
            asm volatile("s_waitcnt vmcnt(0)" ::: "memory");
        }
    }
    __syncthreads();
}

using pg8::bf16_t; using pg8::bf16x8; using pg8::f32x4; using pg8::u32x4; using pg8::Unit; using pg8::cvt_pk_bf16;

typedef float f32x2 __attribute__((ext_vector_type(2)));
typedef unsigned u32x2 __attribute__((ext_vector_type(2)));

constexpr int MROWS = 16640, MPROMPT = 16384, DM = 1024, FF = 2816, NIN = 3216, NINP = 3328, ACOLS = 1664, BOFF = 1664;
constexpr int NSAMP = 16, SAMP_T = 16;
constexpr size_t O_Y = 0, O_SHIFT_P = 17039360, O_WKV_P = 17041024, O_GLA_P = 17073792, O_SHIFT_S = 17106560, O_WKV_S = 17133184, O_GLA_S = 17657472, O_END = 18181760;
constexpr size_t al256(size_t x) { return (x + 255) & ~(size_t)255; }
constexpr size_t WS_W1GU = 0;
constexpr size_t WS_W1D  = WS_W1GU + (size_t)5632 * 1024 * 2;
constexpr size_t WS_WIN  = WS_W1D + (size_t)1024 * 2816 * 2;
constexpr size_t WS_WOUT = WS_WIN + (size_t)NINP * 1024 * 2;
constexpr size_t WS_W2GU = WS_WOUT + (size_t)1024 * 1024 * 2;
constexpr size_t WS_W2D  = WS_W2GU + (size_t)5632 * 1024 * 2;
constexpr size_t WS_SSQ  = WS_W2D + (size_t)1024 * 2816 * 2;
constexpr size_t SSQ_BYTES = (size_t)16 * MROWS * 4;
constexpr size_t WS_HB   = WS_SSQ + 4 * SSQ_BYTES;
constexpr size_t WS_PACT = WS_HB + (size_t)MROWS * 1024 * 2;
constexpr size_t WS_G    = WS_PACT + (size_t)MROWS * NIN * 2;
constexpr size_t WS_HSR  = WS_G + (size_t)144 * 8 * 8192;
constexpr size_t WS_HSG  = WS_HSR + (size_t)144 * 8 * 16384;
constexpr size_t WS_DECG = WS_HSG + (size_t)272 * 4 * 32768;
constexpr size_t WS_BONUS= WS_DECG + (size_t)272 * 4 * 64 * 4;
constexpr size_t WS_BAR  = WS_BONUS + (size_t)MROWS * 8 * 4;
constexpr size_t WS_DUMMY= WS_BAR + 16384;
constexpr size_t WS_GBS  = WS_DUMMY + ((size_t)1 << 20);
constexpr size_t WS_RSTD = WS_GBS + (size_t)272 * 4 * 4 * 2 * 64 * 4;
constexpr size_t WS_END  = WS_RSTD + (size_t)2 * MROWS * 4;
constexpr size_t WS_Y    = WS_W1GU;
constexpr size_t WS_HB2  = WS_HSG;
static_assert((size_t)MROWS * 512 * 2 <= WS_WOUT, "Y overlay");
static_assert((size_t)MROWS * 1024 * 2 <= (size_t)272 * 4 * 32768, "HB2 overlay");
constexpr int LDS_BYTES = 131072 + 16;

struct Params { const float* in[31]; float* out; unsigned char* ws; };

__device__ __forceinline__ float rstd_of(const float* ssq, int nparts, int row) {
    float s = 0.f;
    for (int p = 0; p < nparts; ++p) s += ssq[(size_t)p * MROWS + row];
    return rsqrtf(s * (1.0f / 1024.0f) + 1e-6f);
}
__device__ __forceinline__ int tid_opaque() { int t = threadIdx.x; asm volatile("" : "+v"(t)); return t; }
__device__ __forceinline__ float sigmoidf_(float x) { return __builtin_amdgcn_rcpf(1.0f + __expf(-x)); }

struct EpiSwiglu {
    static constexpr bool PERM = true, AFTER_DRAIN = false;
    bf16_t* O; const float* rstd; int nparts;
    __device__ __forceinline__ void prefetch(const Unit& u, int wr, int fr, float (&pre)[8]) const {
        if (nparts) {
#pragma unroll
            for (int ai = 0; ai < 2; ++ai)
#pragma unroll
                for (int m = 0; m < 4; ++m) pre[ai * 4 + m] = rstd[u.pm * 256 + wr * 64 + fr + ai * 128 + m * 16];
        }
    }
    __device__ __forceinline__ void operator()(const f32x4 (&acc)[2][2][4][2], const Unit& u, int wr, int wc, int fr, int fq, const float (&pre)[8]) const {
        const int row0 = u.pm * 256 + wr * 64 + fr, col0 = u.pn * 128 + wc * 32 + 8 * fq;
#pragma unroll
        for (int ai = 0; ai < 2; ++ai)
#pragma unroll
            for (int m = 0; m < 4; ++m) {
                const int row = row0 + ai * 128 + m * 16; const float rs = nparts ? pre[ai * 4 + m] : 1.0f;
                float a[8];
#pragma unroll
                for (int n = 0; n < 2; ++n)
#pragma unroll
                    for (int j = 0; j < 4; ++j) { const float g = acc[ai][0][m][n][j] * rs, up = acc[ai][1][m][n][j] * rs; a[n * 4 + j] = g * sigmoidf_(g) * up; }
                u32x4 w; w.x = cvt_pk_bf16(a[0], a[1]); w.y = cvt_pk_bf16(a[2], a[3]); w.z = cvt_pk_bf16(a[4], a[5]); w.w = cvt_pk_bf16(a[6], a[7]);
                *(u32x4*)(O + (size_t)row * FF + col0) = w;
            }
    }
};
struct EpiResid {
    static constexpr bool PERM = true, AFTER_DRAIN = false;
    const float* xoldA; float scale; const float* xoldB; int dry; float* xnew; bf16_t* xb; float* ssq; float* part;
    __device__ __forceinline__ void prefetch(const Unit&, int, int, float (&)[8]) const {}
    __device__ __forceinline__ void operator()(const f32x4 (&acc)[2][2][4][2], const Unit& u, int wr, int wc, int fr, int fq, const float (&)[8]) const {
        const int row0 = u.pm * 256 + wr * 64 + fr, col0 = u.pn * 256 + wc * 32 + 8 * fq;
        float sc_ = scale; asm volatile("" : "+v"(sc_)); const f32x4 sc4 = (f32x4){sc_, sc_, sc_, sc_};
        if (u.part >= 0) {
            float* pb = part + ((size_t)(u.part * 4 + u.pn) * 256 + wr * 64 + fr) * 256 + wc * 32 + 8 * fq;
#pragma unroll
            for (int ai = 0; ai < 2; ++ai)
#pragma unroll
                for (int m = 0; m < 4; ++m)
#pragma unroll
                    for (int bj = 0; bj < 2; ++bj) { float* q = pb + (size_t)(ai * 128 + m * 16) * 256 + bj * 128; *(f32x4*)q = acc[ai][bj][m][0]; *(f32x4*)(q + 4) = acc[ai][bj][m][1]; }
        } else {
#pragma unroll
        for (int ai = 0; ai < 2; ++ai) {
            f32x4 xv[4][2][2];
#pragma unroll
            for (int m = 0; m < 4; ++m) {
                const int row = row0 + ai * 128 + m * 16;
                const float* xo = row < MPROMPT ? xoldA + (size_t)row * DM : xoldB + (size_t)(row - MPROMPT) * DM;
#pragma unroll
                for (int bj = 0; bj < 2; ++bj) { xv[m][bj][0] = *(const f32x4*)(xo + col0 + bj * 128); xv[m][bj][1] = *(const f32x4*)(xo + col0 + bj * 128 + 4); }
            }
            __builtin_amdgcn_sched_barrier(0);
#pragma unroll
            for (int m = 0; m < 4; ++m) {
                const int row = row0 + ai * 128 + m * 16;
                float sq = 0.f;
#pragma unroll
                for (int bj = 0; bj < 2; ++bj) {
                    const int col = col0 + bj * 128;
                    f32x4 v0 = xv[m][bj][0], v1 = xv[m][bj][1];
                    if (!dry) { v0 += acc[ai][bj][m][0] * sc4; v1 += acc[ai][bj][m][1] * sc4; }
                    *(f32x4*)(xnew + (size_t)row * DM + col) = v0; *(f32x4*)(xnew + (size_t)row * DM + col + 4) = v1;
                    if (xb) { u32x4 w; w.x = cvt_pk_bf16(v0[0], v0[1]); w.y = cvt_pk_bf16(v0[2], v0[3]); w.z = cvt_pk_bf16(v1[0], v1[1]); w.w = cvt_pk_bf16(v1[2], v1[3]);
                        *(u32x4*)(xb + (size_t)row * DM + col) = w; }
                    sq += (v0[0] * v0[0] + v0[1] * v0[1]) + (v0[2] * v0[2] + v0[3] * v0[3]) + (v1[0] * v1[0] + v1[1] * v1[1]) + (v1[2] * v1[2] + v1[3] * v1[3]);
                }
                sq += __shfl_xor(sq, 16); sq += __shfl_xor(sq, 32);
                if (fq == 0) ssq[(size_t)(u.pn * 4 + wc) * MROWS + row] = sq;
            }
            __builtin_amdgcn_sched_barrier(0);
        }
        }
    }
};
struct EpiP {
    static constexpr bool PERM = true, AFTER_DRAIN = false;
    bf16_t* P; const float* rstd; float* out;
    __device__ __forceinline__ void prefetch(const Unit& u, int wr, int fr, float (&pre)[8]) const {
#pragma unroll
        for (int ai = 0; ai < 2; ++ai)
#pragma unroll
            for (int m = 0; m < 4; ++m) pre[ai * 4 + m] = rstd[u.pm * 256 + wr * 64 + fr + ai * 128 + m * 16];
    }
    __device__ __forceinline__ void operator()(const f32x4 (&acc)[2][2][4][2], const Unit& u, int wr, int wc, int fr, int fq, const float (&pre)[8]) const {
        const int row0 = u.pm * 256 + wr * 64 + fr, col0 = u.pn * 256 + wc * 32 + 8 * fq;
#pragma unroll
        for (int ai = 0; ai < 2; ++ai)
#pragma unroll
            for (int m = 0; m < 4; ++m) {
                const int row = row0 + ai * 128 + m * 16; const float rs = pre[ai * 4 + m];
                float* dst = nullptr;
                if (row == MPROMPT - 1) dst = out + O_SHIFT_P;
                else if (row >= MPROMPT && ((row - MPROMPT) & 15) == 15) dst = out + O_SHIFT_S + (size_t)((row - MPROMPT) >> 4) * ACOLS;
#pragma unroll
                for (int bj = 0; bj < 2; ++bj) {
                    const int col = col0 + bj * 128;
                    if (col < NIN) {
                        const f32x4 v0 = acc[ai][bj][m][0] * rs, v1 = acc[ai][bj][m][1] * rs;
                        u32x4 w; w.x = cvt_pk_bf16(v0[0], v0[1]); w.y = cvt_pk_bf16(v0[2], v0[3]); w.z = cvt_pk_bf16(v1[0], v1[1]); w.w = cvt_pk_bf16(v1[2], v1[3]);
                        *(u32x4*)(P + (size_t)row * NIN + col) = w;
                        if (dst && col < ACOLS) { *(f32x4*)(dst + col) = v0; *(f32x4*)(dst + col + 4) = v1; }
                    }
                }
            }
    }
};
template <class Epi>
__device__ __forceinline__ void run_gemm(LAS unsigned char* lds, const bf16_t* A, const bf16_t* Bt, int N, int K, const Epi& E) {
    pg8::Gemm g; g.A = A; g.Bt = Bt; g.M = MROWS; g.N = N; g.K = K;
    pg8::StaticOrder S; S.init(MROWS, N, (int)gridDim.x, (int)blockIdx.x, K);
    pg8::gemm_phase<Epi, pg8::StaticOrder, false>(lds, g, S, E, nullptr);
}
struct SplitOrder {
    pg8::StaticOrder S; int nsmall, c;
    __device__ void init(int G, int c_, int K) { S.init(MPROMPT, 1024, G, c_, K); c = c_; nsmall = 4 * (K / 256); }
    __device__ bool next(int i, Unit& u) const {
        if (i == 0) return S.next(0, u);
        if (i == 1 && c < nsmall) { u.pm = MPROMPT / 256; u.pn = c & 3; u.part = c >> 2; u.k0 = u.part * 4; u.nkt = 4; return true; }
        return false;
    }
    __device__ __forceinline__ void a_ready(const Unit&) const {}
    __device__ __forceinline__ void done(const Unit&) const {}
};
template <class Epi>
__device__ __forceinline__ void run_gemm_split(LAS unsigned char* lds, const bf16_t* A, const bf16_t* Bt, int K, const Epi& E) {
    pg8::Gemm g; g.A = A; g.Bt = Bt; g.M = MROWS; g.N = 1024; g.K = K;
    SplitOrder S; S.init((int)gridDim.x, (int)blockIdx.x, K);
    pg8::gemm_phase<Epi, SplitOrder, false>(lds, g, S, E, nullptr);
}
__device__ __forceinline__ void split_fixup(const float* part, int nsplit, const float* xold, float* xnew, bf16_t* xb, float* ssq, float scale, int dry, const float* fin_g, float* rstd_out) {
    const int tid = tid_opaque(), wave = tid >> 6, lane = tid & 63;
    for (int r = blockIdx.x * 8 + wave; r < 256; r += gridDim.x * 8) {
        const int row = MPROMPT + r; float sq = 0.f; f32x4 v[4];
#pragma unroll
        for (int i = 0; i < 4; ++i) {
            const int col = i * 256 + lane * 4;
            f32x4 a = (f32x4){0.f, 0.f, 0.f, 0.f};
            for (int ks = 0; ks < nsplit; ++ks) a += *(const f32x4*)(part + ((size_t)(ks * 4 + i) * 256 + r) * 256 + lane * 4);
            v[i] = *(const f32x4*)(xold + (size_t)r * DM + col);
            if (!dry) v[i] += a * (f32x4){scale, scale, scale, scale};
            sq += (v[i][0] * v[i][0] + v[i][1] * v[i][1]) + (v[i][2] * v[i][2] + v[i][3] * v[i][3]);
        }
#pragma unroll
        for (int o = 32; o > 0; o >>= 1) sq += __shfl_xor(sq, o);
        const float rs = rsqrtf(sq * (1.0f / 1024.0f) + 1e-6f);
#pragma unroll
        for (int i = 0; i < 4; ++i) {
            const int col = i * 256 + lane * 4;
            if (fin_g) v[i] = v[i] * rs * *(const f32x4*)(fin_g + col);
            *(f32x4*)(xnew + (size_t)row * DM + col) = v[i];
            if (xb) { u32x2 w; w.x = cvt_pk_bf16(v[i][0], v[i][1]); w.y = cvt_pk_bf16(v[i][2], v[i][3]); *(u32x2*)(xb + (size_t)row * DM + col) = w; }
        }
        if (lane < 16) ssq[(size_t)lane * MROWS + row] = lane == 0 ? sq : 0.f;
        if (lane == 0 && rstd_out) rstd_out[row] = rs;
    }
    if (rstd_out) for (int row = blockIdx.x * 512 + tid; row < MPROMPT; row += gridDim.x * 512) rstd_out[row] = rstd_of(ssq, 16, row);
}
struct CvtJob { const float* src; const float* gain; bf16_t* dst; int ldsrc, nvalid, k0, ns0, K, nd0; };
__device__ __forceinline__ void cvt_decode(const Params& p, int tidx, CvtJob& J) {
    if (tidx < 2816) {
        const int f = tidx / 1408, r = tidx % 1408, nb = r / 16, kb = r % 16, pn = nb >> 2, bj = (nb >> 1) & 1, h = nb & 1;
        J.src = f == 0 ? (bj ? p.in[7] : p.in[6]) : (bj ? p.in[28] : p.in[27]); J.gain = f == 0 ? nullptr : p.in[26]; J.dst = (bf16_t*)(p.ws + (f == 0 ? WS_W1GU : WS_W2GU));
        J.ldsrc = FF; J.nvalid = FF; J.k0 = kb * 64; J.ns0 = pn * 128 + h * 64; J.K = 1024; J.nd0 = nb * 64;
    } else if (tidx < 4224) {
        const int f = (tidx - 2816) / 704, r = (tidx - 2816) % 704, nb = r / 44, kb = r % 44;
        J.src = f == 0 ? p.in[8] : p.in[29]; J.gain = nullptr; J.dst = (bf16_t*)(p.ws + (f == 0 ? WS_W1D : WS_W2D)); J.ldsrc = 1024; J.nvalid = 1024; J.k0 = kb * 64; J.ns0 = nb * 64; J.K = FF; J.nd0 = nb * 64;
    } else if (tidx < 5056) {
        const int r = tidx - 4224, nb = r / 16, kb = r % 16;
        J.src = p.in[10]; J.gain = p.in[9]; J.dst = (bf16_t*)(p.ws + WS_WIN); J.ldsrc = NIN; J.nvalid = NIN; J.k0 = kb * 64; J.ns0 = nb * 64; J.K = 1024; J.nd0 = nb * 64;
    } else {
        const int r = tidx - 5056, nb = r / 16, kb = r % 16;
        J.src = p.in[25]; J.gain = nullptr; J.dst = (bf16_t*)(p.ws + WS_WOUT); J.ldsrc = 1024; J.nvalid = 1024; J.k0 = kb * 64; J.ns0 = nb * 64; J.K = 1024; J.nd0 = nb * 64;
    }
}
__device__ __forceinline__ int cvt_remap(int i, int late) {
    if (late == 2) return i;
    if (!late) return i < 1408 ? i : (i < 2112 ? i + 1408 : i + 2112);
    return i < 1408 ? i + 1408 : (i < 2112 ? i + 2112 : i + 2944);
}
__device__ __forceinline__ void phase_convert(const Params& p, LAS unsigned char* lds, int late, int wb, int nb) {
    LAS float* tiles = (LAS float*)lds;
    bf16_t* ws16 = (bf16_t*)p.ws;
    const int t = tid_opaque(), ntiles = late == 2 ? 5312 : (late ? 2368 : 2944);
    for (int base = wb; base < ntiles; base += 4 * nb) {
        f32x4 v[4][2]; float gq[4][2];
#pragma unroll
        for (int u = 0; u < 4; ++u) {
            const int tidx = base + u * nb;
            if (tidx < ntiles) { CvtJob J; cvt_decode(p, cvt_remap(tidx, late), J);
#pragma unroll
                for (int h = 0; h < 2; ++h) { const int i = (t >> 4) + h * 32, j4 = (t & 15) * 4;
                    v[u][h] = (f32x4){0.f, 0.f, 0.f, 0.f};
                    if (J.ns0 + j4 < J.nvalid) v[u][h] = *(const f32x4*)(J.src + (size_t)(J.k0 + i) * J.ldsrc + J.ns0 + j4);
                    gq[u][h] = J.gain ? J.gain[J.k0 + i] : 1.0f; } }
        }
#pragma unroll
        for (int u = 0; u < 4; ++u)
            if (base + u * nb < ntiles) {
#pragma unroll
                for (int h = 0; h < 2; ++h) { const int i = (t >> 4) + h * 32, j4 = (t & 15) * 4;
#pragma unroll
                    for (int e = 0; e < 4; ++e) tiles[u * 4160 + i * 65 + j4 + e] = v[u][h][e] * gq[u][h]; } }
        __syncthreads();
#pragma unroll
        for (int u = 0; u < 4; ++u) {
            const int tidx = base + u * nb;
            if (tidx < ntiles) { CvtJob J; cvt_decode(p, cvt_remap(tidx, late), J);
                const int j = t >> 3, ks = (t & 7) * 8; float a[8];
#pragma unroll
                for (int e = 0; e < 8; ++e) a[e] = tiles[u * 4160 + (ks + e) * 65 + j];
                u32x4 w; w.x = cvt_pk_bf16(a[0], a[1]); w.y = cvt_pk_bf16(a[2], a[3]); w.z = cvt_pk_bf16(a[4], a[5]); w.w = cvt_pk_bf16(a[6], a[7]);
                *(u32x4*)(J.dst + (size_t)(J.nd0 + j) * J.K + J.k0 + ks) = w; }
        }
        __syncthreads();
    }
    (void)ws16;
    if (late == 1) return;
    const int tid = tid_opaque(), wave = tid >> 6, lane = tid & 63;
    float* ssq0 = (float*)(p.ws + WS_SSQ);
    bf16_t* hb = (bf16_t*)(p.ws + WS_HB);
    for (int row = blockIdx.x * 8 + wave; row < MROWS; row += gridDim.x * 8) {
        const float* x = row < MPROMPT ? p.in[0] + (size_t)row * DM : p.in[1] + (size_t)(row - MPROMPT) * DM;
        float sq = 0.f; f32x4 v[4];
#pragma unroll
        for (int i = 0; i < 4; ++i) { v[i] = *(const f32x4*)(x + i * 256 + lane * 4); sq += (v[i][0] * v[i][0] + v[i][1] * v[i][1]) + (v[i][2] * v[i][2] + v[i][3] * v[i][3]); }
#pragma unroll
        for (int o = 32; o > 0; o >>= 1) sq += __shfl_xor(sq, o);
        const float rs = rsqrtf(sq * (1.0f / 1024.0f) + 1e-6f);
#pragma unroll
        for (int i = 0; i < 4; ++i) {
            const f32x4 h = v[i] * rs * *(const f32x4*)(p.in[5] + i * 256 + lane * 4);
            u32x2 w; w.x = cvt_pk_bf16(h[0], h[1]); w.y = cvt_pk_bf16(h[2], h[3]);
            *(u32x2*)(hb + (size_t)row * DM + i * 256 + lane * 4) = w;
        }
    }
}
__device__ __forceinline__ void phase_final_norm(const Params& p, int dry) {
    const int tid = tid_opaque(), wave = tid >> 6, lane = tid & 63;
    const float* ssq3 = (const float*)(p.ws + WS_SSQ + 3 * SSQ_BYTES);
    const float* g = p.in[30];
    f32x4 gg[4];
#pragma unroll
    for (int i = 0; i < 4; ++i) gg[i] = *(const f32x4*)(g + i * 256 + lane * 4);
    const int stride = gridDim.x * 8;
    for (int row0 = blockIdx.x * 8 + wave; row0 < MPROMPT; row0 += 4 * stride) {
        f32x4 v[4][4]; float rs[4];
#pragma unroll
        for (int r = 0; r < 4; ++r) { const int row = row0 + r * stride;
            if (row < MPROMPT) { rs[r] = rstd_of(ssq3, 16, row);
#pragma unroll
                for (int i = 0; i < 4; ++i) v[r][i] = *(const f32x4*)(p.out + (size_t)row * DM + i * 256 + lane * 4); } }
        __builtin_amdgcn_sched_barrier(0);
#pragma unroll
        for (int r = 0; r < 4; ++r) { const int row = row0 + r * stride;
            if (row < MPROMPT) {
#pragma unroll
                for (int i = 0; i < 4; ++i) *(f32x4*)(p.out + (size_t)row * DM + i * 256 + lane * 4) = dry ? v[r][i] : v[r][i] * rs[r] * gg[i]; } }
    }
}
__device__ __forceinline__ float bf2f(bf16_t b) { return __uint_as_float(((unsigned)b) << 16); }
__device__ __forceinline__ float quad_sum(float x) {
    x += __int_as_float(__builtin_amdgcn_update_dpp(0, __float_as_int(x), 0xB1, 0xF, 0xF, true));
    x += __int_as_float(__builtin_amdgcn_update_dpp(0, __float_as_int(x), 0x4E, 0xF, 0xF, true));
    return x;
}
__device__ __forceinline__ float wave_sum(float x) {
    x += __int_as_float(__builtin_amdgcn_update_dpp(0, __float_as_int(x), 0xB1, 0xF, 0xF, true));
    x += __int_as_float(__builtin_amdgcn_update_dpp(0, __float_as_int(x), 0x4E, 0xF, 0xF, true));
    x += __int_as_float(__builtin_amdgcn_update_dpp(0, __float_as_int(x), 0x124, 0xF, 0xF, true));
    x += __int_as_float(__builtin_amdgcn_update_dpp(0, __float_as_int(x), 0x128, 0xF, 0xF, true));
    const int xi = __float_as_int(x);
    return (__int_as_float(__builtin_amdgcn_readlane(xi, 0)) + __int_as_float(__builtin_amdgcn_readlane(xi, 16))) + (__int_as_float(__builtin_amdgcn_readlane(xi, 32)) + __int_as_float(__builtin_amdgcn_readlane(xi, 48)));
}
__device__ __forceinline__ float softplusf_(float x) { return fmaxf(x, 0.f) + __logf(1.0f + __expf(-fabsf(x))); }
__device__ __forceinline__ float tanhf_(float x) { return 1.0f - 2.0f * __builtin_amdgcn_rcpf(1.0f + __expf(2.0f * x)); }
__device__ __forceinline__ f32x2 lo2(f32x4 v) { return __builtin_shufflevector(v, v, 0, 1); }
__device__ __forceinline__ f32x2 hi2(f32x4 v) { return __builtin_shufflevector(v, v, 2, 3); }
__device__ __forceinline__ f32x2 bc2(float x) { return (f32x2){x, x}; }

struct Seg { int row0, nsteps, prevkind; const float* prevptr; };
__device__ __forceinline__ float seg_prev0(const bf16_t* P, const Seg& sg, int col) {
    float prev = 0.f;
    if (sg.prevkind == 1) prev = bf2f(P[(size_t)(sg.row0 - 1) * NIN + col]);
    else if (sg.prevkind == 2) prev = sg.prevptr[col];
    return prev;
}
__device__ __forceinline__ float xs_lerp(const bf16_t* P, const Seg& sg, int i, int col, float mu, float prev0) {
    const float cur = bf2f(P[(size_t)(sg.row0 + i) * NIN + col]);
    const float pr = bf2f(P[(size_t)(sg.row0 + (i > 0 ? i - 1 : 0)) * NIN + col]);
    const float prev = i == 0 ? prev0 : pr;
    return cur + (prev - cur) * mu;
}
__device__ __forceinline__ void load16(const LAS float* src, f32x2 (&d)[8]) {
    const LAS f32x4* s4 = (const LAS f32x4*)src;
#pragma unroll
    for (int i = 0; i < 4; ++i) { const f32x4 v = s4[i]; d[2 * i] = lo2(v); d[2 * i + 1] = hi2(v); }
}

constexpr int RST = 384;
__device__ __forceinline__ void rwkv_a_task(const Params& p, LAS unsigned char* lds, int tk, int mode) {
    const int tid = tid_opaque(), wave = tid >> 6, lane = tid & 63;
    const bf16_t* P = (const bf16_t*)(p.ws + WS_PACT);
    Seg sg; int ci, g;
    if (tk < 256) { const int c = tk >> 1; g = tk & 1; sg.row0 = c * 128; sg.nsteps = 128; sg.prevkind = c == 0 ? 0 : 1; sg.prevptr = nullptr; ci = c; }
    else { const int b = (tk - 256) >> 1; g = (tk - 256) & 1; sg.row0 = MPROMPT + b * 16; sg.nsteps = 16; sg.prevkind = 2; sg.prevptr = p.in[2] + (size_t)b * ACOLS; ci = 128 + b; }
    LAS float* stage = (LAS float*)lds;
    LAS float* bcs = (LAS float*)(lds + 98304) + wave * 512;
    const float* mu = p.in[11];
    const int phl = wave & 3, ptb = (wave >> 2) * 8, hd = g * 4 + phl, C = hd * 64 + lane;
    const float mu_r = mu[C], mu_k = mu[512 + C], mu_v = mu[1024 + C], mu_x = mu[1536 + lane];
    const float w0c = p.in[12][C], a0c = p.in[14][C], kkc = p.in[17][C], kac = p.in[18][C], rkc = p.in[19][C];
    const float pv_r = seg_prev0(P, sg, C), pv_k = seg_prev0(P, sg, 512 + C), pv_v = seg_prev0(P, sg, 1024 + C), pv_x = seg_prev0(P, sg, 1536 + lane);
    const float* wup = p.in[13] + C; const float* aup = p.in[15] + C;
    float* bonus = (float*)(p.ws + WS_BONUS);
    const bool isH = wave >= 4; const int rhd = g * 4 + (wave & 3), rg = lane >> 2, ks = lane & 3;
    f32x2 s[4][8];
#pragma unroll
    for (int r = 0; r < 4; ++r)
#pragma unroll
        for (int j = 0; j < 8; ++j) { s[r][j].x = (!isH && (rg * 4 + r == ks * 16 + 2 * j)) ? 1.f : 0.f; s[r][j].y = (!isH && (rg * 4 + r == ks * 16 + 2 * j + 1)) ? 1.f : 0.f; }
    bf16_t* Yb = (bf16_t*)(p.ws + WS_Y); bf16_t* HB = (bf16_t*)(p.ws + WS_HB);
    bf16_t raw[9][4];
#define RW_LOAD(sbn) do { _Pragma("unroll") for (int i = 0; i < 9; ++i) { const int ti_ = (sbn) * 16 + ptb + i - 1; const bf16_t* rp_ = P + (size_t)(sg.row0 + (ti_ < 0 ? 0 : ti_)) * NIN; \
        raw[i][0] = rp_[C]; raw[i][1] = rp_[512 + C]; raw[i][2] = rp_[1024 + C]; raw[i][3] = rp_[1536 + lane]; } } while (0)
    RW_LOAD(0);
    for (int sb = 0; sb < sg.nsteps / 16; ++sb) {
        if (!(mode & 4)) {
#pragma unroll
            for (int i = 0; i < 8; ++i) { const float cur = bf2f(raw[i + 1][3]), prev = (sb * 16 + ptb + i == 0) ? pv_x : bf2f(raw[i][3]); float xv = cur + (prev - cur) * mu_x; if (lane < 32) xv = tanhf_(xv); bcs[i * 64 + lane] = xv; }
            float wl[8], al[8];
#pragma unroll
            for (int i = 0; i < 8; ++i) { wl[i] = w0c; al[i] = a0c; }
#pragma unroll 2
            for (int j4 = 0; j4 < 8; ++j4) {
                float wu[4], au[4];
#pragma unroll
                for (int e = 0; e < 4; ++e) { wu[e] = wup[(size_t)(j4 * 4 + e) * 512]; au[e] = aup[(size_t)(j4 * 4 + e) * 512]; }
#pragma unroll
                for (int i = 0; i < 8; ++i) {
                    const f32x4 t4 = *(const LAS f32x4*)(bcs + i * 64 + j4 * 4), x4 = *(const LAS f32x4*)(bcs + i * 64 + 32 + j4 * 4);
#pragma unroll
                    for (int e = 0; e < 4; ++e) { wl[i] += t4[e] * wu[e]; al[i] += x4[e] * au[e]; }
                }
            }
            float rr[8], kr[8], vr[8];
#pragma unroll
            for (int i = 0; i < 8; ++i) { const bool f0 = (sb * 16 + ptb + i == 0);
                const float cr = bf2f(raw[i + 1][0]), ck = bf2f(raw[i + 1][1]), cv = bf2f(raw[i + 1][2]);
                const float qr = f0 ? pv_r : bf2f(raw[i][0]), qk = f0 ? pv_k : bf2f(raw[i][1]), qv = f0 ? pv_v : bf2f(raw[i][2]);
                rr[i] = cr + (qr - cr) * mu_r; kr[i] = ck + (qk - ck) * mu_k; vr[i] = cv + (qv - cv) * mu_v; }
#pragma unroll
            for (int i = 0; i < 8; ++i) {
                const int ti = sb * 16 + ptb + i, row = sg.row0 + ti;
                const float r = rr[i], k = kr[i], v = vr[i];
                const float wlog = -softplusf_(-wl[i]) - 0.5f, dec = __expf(-__expf(wlog));
                const float a = sigmoidf_(al[i]);
                float kk = k * kkc; const float n2 = wave_sum(kk * kk); kk = kk / fmaxf(sqrtf(n2), 1e-12f);
                const float kmod = k * (1.0f + (a - 1.0f) * kac), kka = kk * a;
                const float bs = wave_sum(r * kmod * rkc);
                if (lane == 0) bonus[(size_t)row * 8 + hd] = bs;
                LAS float* st = stage + ((ptb + i) * 4 + phl) * RST;
                st[lane] = dec; st[64 + lane] = kk; st[128 + lane] = kka; st[192 + lane] = kmod; st[256 + lane] = r; st[320 + lane] = v;
            }
        }
        __syncthreads();
        if (sb + 1 < sg.nsteps / 16) RW_LOAD(sb + 1);
        if (!(mode & 8)) for (int tl = 0; tl < 16; ++tl) {
            const LAS float* st = stage + (tl * 4 + (wave & 3)) * RST;
            const int row = sg.row0 + sb * 16 + tl;
            f32x2 w2[8], kk2[8], ka2[8], r2[8];
            load16(st + ks * 16, w2); load16(st + 64 + ks * 16, kk2); load16(st + 128 + ks * 16, ka2); load16(st + 256 + ks * 16, r2);
            float sa[4];
#pragma unroll
            for (int r = 0; r < 4; ++r) { f32x2 acc = s[r][0] * kk2[0];
#pragma unroll
                for (int j = 1; j < 8; ++j) acc = s[r][j] * kk2[j] + acc;
                sa[r] = quad_sum(acc.x + acc.y); }
            float yo[4];
            if (!isH) {
#pragma unroll
                for (int r = 0; r < 4; ++r) { const f32x2 nsa = bc2(-sa[r]);
#pragma unroll
                    for (int j = 0; j < 8; ++j) s[r][j] = s[r][j] * w2[j] + nsa * ka2[j]; }
            } else {
                f32x2 km2[8]; load16(st + 192 + ks * 16, km2);
                const f32x4 v4 = *(const LAS f32x4*)(st + 320 + rg * 4);
#pragma unroll
                for (int r = 0; r < 4; ++r) { const f32x2 nsa = bc2(-sa[r]), vv = bc2(v4[r]);
#pragma unroll
                    for (int j = 0; j < 8; ++j) s[r][j] = (s[r][j] * w2[j] + nsa * ka2[j]) + vv * km2[j]; }
            }
#pragma unroll
            for (int r = 0; r < 4; ++r) { f32x2 acc = s[r][0] * r2[0];
#pragma unroll
                for (int j = 1; j < 8; ++j) acc = s[r][j] * r2[j] + acc;
                yo[r] = quad_sum(acc.x + acc.y); }
            if (ks == 0) {
                u32x2 w; w.x = cvt_pk_bf16(yo[0], yo[1]); w.y = cvt_pk_bf16(yo[2], yo[3]);
                if (!isH) *(u32x2*)(Yb + (size_t)row * 512 + rhd * 64 + rg * 4) = w;
                else *(u32x2*)(HB + (size_t)row * 1024 + rhd * 64 + rg * 4) = w;
            }
        }
        __syncthreads();
    }
    if (!isH) {
        bf16_t* Gf = (bf16_t*)(p.ws + WS_G) + (size_t)(ci * 8 + rhd) * 4096;
#pragma unroll
        for (int j = 0; j < 8; ++j)
#pragma unroll
            for (int h = 0; h < 2; ++h) {
                const int jj = 2 * j + h;
                u32x2 w; w.x = cvt_pk_bf16(h ? s[0][j].y : s[0][j].x, h ? s[1][j].y : s[1][j].x); w.y = cvt_pk_bf16(h ? s[2][j].y : s[2][j].x, h ? s[3][j].y : s[3][j].x);
                *(u32x2*)(Gf + (size_t)((ks * 2 + (rg >> 3)) * 64 + (rg & 3) * 16 + jj) * 8 + ((rg >> 2) & 1) * 4) = w;
            }
    } else {
        float* Hs = (float*)(p.ws + WS_HSR) + (size_t)(ci * 8 + rhd) * 4096;
#pragma unroll
        for (int r = 0; r < 4; ++r)
#pragma unroll
            for (int q = 0; q < 4; ++q) *(f32x4*)(Hs + (rg * 4 + r) * 64 + ks * 16 + q * 4) = (f32x4){s[r][2 * q].x, s[r][2 * q].y, s[r][2 * q + 1].x, s[r][2 * q + 1].y};
    }
}

constexpr int GST = 320;
__device__ __forceinline__ void gla_a_task(const Params& p, LAS unsigned char* lds, int tk) {
    const int tid = tid_opaque(), wave = tid >> 6, lane = tid & 63;
    const bf16_t* P = (const bf16_t*)(p.ws + WS_PACT) + BOFF;
    int row0, nsteps, ci;
    if (tk < 256) { row0 = tk * 64; nsteps = 64; ci = tk; } else { row0 = MPROMPT + (tk - 256) * 16; nsteps = 16; ci = tk; }
    LAS float* stage = (LAS float*)lds;
    LAS float* red = (LAS float*)(lds + 98304);
    const int hd = wave >> 1, half = wave & 1, rg = lane >> 2, ks = lane & 3;
    const int kc = hd * 64 + lane;
    float gku[16];
#pragma unroll
    for (int j = 0; j < 16; ++j) gku[j] = p.in[22][j * 256 + kc];
    const float gkb = p.in[23][kc];
    float lsum = 0.f;
    f32x2 s[4][8];
#pragma unroll
    for (int r = 0; r < 4; ++r)
#pragma unroll
        for (int j = 0; j < 8; ++j) s[r][j] = (f32x2){0.f, 0.f};
    bf16_t* HB = (bf16_t*)(p.ws + WS_HB);
    unsigned gxw; bf16_t graw[8][4];
#define GL_LOAD(sbn) do { gxw = *(const unsigned*)(P + (size_t)(row0 + (sbn) * 16 + half * 8 + (lane >> 3)) * NIN + 1024 + (lane & 7) * 2); \
        _Pragma("unroll") for (int i = 0; i < 8; ++i) { const bf16_t* pr_ = P + (size_t)(row0 + (sbn) * 16 + half * 8 + i) * NIN; graw[i][0] = pr_[256 + kc]; graw[i][1] = pr_[kc]; graw[i][2] = pr_[512 + hd * 128 + lane]; graw[i][3] = pr_[512 + hd * 128 + 64 + lane]; } } while (0)
    GL_LOAD(0);
    for (int sb = 0; sb < nsteps / 16; ++sb) {
        {
            LAS float* xg = (LAS float*)(lds + 81920) + wave * 128;
            { const int j2 = (lane & 7) * 2; xg[(lane >> 3) * 16 + j2] = __uint_as_float(gxw << 16); xg[(lane >> 3) * 16 + j2 + 1] = __uint_as_float(gxw & 0xffff0000u); }
            float kv[8], qv[8], v0[8], v1[8]; float bsub = 0.f;
#pragma unroll
            for (int i = 0; i < 8; ++i) { kv[i] = bf2f(graw[i][0]); qv[i] = bf2f(graw[i][1]) * 0.125f; v0[i] = bf2f(graw[i][2]); v1[i] = bf2f(graw[i][3]); }
#pragma unroll
            for (int i = 0; i < 8; ++i) {
                const int tl = half * 8 + i;
                float gl = gkb;
#pragma unroll
                for (int j4 = 0; j4 < 4; ++j4) { const f32x4 x4 = *(const LAS f32x4*)(xg + i * 16 + j4 * 4); gl += x4[0] * gku[j4 * 4] + x4[1] * gku[j4 * 4 + 1] + x4[2] * gku[j4 * 4 + 2] + x4[3] * gku[j4 * 4 + 3]; }
                const float la = -softplusf_(-gl) * (1.0f / 16.0f);
                lsum += la; bsub += la;
                LAS float* st = stage + (tl * 4 + hd) * GST;
                st[lane] = __expf(la); st[64 + lane] = kv[i]; st[128 + lane] = qv[i]; st[192 + lane] = v0[i]; st[256 + lane] = v1[i];
            }
            ((float*)(p.ws + WS_GBS))[(size_t)((((ci * 4 + sb) * 4 + hd) * 2 + half)) * 64 + lane] = bsub;
        }
        __syncthreads();
        if (sb + 1 < nsteps / 16) GL_LOAD(sb + 1);
        for (int tl = 0; tl < 16; ++tl) {
            const LAS float* st = stage + (tl * 4 + hd) * GST;
            const int row = row0 + sb * 16 + tl;
            f32x2 a2[8], k2[8], q2[8];
            load16(st + ks * 16, a2); load16(st + 64 + ks * 16, k2); load16(st + 128 + ks * 16, q2);
            const f32x4 v4 = *(const LAS f32x4*)(st + 192 + half * 64 + rg * 4);
            float zo[4];
#pragma unroll
            for (int r = 0; r < 4; ++r) { const f32x2 vv = bc2(v4[r]); f32x2 acc = (f32x2){0.f, 0.f};
#pragma unroll
                for (int j = 0; j < 8; ++j) { s[r][j] = s[r][j] * a2[j] + vv * k2[j]; acc = s[r][j] * q2[j] + acc; }
                zo[r] = quad_sum(acc.x + acc.y); }
            if (ks == 0) { u32x2 w; w.x = cvt_pk_bf16(zo[0], zo[1]); w.y = cvt_pk_bf16(zo[2], zo[3]);
                *(u32x2*)(HB + (size_t)row * 1024 + 512 + hd * 128 + half * 64 + rg * 4) = w; }
        }
        __syncthreads();
    }
    float* Hs = (float*)(p.ws + WS_HSG) + (size_t)(ci * 4 + hd) * 8192;
#pragma unroll
    for (int j = 0; j < 8; ++j) {
        *(f32x4*)(Hs + (ks * 16 + 2 * j) * 128 + half * 64 + rg * 4) = (f32x4){s[0][j].x, s[1][j].x, s[2][j].x, s[3][j].x};
        *(f32x4*)(Hs + (ks * 16 + 2 * j + 1) * 128 + half * 64 + rg * 4) = (f32x4){s[0][j].y, s[1][j].y, s[2][j].y, s[3][j].y};
    }
    red[wave * 64 + lane] = lsum;
    __syncthreads();
    if (half == 0) ((float*)(p.ws + WS_DECG))[(size_t)(ci * 4 + hd) * 64 + lane] = __expf(red[wave * 64 + lane] + red[(wave + 1) * 64 + lane]);
    __syncthreads();
}
__device__ __forceinline__ bf16x8 pack8(const float (&v)[8]);
typedef short bf16x4 __attribute__((ext_vector_type(4)));
typedef __bf16 bf16v2 __attribute__((ext_vector_type(2)));
__device__ __forceinline__ unsigned cvt_pk_native(float a, float b) { const f32x2 v = (f32x2){a, b}; const bf16v2 r = __builtin_convertvector(v, bf16v2); return __builtin_bit_cast(unsigned, r); }
__device__ __forceinline__ bf16x8 pack4z(float a, float b, float c, float d) { u32x4 w; w.x = cvt_pk_bf16(a, b); w.y = cvt_pk_bf16(c, d); w.z = 0u; w.w = 0u; return __builtin_bit_cast(bf16x8, w); }
__device__ __forceinline__ void gla_a_wave_task(const Params& p, LAS unsigned char* wl8, int ci, int row0, int nblk, int hd, int sel) {
    const int lane = tid_opaque() & 63, n = lane & 15, q = lane >> 4, kc = hd * 64 + lane;
    const bf16_t* P = (const bf16_t*)(p.ws + WS_PACT) + BOFF; bf16_t* HB = (bf16_t*)(p.ws + WS_HB);
    LAS float* XG = (LAS float*)wl8; LAS bf16_t* QT = (LAS bf16_t*)(wl8 + 1024); LAS bf16_t* KT = (LAS bf16_t*)(wl8 + 3328); LAS bf16_t* KTt = (LAS bf16_t*)(wl8 + 5632); LAS float* BETA = (LAS float*)(wl8 + 8704);
    float gku[16];
#pragma unroll
    for (int j = 0; j < 16; ++j) gku[j] = p.in[22][j * 256 + kc];
    const float gkb = p.in[23][kc];
    f32x4 H[4][8];
#pragma unroll
    for (int kt = 0; kt < 4; ++kt)
#pragma unroll
        for (int vt = 0; vt < 8; ++vt) H[kt][vt] = (f32x4){0.f, 0.f, 0.f, 0.f};
    float lsum = 0.f;
    for (int blk = 0; blk < nblk; ++blk) {
        const int rowb = row0 + blk * 16;
        { const int idx = lane * 4, tk = idx >> 4, j = idx & 15;
          const u32x2 xw = *(const u32x2*)(P + (size_t)(rowb + tk) * NIN + 1024 + j);
          *(LAS f32x4*)(XG + idx) = (f32x4){__uint_as_float(xw.x << 16), __uint_as_float(xw.x & 0xffff0000u), __uint_as_float(xw.y << 16), __uint_as_float(xw.y & 0xffff0000u)}; }
        unsigned qkr[16];
#pragma unroll
        for (int i = 0; i < 16; ++i) { const bf16_t* pr = P + (size_t)(rowb + i) * NIN; qkr[i] = (unsigned)pr[kc] | ((unsigned)pr[256 + kc] << 16); }
        float bsub = 0.f;
#pragma unroll
        for (int i = 0; i < 16; ++i) {
            float gl = gkb;
#pragma unroll
            for (int j4 = 0; j4 < 4; ++j4) { const f32x4 x4 = *(const LAS f32x4*)(XG + i * 16 + j4 * 4); gl += x4[0] * gku[j4 * 4] + x4[1] * gku[j4 * 4 + 1] + x4[2] * gku[j4 * 4 + 2] + x4[3] * gku[j4 * 4 + 3]; }
            bsub += -softplusf_(-gl) * (1.0f / 16.0f);
            const unsigned qk = cvt_pk_bf16(__uint_as_float(qkr[i] << 16) * 0.125f * __expf(bsub), __uint_as_float(qkr[i] & 0xffff0000u) * __expf(-bsub));
            QT[i * 72 + lane] = (bf16_t)(qk & 0xffffu); KT[i * 72 + lane] = (bf16_t)(qk >> 16); KTt[lane * 24 + i] = (bf16_t)(qk >> 16);
        }
        BETA[lane] = __expf(bsub); lsum += bsub;
        asm volatile("" ::: "memory");
        if (sel & 4) { float* gb = (float*)(p.ws + WS_GBS) + (size_t)(((ci * 4 + blk) * 4 + hd) * 2) * 64 + lane; gb[0] = bsub; gb[64] = 0.f; }
        u32x2 VP[8];
#pragma unroll
        for (int vt = 0; vt < 8; ++vt) { const bf16_t* vp = P + (size_t)(rowb + 4 * q) * NIN + 512 + hd * 128 + vt * 16 + n;
            VP[vt].x = (unsigned)vp[0] | ((unsigned)vp[NIN] << 16); VP[vt].y = (unsigned)vp[2 * NIN] | ((unsigned)vp[3 * NIN] << 16); }
#define VF(vt) __builtin_bit_cast(bf16x8, (u32x4){VP[vt].x, VP[vt].y, 0u, 0u})
        f32x4 sc = (f32x4){0.f, 0.f, 0.f, 0.f};
#pragma unroll
        for (int kh = 0; kh < 2; ++kh) sc = __builtin_amdgcn_mfma_f32_16x16x32_bf16(*(const LAS bf16x8*)(KT + n * 72 + kh * 32 + q * 8), *(const LAS bf16x8*)(QT + n * 72 + kh * 32 + q * 8), sc, 0, 0, 0);
        const bf16x8 SCB = pack4z(4 * q + 0 <= n ? sc[0] : 0.f, 4 * q + 1 <= n ? sc[1] : 0.f, 4 * q + 2 <= n ? sc[2] : 0.f, 4 * q + 3 <= n ? sc[3] : 0.f);
        bf16x8 QB[2];
#pragma unroll
        for (int kh = 0; kh < 2; ++kh) { const u32x2 a = __builtin_bit_cast(u32x2, *(const LAS bf16x4*)(QT + n * 72 + kh * 32 + 4 * q)), b = __builtin_bit_cast(u32x2, *(const LAS bf16x4*)(QT + n * 72 + kh * 32 + 16 + 4 * q));
            u32x4 w; w.x = a.x; w.y = a.y; w.z = b.x; w.w = b.y; QB[kh] = __builtin_bit_cast(bf16x8, w); }
#pragma unroll
        for (int vt = 0; vt < 8; ++vt) {
            f32x4 z = (f32x4){0.f, 0.f, 0.f, 0.f};
#pragma unroll
            for (int kh = 0; kh < 2; ++kh) { const float hv[8] = {H[2 * kh][vt][0], H[2 * kh][vt][1], H[2 * kh][vt][2], H[2 * kh][vt][3], H[2 * kh + 1][vt][0], H[2 * kh + 1][vt][1], H[2 * kh + 1][vt][2], H[2 * kh + 1][vt][3]};
                z = __builtin_amdgcn_mfma_f32_16x16x32_bf16(pack8(hv), QB[kh], z, 0, 0, 0); }
            z = __builtin_amdgcn_mfma_f32_16x16x32_bf16(VF(vt), SCB, z, 0, 0, 0);
            u32x2 w; w.x = cvt_pk_native(z[0], z[1]); w.y = cvt_pk_native(z[2], z[3]);
            if (sel & 1) *(u32x2*)(HB + (size_t)(rowb + n) * 1024 + 512 + hd * 128 + vt * 16 + 4 * q) = w;
        }
#pragma unroll
        for (int kt = 0; kt < 4; ++kt) {
            const u32x2 ka = __builtin_bit_cast(u32x2, *(const LAS bf16x4*)(KTt + (kt * 16 + n) * 24 + 4 * q));
            u32x4 kw; kw.x = ka.x; kw.y = ka.y; kw.z = 0u; kw.w = 0u; const bf16x8 KA = __builtin_bit_cast(bf16x8, kw);
            const f32x4 b4 = *(const LAS f32x4*)(BETA + kt * 16 + 4 * q);
#pragma unroll
            for (int vt = 0; vt < 8; ++vt) H[kt][vt] = __builtin_amdgcn_mfma_f32_16x16x32_bf16(KA, VF(vt), H[kt][vt], 0, 0, 0) * b4;
        }
    }
#undef VF
    float* Hs = (float*)(p.ws + WS_HSG) + (size_t)(ci * 4 + hd) * 8192;
#pragma unroll
    for (int kt = 0; kt < 4; ++kt)
#pragma unroll
        for (int vt = 0; vt < 8; ++vt)
#pragma unroll
            for (int i = 0; i < 4; ++i) if (sel & 2) Hs[(kt * 16 + 4 * q + i) * 128 + vt * 16 + n] = H[kt][vt][i];
    if (sel & 4) ((float*)(p.ws + WS_DECG))[(size_t)(ci * 4 + hd) * 64 + lane] = __expf(lsum);
}
__device__ __forceinline__ void phase_mix_a2(const Params& p, LAS unsigned char* lds, int sel) {
    const int wave = tid_opaque() >> 6, skip = gridDim.x >= 64 ? 32 : 0, ng = (int)gridDim.x - skip, nw = ng * 8;
    if ((int)blockIdx.x >= skip) for (int j = wave * ng + ((int)blockIdx.x - skip); j < 1088; j += nw) {
        int ci, row0, nblk, hd;
        if (j < 1024) { ci = j >> 2; row0 = ci * 64; nblk = 4; hd = j & 3; }
        else { const int r = j - 1024, sb = r >> 2; ci = 256 + sb; row0 = MPROMPT + sb * 16; nblk = 1; hd = r & 3; }
        gla_a_wave_task(p, lds + wave * 16384, ci, row0, nblk, hd, sel);
    }
}
__device__ __forceinline__ void phase_mix_a(const Params& p, LAS unsigned char* lds, int mask) {
    if (mask & 1) for (int t = blockIdx.x; t < 288; t += gridDim.x) rwkv_a_task(p, lds, t, mask);
    if (mask & 2) phase_mix_a2(p, lds, 7);
}

__device__ __forceinline__ void rwkv_scan_job(const Params& p, int head, int vt, int ci0, int nchunks, const float* S0, float* Sout, int dry) {
    const int lane = tid_opaque() & 63, n = lane & 15, q = lane >> 4, v = vt * 16 + n;
    f32x4 D[4];
#pragma unroll
    for (int jt = 0; jt < 4; ++jt) D[jt] = S0 ? *(const f32x4*)(S0 + v * 64 + jt * 16 + q * 4) : (f32x4){0.f, 0.f, 0.f, 0.f};
    for (int c = 0; c < nchunks; ++c) {
        const int ci = ci0 + c;
        float* HS = (float*)(p.ws + WS_HSR) + (size_t)(ci * 8 + head) * 4096;
        const bf16x8* Gf = (const bf16x8*)(p.ws + WS_G + (size_t)(ci * 8 + head) * 8192);
        f32x4 Hc[4]; bf16x8 A[4][2];
#pragma unroll
        for (int jt = 0; jt < 4; ++jt) { Hc[jt] = *(const f32x4*)(HS + v * 64 + jt * 16 + q * 4); A[jt][0] = Gf[(jt * 2 + 0) * 64 + lane]; A[jt][1] = Gf[(jt * 2 + 1) * 64 + lane]; }
#pragma unroll
        for (int jt = 0; jt < 4; ++jt) *(f32x4*)(HS + v * 64 + jt * 16 + q * 4) = dry ? Hc[jt] : D[jt];
        bf16x8 B[2];
#pragma unroll
        for (int kh = 0; kh < 2; ++kh) { u32x4 w; w.x = cvt_pk_native(D[2 * kh][0], D[2 * kh][1]); w.y = cvt_pk_native(D[2 * kh][2], D[2 * kh][3]);
            w.z = cvt_pk_native(D[2 * kh + 1][0], D[2 * kh + 1][1]); w.w = cvt_pk_native(D[2 * kh + 1][2], D[2 * kh + 1][3]); B[kh] = __builtin_bit_cast(bf16x8, w); }
#pragma unroll
        for (int jt = 0; jt < 4; ++jt) { f32x4 d = __builtin_amdgcn_mfma_f32_16x16x32_bf16(A[jt][0], B[0], Hc[jt], 0, 0, 0); D[jt] = __builtin_amdgcn_mfma_f32_16x16x32_bf16(A[jt][1], B[1], d, 0, 0, 0); }
    }
#pragma unroll
    for (int jt = 0; jt < 4; ++jt) *(f32x4*)(Sout + v * 64 + jt * 16 + q * 4) = D[jt];
}
constexpr int SC_SLOT = 12544, SC_NB = 8;
__device__ __forceinline__ void rwkv_scan_prompt(const Params& p, LAS unsigned char* lds, int head, int vt, int dry) {
    const int tid = tid_opaque(), wave = tid >> 6, lane = tid & 63, n = lane & 15, q = lane >> 4, v = vt * 16 + n;
    const unsigned char* Gb = p.ws + WS_G; unsigned char* Hb = p.ws + WS_HSR;
    u32x4 pfA[12], pfB[12];
    unsigned off0[12], hmask = 0u;
#pragma unroll
    for (int i = 0; i < 12; ++i) { const int qd = tid + 512 * i, cl = qd / 768, wi = qd % 768;
        off0[i] = wi < 512 ? (unsigned)(WS_G + (size_t)(cl * 8 + head) * 8192 + wi * 16) : (unsigned)(WS_HSR + ((size_t)(cl * 8 + head) * 4096 + vt * 1024) * 4 + (wi - 512) * 16);
        hmask |= (wi < 512 ? 0u : 1u) << i; }
#define SC_ISSUE(pf, batch) do { _Pragma("unroll") for (int i = 0; i < 12; ++i) { \
        const unsigned o_ = off0[i] + (unsigned)(batch) * ((unsigned)(SC_NB * 8 * 8192) << ((hmask >> i) & 1u)); pf[i] = *(const u32x4*)(p.ws + o_); } } while (0)
#define SC_COMMIT(pf) do { _Pragma("unroll") for (int i = 0; i < 12; ++i) { const int qd = tid + 512 * i, cl = qd / 768, wi = qd % 768; \
        const int dst = cl * SC_SLOT + (wi < 512 ? wi * 16 : 8192 + ((wi - 512) >> 4) * 272 + ((wi - 512) & 15) * 16); *(LAS u32x4*)(lds + dst) = pf[i]; } } while (0)
#define SC_COMPUTE(bb) do { if (wave == 0) { for (int cl = 0; cl < SC_NB; ++cl) { \
                const int ci = (bb) * SC_NB + cl; const LAS unsigned char* sl = lds + cl * SC_SLOT; \
                float* HS = (float*)Hb + (size_t)(ci * 8 + head) * 4096; \
                f32x4 Hc[4]; bf16x8 A[4][2]; \
                _Pragma("unroll") for (int jt = 0; jt < 4; ++jt) { Hc[jt] = *(const LAS f32x4*)(sl + 8192 + n * 272 + (jt * 4 + q) * 16); \
                    A[jt][0] = *(const LAS bf16x8*)(sl + ((jt * 2 + 0) * 64 + lane) * 16); A[jt][1] = *(const LAS bf16x8*)(sl + ((jt * 2 + 1) * 64 + lane) * 16); } \
                _Pragma("unroll") for (int jt = 0; jt < 4; ++jt) *(f32x4*)(HS + v * 64 + jt * 16 + q * 4) = dry ? Hc[jt] : D[jt]; \
                bf16x8 B[2]; \
                _Pragma("unroll") for (int kh = 0; kh < 2; ++kh) { u32x4 w; w.x = cvt_pk_native(D[2 * kh][0], D[2 * kh][1]); w.y = cvt_pk_native(D[2 * kh][2], D[2 * kh][3]); \
                    w.z = cvt_pk_native(D[2 * kh + 1][0], D[2 * kh + 1][1]); w.w = cvt_pk_native(D[2 * kh + 1][2], D[2 * kh + 1][3]); B[kh] = __builtin_bit_cast(bf16x8, w); } \
                _Pragma("unroll") for (int jt = 0; jt < 4; ++jt) { f32x4 d = __builtin_amdgcn_mfma_f32_16x16x32_bf16(A[jt][0], B[0], Hc[jt], 0, 0, 0); D[jt] = __builtin_amdgcn_mfma_f32_16x16x32_bf16(A[jt][1], B[1], d, 0, 0, 0); } \
            } } } while (0)
    f32x4 D[4];
#pragma unroll
    for (int jt = 0; jt < 4; ++jt) D[jt] = (f32x4){0.f, 0.f, 0.f, 0.f};
    constexpr int NBT = 128 / SC_NB;
    SC_ISSUE(pfA, 0); SC_COMMIT(pfA);
    __syncthreads();
    SC_ISSUE(pfA, 1); SC_ISSUE(pfB, 2);
    for (int b = 0; b < NBT; b += 2) {
        SC_COMPUTE(b);
        __syncthreads();
        SC_COMMIT(pfA);
        { const int nb_ = b + 3 < NBT ? b + 3 : NBT - 1; SC_ISSUE(pfA, nb_); }
        __syncthreads();
        SC_COMPUTE(b + 1);
        __syncthreads();
        SC_COMMIT(pfB);
        { const int nb_ = b + 4 < NBT ? b + 4 : NBT - 1; SC_ISSUE(pfB, nb_); }
        __syncthreads();
    }
#undef SC_COMPUTE
    if (wave == 0) {
        float* Sout = p.out + O_WKV_P + (size_t)head * 4096;
#pragma unroll
        for (int jt = 0; jt < 4; ++jt) *(f32x4*)(Sout + v * 64 + jt * 16 + q * 4) = D[jt];
    }
#undef SC_ISSUE
#undef SC_COMMIT
}
__device__ __forceinline__ void phase_scan(const Params& p, LAS unsigned char* lds, int dry) {
    const int tid = tid_opaque(), wave = tid >> 6, b = blockIdx.x;
    float* HSG = (float*)(p.ws + WS_HSG); const float* DEC = (const float*)(p.ws + WS_DECG);
    if (b < 32) rwkv_scan_prompt(p, lds, b >> 2, b & 3, dry);
    else if (b < 96) {
        const int e = (b - 32) * 512 + tid, hd = e >> 13, k = (e >> 7) & 63;
        float S = 0.f;
        for (int c = 0; c < 256; c += 32) {
            float t[32], d[32];
#pragma unroll
            for (int u = 0; u < 32; ++u) { t[u] = HSG[(size_t)(c + u) * 32768 + e]; d[u] = DEC[(size_t)((c + u) * 4 + hd) * 64 + k]; }
#pragma unroll
            for (int u = 0; u < 32; ++u) { HSG[(size_t)(c + u) * 32768 + e] = dry ? t[u] : S; S = S * d[u] + t[u]; }
        }
        p.out[O_GLA_P + e] = S;
    } else {
        const int nb = gridDim.x - 96, bb = b - 96;
        for (int j = bb * 8 + wave; j < 512; j += nb * 8) { const int sb = j >> 5, hd = (j >> 2) & 7, vt = j & 3;
            rwkv_scan_job(p, hd, vt, 128 + sb, 1, p.in[3] + (size_t)(sb * 8 + hd) * 4096, p.out + O_WKV_S + (size_t)(sb * 8 + hd) * 4096, dry); }
        for (int i = bb * 512 + tid; i < 16 * 8192; i += nb * 512) { const int sb = i >> 13, e = (i & 8191) * 4, hd = e >> 13, k = (e >> 7) & 63;
            const f32x4 S0 = *(const f32x4*)(p.in[4] + (size_t)sb * 32768 + e); float* hp = HSG + (size_t)(256 + sb) * 32768 + e;
            const f32x4 t = *(const f32x4*)hp; const float d = DEC[(size_t)((256 + sb) * 4 + hd) * 64 + k];
            *(f32x4*)hp = dry ? t : S0; *(f32x4*)(p.out + O_GLA_S + (size_t)sb * 32768 + e) = S0 * d + t; }
    }
}

struct RwkvCConst { bf16x8 GB[4][2]; float lw[4], lb[4], muv[4]; float mug[16]; };
__device__ __forceinline__ float row16_sum(float x) {
    x += __int_as_float(__builtin_amdgcn_update_dpp(0, __float_as_int(x), 0xB1, 0xF, 0xF, true));
    x += __int_as_float(__builtin_amdgcn_update_dpp(0, __float_as_int(x), 0x4E, 0xF, 0xF, true));
    x += __int_as_float(__builtin_amdgcn_update_dpp(0, __float_as_int(x), 0x124, 0xF, 0xF, true));
    x += __int_as_float(__builtin_amdgcn_update_dpp(0, __float_as_int(x), 0x128, 0xF, 0xF, true));
    return x;
}
__device__ __forceinline__ bf16x8 pack8(const float (&v)[8]) {
    u32x4 w; w.x = cvt_pk_bf16(v[0], v[1]); w.y = cvt_pk_bf16(v[2], v[3]); w.z = cvt_pk_bf16(v[4], v[5]); w.w = cvt_pk_bf16(v[6], v[7]); return __builtin_bit_cast(bf16x8, w);
}
__device__ __forceinline__ void unpack8(u32x4 w, float (&v)[8]) {
    v[0] = __uint_as_float(w.x << 16); v[1] = __uint_as_float(w.x & 0xffff0000u); v[2] = __uint_as_float(w.y << 16); v[3] = __uint_as_float(w.y & 0xffff0000u);
    v[4] = __uint_as_float(w.z << 16); v[5] = __uint_as_float(w.z & 0xffff0000u); v[6] = __uint_as_float(w.w << 16); v[7] = __uint_as_float(w.w & 0xffff0000u);
}
__device__ __forceinline__ void rwkv_c_const(const Params& p, int hd, RwkvCConst& K) {
    const int lane = tid_opaque() & 63, n = lane & 15, q = lane >> 4;
#pragma unroll
    for (int nt = 0; nt < 4; ++nt) {
        const int C = hd * 64 + nt * 16 + n;
        K.lw[nt] = p.in[20][C]; K.lb[nt] = p.in[21][C]; K.muv[nt] = p.in[11][1024 + C];
#pragma unroll
        for (int kh = 0; kh < 2; ++kh) { float g[8];
#pragma unroll
            for (int e = 0; e < 8; ++e) g[e] = p.in[16][(size_t)(kh * 32 + q * 8 + e) * 512 + C];
            K.GB[nt][kh] = pack8(g); }
    }
#pragma unroll
    for (int kh = 0; kh < 2; ++kh)
#pragma unroll
        for (int e = 0; e < 8; ++e) K.mug[kh * 8 + e] = p.in[11][1600 + kh * 32 + q * 8 + e];
}
__device__ __forceinline__ void rwkv_c_task(const Params& p, const RwkvCConst& K, int ci, int tok0, int hd, const Seg& sg, int dry) {
    const int lane = tid_opaque() & 63, n = lane & 15, q = lane >> 4;
    const bf16_t* P = (const bf16_t*)(p.ws + WS_PACT);
    const bf16_t* Yb = (const bf16_t*)(p.ws + WS_Y); bf16_t* HB = (bf16_t*)(p.ws + WS_HB);
    const float* Ss = (const float*)(p.ws + WS_HSR) + (size_t)(ci * 8 + hd) * 4096;
    const float* bonus = (const float*)(p.ws + WS_BONUS);
    const int rowb = sg.row0 + tok0;
    bf16x8 SB[4][2]; float bo[4]; bf16_t zr[4][4], cr_[4][4]; float pv0[4];
#pragma unroll
    for (int nt = 0; nt < 4; ++nt)
#pragma unroll
        for (int kh = 0; kh < 2; ++kh) {
            const float* sp = Ss + (nt * 16 + n) * 64 + kh * 32 + q * 8;
            const f32x4 s0 = *(const f32x4*)sp, s1 = *(const f32x4*)(sp + 4);
            const float sv[8] = {s0[0], s0[1], s0[2], s0[3], s1[0], s1[1], s1[2], s1[3]};
            SB[nt][kh] = pack8(sv);
        }
#pragma unroll
    for (int i = 0; i < 4; ++i) bo[i] = bonus[(size_t)(rowb + q * 4 + i) * 8 + hd];
#pragma unroll
    for (int nt = 0; nt < 4; ++nt) {
        const int C = hd * 64 + nt * 16 + n;
        const bool first = (tok0 + q * 4 == 0) && sg.prevkind != 1;
        pv0[nt] = bf2f(P[(size_t)(rowb + q * 4 - (first ? 0 : 1)) * NIN + 1024 + C]);
        if (first) pv0[nt] = sg.prevkind == 2 ? sg.prevptr[1024 + C] : 0.f;
#pragma unroll
        for (int i = 0; i < 4; ++i) { const int row = rowb + q * 4 + i; zr[nt][i] = HB[(size_t)row * 1024 + C]; cr_[nt][i] = P[(size_t)row * NIN + 1024 + C]; }
    }
    bf16x8 AY[2], AG[2];
    {
        const bool first = (tok0 + n == 0) && sg.prevkind != 1;
        const bf16_t* cr = P + (size_t)(rowb + n) * NIN + 1600 + q * 8;
        const bf16_t* pr = P + (size_t)(rowb + n - (first ? 0 : 1)) * NIN + 1600 + q * 8;
#pragma unroll
        for (int kh = 0; kh < 2; ++kh) {
            AY[kh] = *(const bf16x8*)(Yb + (size_t)(rowb + n) * 512 + hd * 64 + kh * 32 + q * 8);
            float c8[8], p8[8];
            unpack8(*(const u32x4*)(cr + kh * 32), c8); unpack8(*(const u32x4*)(pr + kh * 32), p8);
            if (first) {
#pragma unroll
                for (int e = 0; e < 8; ++e) p8[e] = sg.prevkind == 2 ? sg.prevptr[1600 + kh * 32 + q * 8 + e] : 0.f;
            }
#pragma unroll
            for (int e = 0; e < 8; ++e) c8[e] = sigmoidf_(c8[e] + (p8[e] - c8[e]) * K.mug[kh * 8 + e]);
            AG[kh] = pack8(c8);
        }
    }
    f32x4 D[4], G[4];
#pragma unroll
    for (int nt = 0; nt < 4; ++nt) {
        f32x4 d = (f32x4){0.f, 0.f, 0.f, 0.f}, g = (f32x4){0.f, 0.f, 0.f, 0.f};
#pragma unroll
        for (int kh = 0; kh < 2; ++kh) {
            d = __builtin_amdgcn_mfma_f32_16x16x32_bf16(AY[kh], SB[nt][kh], d, 0, 0, 0);
            g = __builtin_amdgcn_mfma_f32_16x16x32_bf16(AG[kh], K.GB[nt][kh], g, 0, 0, 0);
        }
        D[nt] = d; G[nt] = g;
    }
    float o[4][4], vv[4][4];
#pragma unroll
    for (int nt = 0; nt < 4; ++nt) {
        float pv = pv0[nt];
#pragma unroll
        for (int i = 0; i < 4; ++i) {
            o[nt][i] = D[nt][i] + bf2f(zr[nt][i]);
            const float cv = bf2f(cr_[nt][i]);
            vv[nt][i] = cv + (pv - cv) * K.muv[nt]; pv = cv;
        }
    }
#pragma unroll
    for (int i = 0; i < 4; ++i) {
        const float mean = row16_sum((o[0][i] + o[1][i]) + (o[2][i] + o[3][i])) * (1.0f / 64.0f);
        float d2 = 0.f;
#pragma unroll
        for (int nt = 0; nt < 4; ++nt) { o[nt][i] -= mean; d2 += o[nt][i] * o[nt][i]; }
        const float rs = rsqrtf(row16_sum(d2) * (1.0f / 64.0f) + 64e-5f);
#pragma unroll
        for (int nt = 0; nt < 4; ++nt) {
            const int C = hd * 64 + nt * 16 + n;
            const float res = (o[nt][i] * rs * K.lw[nt] + K.lb[nt] + bo[i] * vv[nt][i]) * G[nt][i];
            const unsigned rb = cvt_pk_bf16(res, 0.f);
            bf16_t* dp = dry ? (bf16_t*)(p.ws + WS_DUMMY) + (size_t)blockIdx.x * 512 + threadIdx.x : HB + (size_t)(rowb + q * 4 + i) * 1024 + C;
            *dp = (bf16_t)(rb & 0xffffu);
        }
    }
}
__device__ __forceinline__ void gla_c_task(const Params& p, LAS float* wl, int ci, int row0, int rd, int hd, int dry) {
    const int lane = tid_opaque() & 63, n = lane & 15, q = lane >> 4, kc = hd * 64 + lane;
    const bf16_t* P = (const bf16_t*)(p.ws + WS_PACT) + BOFF; bf16_t* HB = (bf16_t*)(p.ws + WS_HB);
    const float* Ss = (const float*)(p.ws + WS_HSG) + (size_t)(ci * 4 + hd) * 8192;
    LAS float* XG = wl; LAS bf16_t* QT = (LAS bf16_t*)(wl + 256);
    const int rowb = row0 + rd * 16;
    float gku[16];
#pragma unroll
    for (int j = 0; j < 16; ++j) gku[j] = p.in[22][j * 256 + kc];
    const float gkb = p.in[23][kc];
    float bsum = 0.f;
    for (int sb = 0; sb < rd; ++sb) { const float* g = (const float*)(p.ws + WS_GBS) + (size_t)(((ci * 4 + sb) * 4 + hd) * 2) * 64 + lane; bsum += g[0]; bsum += g[64]; }
    { const int idx = lane * 4, tk = idx >> 4, j = idx & 15;
      const u32x2 xw = *(const u32x2*)(P + (size_t)(rowb + tk) * NIN + 1024 + j);
      *(LAS f32x4*)(XG + idx) = (f32x4){__uint_as_float(xw.x << 16), __uint_as_float(xw.x & 0xffff0000u), __uint_as_float(xw.y << 16), __uint_as_float(xw.y & 0xffff0000u)}; }
    float qv[16];
#pragma unroll
    for (int i = 0; i < 16; ++i) qv[i] = bf2f(P[(size_t)(rowb + i) * NIN + kc]) * 0.125f;
    bf16x8 B[8][2];
#pragma unroll
    for (int nt = 0; nt < 8; ++nt)
#pragma unroll
        for (int kh = 0; kh < 2; ++kh) { float sv[8];
#pragma unroll
            for (int e = 0; e < 8; ++e) sv[e] = Ss[(size_t)(kh * 32 + q * 8 + e) * 128 + nt * 16 + n];
            B[nt][kh] = pack8(sv); }
    bf16_t zr[4][8], gr[4][8]; float ng[8];
#pragma unroll
    for (int nt = 0; nt < 8; ++nt) ng[nt] = p.in[24][nt * 16 + n];
#pragma unroll
    for (int i = 0; i < 4; ++i) {
        const int row = rowb + q * 4 + i;
#pragma unroll
        for (int nt = 0; nt < 8; ++nt) { zr[i][nt] = HB[(size_t)row * 1024 + 512 + hd * 128 + nt * 16 + n]; gr[i][nt] = P[(size_t)row * NIN + 1040 + hd * 128 + nt * 16 + n]; }
    }
    __builtin_amdgcn_sched_barrier(0);
#pragma unroll
    for (int i = 0; i < 16; ++i) {
        float gl = gkb;
#pragma unroll
        for (int j4 = 0; j4 < 4; ++j4) { const f32x4 x4 = *(const LAS f32x4*)(XG + i * 16 + j4 * 4); gl += x4[0] * gku[j4 * 4] + x4[1] * gku[j4 * 4 + 1] + x4[2] * gku[j4 * 4 + 2] + x4[3] * gku[j4 * 4 + 3]; }
        bsum += -softplusf_(-gl) * (1.0f / 16.0f);
        QT[i * 72 + lane] = (bf16_t)(cvt_pk_bf16(qv[i] * __expf(bsum), 0.f) & 0xffffu);
    }
    bf16x8 A[2];
#pragma unroll
    for (int kh = 0; kh < 2; ++kh) A[kh] = *(const LAS bf16x8*)(QT + n * 72 + kh * 32 + q * 8);
    f32x4 D[8];
#pragma unroll
    for (int nt = 0; nt < 8; ++nt) {
        f32x4 d = (f32x4){0.f, 0.f, 0.f, 0.f};
#pragma unroll
        for (int kh = 0; kh < 2; ++kh) d = __builtin_amdgcn_mfma_f32_16x16x32_bf16(A[kh], B[nt][kh], d, 0, 0, 0);
        D[nt] = d;
    }
#pragma unroll
    for (int i = 0; i < 4; ++i) {
        const int row = rowb + q * 4 + i;
        bf16_t* ob = HB + (size_t)row * 1024 + 512 + hd * 128 + n;
        float o[8], ss = 0.f;
#pragma unroll
        for (int nt = 0; nt < 8; ++nt) { o[nt] = D[nt][i] + bf2f(zr[i][nt]); ss += o[nt] * o[nt]; }
        const float rs = rsqrtf(row16_sum(ss) * (1.0f / 128.0f) + 1e-6f);
#pragma unroll
        for (int nt = 0; nt < 8; ++nt) {
            const float g = bf2f(gr[i][nt]);
            const unsigned rb = cvt_pk_bf16(o[nt] * rs * ng[nt] * g * sigmoidf_(g), 0.f);
            bf16_t* dp = dry ? (bf16_t*)(p.ws + WS_DUMMY) + (size_t)blockIdx.x * 512 + threadIdx.x : ob + nt * 16;
            *dp = (bf16_t)(rb & 0xffffu);
        }
    }
}
__device__ __forceinline__ void phase_mix_c(const Params& p, LAS unsigned char* lds, int dry, int mask) {
    const int wave = tid_opaque() >> 6, widx = wave * (int)gridDim.x + (int)blockIdx.x, nw = gridDim.x * 8;
    LAS float* wl = (LAS float*)(lds + wave * 16384);
    if (mask & 1) for (int j = widx; j < 4160; j += nw) {
        int ci, row0, rd, hd;
        if (j < 4096) { ci = j >> 4; row0 = ci * 64; rd = (j >> 2) & 3; hd = j & 3; }
        else { const int r = j - 4096, sb = r >> 2; ci = 256 + sb; row0 = MPROMPT + sb * 16; rd = 0; hd = r & 3; }
        gla_c_task(p, wl, ci, row0, rd, hd, dry);
    }
    const int jb = (widx + 4160) % nw, js = nw, je = 8320;
    RwkvCConst KC; rwkv_c_const(p, jb & 7, KC);
    if (mask & 2) for (int j = jb; j < je; j += js) {
        Seg sg; int ci, tok0, hd;
        if (j < 8192) { const int c = j >> 6; ci = c; tok0 = ((j >> 3) & 7) * 16; hd = j & 7; sg.row0 = c * 128; sg.nsteps = 128; sg.prevkind = c == 0 ? 0 : 1; sg.prevptr = nullptr; }
        else { const int r = j - 8192, sb = r >> 3; ci = 128 + sb; tok0 = 0; hd = r & 7; sg.row0 = MPROMPT + sb * 16; sg.nsteps = 16; sg.prevkind = 2; sg.prevptr = p.in[2] + (size_t)sb * ACOLS; }
        rwkv_c_task(p, KC, ci, tok0, hd, sg, dry);
    }
}
__global__ void __launch_bounds__(512, 2) fwd_megakernel(Params p) {
    extern __shared__ __attribute__((aligned(16))) unsigned char shm[];
    LAS unsigned char* lds = (LAS unsigned char*)shm;
    cg::grid_group grid = cg::this_grid();
    float* ssq = (float*)(p.ws + WS_SSQ);
    bf16_t* HB = (bf16_t*)(p.ws + WS_HB); bf16_t* HB2 = (bf16_t*)(p.ws + WS_HB2); bf16_t* PACT = (bf16_t*)(p.ws + WS_PACT);
    float* XRES = p.out;
    float* RSTD = (float*)(p.ws + WS_RSTD);
    float* PART = (float*)(p.ws + WS_HSR);
#if BARRIER_KIND == 0
#define GSYNC() grid.sync()
#elif BARRIER_KIND == 1
#define GSYNC() xcd_barrier(xb)
#else
    unsigned bar_round = 0;
    const unsigned bar_g = blockIdx.x & 7u, bar_gsize = (gridDim.x + 7u - bar_g) >> 3, bar_ngrp = gridDim.x < 8u ? gridDim.x : 8u;
#define GSYNC() do { asm volatile("s_waitcnt vmcnt(0)" ::: "memory"); __syncthreads(); if (threadIdx.x == 0) { size_t off_ = WS_BAR + 3520 * 4; asm volatile("" : "+s"(off_)); unsigned* cnt_ = (unsigned*)(p.ws + off_); ++bar_round; \
        __builtin_amdgcn_fence(__ATOMIC_RELEASE, "agent"); \
        const unsigned old_ = __hip_atomic_fetch_add(cnt_ + 64 * (1 + bar_g), 1u, __ATOMIC_RELAXED, __HIP_MEMORY_SCOPE_AGENT); \
        if (old_ + 1u == bar_gsize * bar_round) __hip_atomic_fetch_add(cnt_, 1u, __ATOMIC_RELAXED, __HIP_MEMORY_SCOPE_AGENT); \
        while (__hip_atomic_load(cnt_, __ATOMIC_RELAXED, __HIP_MEMORY_SCOPE_AGENT) < bar_round * bar_ngrp) __builtin_amdgcn_s_sleep(2); \
        __builtin_amdgcn_fence(__ATOMIC_ACQUIRE, "agent"); asm volatile("s_waitcnt vmcnt(0)" ::: "memory"); } __syncthreads(); } while (0)
#endif
#define REPS(k) (1 + (DUP_PHASE == (k) ? DUP_N : 0))
#define PHASE(k, ...) for (int rep_ = 0; rep_ < REPS(k); ++rep_) { int dry = rep_ < REPS(k) - 1; asm volatile("" : "+s"(dry)); __VA_ARGS__ GSYNC(); }
    if (p.ws == nullptr) grid.sync();
    for (int rep_ = 0; rep_ < REPS(0); ++rep_) { phase_convert(p, lds, 2, (int)blockIdx.x, (int)gridDim.x); GSYNC(); }
    if (threadIdx.x == 0) *(LAS u32x4*)(lds + 131072) = (u32x4){0u, 0u, 0u, 0u};
    __syncthreads();
#if BARRIER_KIND == 1
    const XcdBarrier xb = xcd_barrier_post((unsigned*)(p.ws + WS_BAR), (volatile LAS unsigned*)(lds + 131072));
#endif
    PHASE(1, { EpiSwiglu E; E.O = PACT; E.rstd = nullptr; E.nparts = 0; run_gemm(lds, HB, (const bf16_t*)(p.ws + WS_W1GU), 5632, 1024, E); })
    PHASE(2, { const EpiResid E{p.in[0], 0.5f, p.in[1], 0, XRES, HB, ssq + 16 * MROWS, PART}; run_gemm_split(lds, PACT, (const bf16_t*)(p.ws + WS_W1D), FF, E); })
    split_fixup(PART, 11, p.in[1], XRES, HB, ssq + 16 * MROWS, 0.5f, 0, nullptr, RSTD); GSYNC();
    PHASE(3, { EpiP E; E.P = PACT; E.rstd = RSTD; E.out = p.out; run_gemm(lds, HB, (const bf16_t*)(p.ws + WS_WIN), NINP, 1024, E); })
    PHASE(4, { int mask = dry ? DUP_MASK : 3; asm volatile("" : "+s"(mask)); phase_mix_a(p, lds, mask); })
#if GLA2_SEL >= 0
    { int sel = GLA2_SEL; asm volatile("" : "+s"(sel)); phase_mix_a2(p, lds, sel); GSYNC(); }
#endif
    PHASE(5, phase_scan(p, lds, dry);)
    PHASE(6, { int mask = dry ? DUP_MASK : 3; asm volatile("" : "+s"(mask)); phase_mix_c(p, lds, dry, mask); })
    PHASE(7, { const EpiResid E{XRES, 1.0f, XRES + (size_t)MPROMPT * DM, dry, XRES, HB2, ssq + 32 * MROWS, PART}; run_gemm_split(lds, HB, (const bf16_t*)(p.ws + WS_WOUT), 1024, E); })
    split_fixup(PART, 4, XRES + (size_t)MPROMPT * DM, XRES, HB2, ssq + 32 * MROWS, 1.0f, 0, nullptr, RSTD + MROWS); GSYNC();
    PHASE(8, { EpiSwiglu E; E.O = PACT; E.rstd = RSTD + MROWS; E.nparts = 1; run_gemm(lds, HB2, (const bf16_t*)(p.ws + WS_W2GU), 5632, 1024, E); })
    PHASE(9, { const EpiResid E{XRES, 0.5f, XRES + (size_t)MPROMPT * DM, dry, XRES, nullptr, ssq + 48 * MROWS, PART}; run_gemm_split(lds, PACT, (const bf16_t*)(p.ws + WS_W2D), FF, E); })
    split_fixup(PART, 11, XRES + (size_t)MPROMPT * DM, XRES, nullptr, ssq + 48 * MROWS, 0.5f, 0, p.in[30], nullptr);
#if DUP_PHASE == 11
    for (int rep_ = 0; rep_ < 10 * DUP_N; ++rep_) GSYNC();
#endif
    for (int rep_ = 0; rep_ < REPS(10); ++rep_) { int dry = rep_ < REPS(10) - 1; asm volatile("" : "+s"(dry)); phase_final_norm(p, dry); if (dry) GSYNC(); }
}

extern "C" void kernel_launch(void* const* d_in, const int* in_sizes, int n_in, void* d_out, int out_size, void* d_ws, size_t ws_size, hipStream_t stream) {
    static int grid = 0;
    if (grid == 0) {
        if (n_in != 31 || (size_t)out_size != O_END || ws_size < WS_END) { fprintf(stderr, "kernel_launch: unexpected sizes n_in %d out %d ws %zu (need %zu)\n", n_in, out_size, ws_size, (size_t)WS_END); grid = -1; return; }
        int dev = 0, cus = 0, per_cu = 0;
        hipGetDevice(&dev); hipDeviceGetAttribute(&cus, hipDeviceAttributeMultiprocessorCount, dev);
        if (hipFuncSetAttribute((const void*)fwd_megakernel, hipFuncAttributeMaxDynamicSharedMemorySize, LDS_BYTES) != hipSuccess) { fprintf(stderr, "kernel_launch: hipFuncSetAttribute failed\n"); grid = -1; return; }
        if (hipOccupancyMaxActiveBlocksPerMultiprocessor(&per_cu, (const void*)fwd_megakernel, 512, LDS_BYTES) != hipSuccess || per_cu < 1) { fprintf(stderr, "kernel_launch: occupancy query says %d\n", per_cu); per_cu = 1; }
        (void)hipGetLastError();
        grid = cus;
    }
    if (grid < 0) return;
    if (hipMemsetAsync((unsigned char*)d_ws + WS_BAR, 0, 16384, stream) != hipSuccess) { fprintf(stderr, "kernel_launch: memset failed\n"); return; }
    Params p{};
    for (int i = 0; i < 31; ++i) p.in[i] = (const float*)d_in[i];
    p.out = (float*)d_out; p.ws = (unsigned char*)d_ws;
    void* args[] = {&p};
    hipError_t e = hipLaunchCooperativeKernel((const void*)fwd_megakernel, dim3(grid), dim3(512), args, LDS_BYTES, stream);
    if (e != hipSuccess) fprintf(stderr, "cooperative launch failed: %s (grid %d)\n", hipGetErrorString(e), grid);
}
```

```cpp
#include <hip/hip_runtime.h>
#include <hip/hip_cooperative_groups.h>
#include <cstdio>
namespace cg = cooperative_groups;
#define BARRIER_KIND 2
#define GLA2_SEL -1
#ifndef DUP_PHASE
#define DUP_PHASE -1
#define DUP_N 1
#define DUP_MASK 3
#endif
namespace pg8 {
#define PG8_LAS __attribute__((address_space(3)))
typedef unsigned short bf16_t;
typedef short bf16x8 __attribute__((ext_vector_type(8)));
typedef float f32x4 __attribute__((ext_vector_type(4)));
typedef unsigned u32x4 __attribute__((ext_vector_type(4)));
constexpr int BM = 256, BK = 64, HALF = 128, HTB = HALF * BK * 2  , STAGE_BYTES = 8 * HTB, NXCD = 8, WGM = 8;

__host__ __device__ __forceinline__ int lds_byte(int r, int c) { const int st = (r >> 4) * 2 + (c >> 5), rr = r & 15, cc = c & 31, ob = rr * 64 + cc * 2; return st * 1024 + (ob ^ (((ob >> 9) & 1) << 5)); }
__host__ __device__ __forceinline__ void stage_rc(int b, int& R, int& C) { const int st = b / 1024, sb = b % 1024, swz = sb ^ (((sb >> 9) & 1) << 5); R = (st >> 1) * 16 + swz / 64; C = (st & 1) * 32 + (swz % 64) / 2; }
__host__ __device__ __forceinline__ int perm32(int rho) { const int n = rho >> 4, i = rho & 15; return 8 * (i >> 2) + 4 * n + (i & 3); }

struct Unit { int pm, pn, k0, nkt, part; };
struct Gemm { const bf16_t* A; const bf16_t* Bt; int M, N, K; };

struct StaticOrder {
    int nM, nN, nwg, G, c, nkt;
    __host__ __device__ void init(int M, int N, int G_, int c_, int K_ = 0) { nM = M / BM; nN = N / BM; nwg = nM * nN; G = G_; c = c_; nkt = K_ / BK; }
    __host__ __device__ bool next(int i, Unit& u) const {
        const long L = (long)i * G + c; if (L >= nwg) return false;
        int wgid = (int)L; { const int q = nwg / NXCD, r = nwg % NXCD, xcd = wgid % NXCD, off = wgid / NXCD; wgid = (xcd < r ? xcd * (q + 1) : r * (q + 1) + (xcd - r) * q) + off; }
        const int nig = WGM * nN, gid = wgid / nig, fm = gid * WGM, gsz = (nM - fm) < WGM ? (nM - fm) : WGM;
        u.pm = fm + ((wgid % nig) % gsz); u.pn = (wgid % nig) / gsz; u.k0 = 0; u.nkt = nkt; u.part = -1; return true;
    }
    __device__ __forceinline__ void a_ready(const Unit&) const {}
    __device__ __forceinline__ void done(const Unit&) const {}
};
__device__ __forceinline__ unsigned cvt_pk_bf16(float lo, float hi) { unsigned r; asm volatile("v_cvt_pk_bf16_f32 %0, %1, %2" : "=v"(r) : "v"(lo), "v"(hi)); return r; }

template <class Epi, class Sched, bool STAMP = false>
__device__ __forceinline__ void gemm_phase(PG8_LAS unsigned char* lds, const Gemm g, const Sched& S, const Epi& E, unsigned long long* stamps) {
    int tid_ = threadIdx.x; asm volatile("" : "+v"(tid_)); const int tid = tid_, wid = __builtin_amdgcn_readfirstlane(tid >> 6), lane = tid & 63, wr = wid >> 2, wc = wid & 3, fr = lane & 15, fq = lane >> 4;
    const int K = g.K;
    int ts_lo = 0, ts_hi = 0, nts = 0; const unsigned long long rt_entry = STAMP ? (unsigned long long)wall_clock64() : 0ull;
#define PG8_STAMP() do { if (STAMP && wid == 0 && nts < 64) { const unsigned long long _c = (unsigned long long)clock64(); \
        ts_lo = (lane == nts) ? (int)(unsigned)_c : ts_lo; ts_hi = (lane == nts) ? (int)(unsigned)(_c >> 32) : ts_hi; ++nts; } } while (0)
    PG8_STAMP();
    unsigned voffA[2], voffB[2];
#pragma unroll
    for (int i = 0; i < 2; ++i) { int R, C; stage_rc(tid * 16 + i * 8192, R, C); const int Rb = Epi::PERM ? ((R & ~31) + perm32(R & 31)) : R;
        voffA[i] = (unsigned)(R * K + C) * 2u; voffB[i] = (unsigned)(Rb * K + C) * 2u; }
    const size_t kstep = (size_t)(BK * 2);
    const size_t hstep = (size_t)HALF * K * 2;
    const size_t tstep = 2 * hstep;
    const unsigned ldsw = (unsigned)wid * 1024u;
    const int aoff = lds_byte(wr * 64 + fr, fq * 8), boff = lds_byte(wc * 32 + fr, fq * 8);
#define PG8_SA(b, h) (((b) * 2 + (h)) * HTB)
#define PG8_SB(b, h) ((4 + (b) * 2 + (h)) * HTB)
#define PG8_STAGE(bufoff, gbase, voff) do { _Pragma("unroll") for (int _i = 0; _i < 2; ++_i) \
        __builtin_amdgcn_global_load_lds((const unsigned*)((const char*)(gbase) + (voff)[_i]), (PG8_LAS unsigned*)(lds + (bufoff) + ldsw + _i * 8192), 16, 0, 0); } while (0)
#define PG8_LDA(dst, b, h) do { _Pragma("unroll") for (int m = 0; m < 4; ++m) _Pragma("unroll") for (int k = 0; k < 2; ++k) dst[m][k] = *(const PG8_LAS bf16x8*)(lds + PG8_SA(b, h) + aoff + m * 2048 + k * 1024); } while (0)
#define PG8_LDB(dst, b, h) do { _Pragma("unroll") for (int n = 0; n < 2; ++n) _Pragma("unroll") for (int k = 0; k < 2; ++k) dst[n][k] = *(const PG8_LAS bf16x8*)(lds + PG8_SB(b, h) + boff + n * 2048 + k * 1024); } while (0)
#define PG8_MMA(ai, bj, At, Bt) do { __builtin_amdgcn_s_setprio(1); _Pragma("unroll") for (int m = 0; m < 4; ++m) _Pragma("unroll") for (int n = 0; n < 2; ++n) _Pragma("unroll") for (int k = 0; k < 2; ++k) \
        acc[ai][bj][m][n] = __builtin_amdgcn_mfma_f32_16x16x32_bf16(Bt[n][k], At[m][k], acc[ai][bj][m][n], 0, 0, 0); __builtin_amdgcn_s_setprio(0); } while (0)
#define PG8_WAIT_V(n) asm volatile("s_waitcnt vmcnt(" #n ")" ::: "memory")
#define PG8_WAIT_L(n) asm volatile("s_waitcnt lgkmcnt(" #n ")" ::: "memory")
#define PG8_BAR __builtin_amdgcn_s_barrier()
#define PG8_SCHED __builtin_amdgcn_sched_barrier(0)
    Unit cur, nxt; int ui = 0;
    if (!S.next(0, cur)) return;
    f32x4 acc[2][2][4][2];
#pragma unroll
    for (int a = 0; a < 2; ++a)
#pragma unroll
        for (int b = 0; b < 2; ++b)
#pragma unroll
            for (int m = 0; m < 4; ++m)
#pragma unroll
                for (int n = 0; n < 2; ++n) acc[a][b][m][n] = (f32x4){0.f, 0.f, 0.f, 0.f};
    bf16x8 At[4][2], B0[2][2], B1[2][2];
    const char* cA = (const char*)g.A + (size_t)cur.pm * tstep + (size_t)cur.k0 * kstep; const char* cB = (const char*)g.Bt + (size_t)cur.pn * tstep + (size_t)cur.k0 * kstep;
    S.a_ready(cur);
    float pre[8]; E.prefetch(cur, wr, fr, pre);
    PG8_STAGE(PG8_SB(0, 0), cB, voffB); PG8_STAGE(PG8_SA(0, 0), cA, voffA); PG8_STAGE(PG8_SB(0, 1), cB + hstep, voffB); PG8_STAGE(PG8_SA(0, 1), cA + hstep, voffA);
    if (wr == 1) PG8_BAR;
    PG8_WAIT_V(4); PG8_BAR;
    PG8_STAGE(PG8_SB(1, 0), cB + kstep, voffB); PG8_STAGE(PG8_SA(1, 0), cA + kstep, voffA); PG8_STAGE(PG8_SB(1, 1), cB + hstep + kstep, voffB);
    PG8_WAIT_V(6); PG8_BAR;
    PG8_STAMP();
    for (;;) {
        const bool has_next = S.next(ui + 1, nxt);
        const char* nA = has_next ? (const char*)g.A + (size_t)nxt.pm * tstep + (size_t)nxt.k0 * kstep : cA; const char* nB = has_next ? (const char*)g.Bt + (size_t)nxt.pn * tstep + (size_t)nxt.k0 * kstep : cB;
        const int nt = cur.nkt;
        for (int t = 0; t < nt; t += 2) {
            const bool last = (t == nt - 2);
            const char* a1 = cA + (size_t)(t + 1) * kstep;
            const char* a2 = last ? nA : cA + (size_t)(t + 2) * kstep; const char* b2 = last ? nB : cB + (size_t)(t + 2) * kstep;
            const char* a3 = a2 + kstep; const char* b3 = b2 + kstep;
            if (last && has_next) S.a_ready(nxt);
            PG8_LDB(B0, 0, 0); PG8_SCHED; PG8_LDA(At, 0, 0); PG8_STAGE(PG8_SA(1, 1), a1 + hstep, voffA);
            PG8_WAIT_L(8); PG8_BAR; PG8_WAIT_L(0); PG8_MMA(0, 0, At, B0); PG8_BAR; PG8_SCHED;
            PG8_LDB(B1, 0, 1); PG8_STAGE(PG8_SB(0, 0), b2, voffB);
            PG8_BAR; PG8_WAIT_L(0); PG8_MMA(0, 1, At, B1); PG8_BAR;
            PG8_LDA(At, 0, 1); PG8_STAGE(PG8_SA(0, 0), a2, voffA);
            PG8_BAR; PG8_WAIT_L(0); PG8_MMA(1, 0, At, B0); PG8_BAR; PG8_SCHED;
            PG8_STAGE(PG8_SB(0, 1), b2 + hstep, voffB);
            PG8_WAIT_V(6); PG8_BAR; PG8_MMA(1, 1, At, B1); PG8_BAR;
            PG8_LDB(B0, 1, 0); PG8_SCHED; PG8_LDA(At, 1, 0); PG8_STAGE(PG8_SA(0, 1), a2 + hstep, voffA);
            PG8_WAIT_L(8); PG8_BAR; PG8_WAIT_L(0); PG8_MMA(0, 0, At, B0); PG8_BAR; PG8_SCHED;
            PG8_LDB(B1, 1, 1); PG8_STAGE(PG8_SB(1, 0), b3, voffB);
            PG8_BAR; PG8_WAIT_L(0); PG8_MMA(0, 1, At, B1); PG8_BAR;
            PG8_LDA(At, 1, 1); PG8_STAGE(PG8_SA(1, 0), a3, voffA);
            PG8_BAR; PG8_WAIT_L(0); PG8_MMA(1, 0, At, B0); PG8_BAR; PG8_SCHED;
            PG8_STAGE(PG8_SB(1, 1), b3 + hstep, voffB);
            PG8_WAIT_V(6); PG8_BAR; PG8_MMA(1, 1, At, B1); PG8_BAR;
        }
        PG8_STAMP();
        if constexpr (!Epi::AFTER_DRAIN) { E(acc, cur, wr, wc, fr, fq, pre); S.done(cur); }
        PG8_STAMP();
        if (!has_next) break;
#pragma unroll
        for (int a = 0; a < 2; ++a)
#pragma unroll
            for (int b = 0; b < 2; ++b)
#pragma unroll
                for (int m = 0; m < 4; ++m)
#pragma unroll
                    for (int n = 0; n < 2; ++n) acc[a][b][m][n] = (f32x4){0.f, 0.f, 0.f, 0.f};
        cur = nxt; cA = nA; cB = nB; ++ui; E.prefetch(cur, wr, fr, pre);
    }
    PG8_WAIT_V(0);
    if (wr == 0) PG8_BAR;
    PG8_BAR;
    if constexpr (Epi::AFTER_DRAIN) { E.fused(acc, cur, wr, wc, fr, fq, lds, wid, lane); S.done(cur); }
    PG8_STAMP();
    if (STAMP && wid == 0) { stamps[lane] = lane < nts ? (((unsigned long long)(unsigned)ts_hi << 32) | (unsigned)ts_lo) : 0ull;
        if (lane == 62) stamps[62] = rt_entry; if (lane == 63) stamps[63] = (unsigned long long)wall_clock64(); }
#undef PG8_STAMP
#undef PG8_SA
#undef PG8_SB
#undef PG8_STAGE
#undef PG8_LDA
#undef PG8_LDB
#undef PG8_MMA
#undef PG8_WAIT_V
#undef PG8_WAIT_L
#undef PG8_BAR
#undef PG8_SCHED
}
}
#define LAS PG8_LAS
#define XB_TMO      128
#define XB_XCNT(j)  (256  + 64 * (j))
#define XB_XSUB(j)  (1280 + 64 * (j))
#define XB_XGEN(j)  (2304 + 64 * (j))
#define XB_TOP      3328
#define XB_TOPGEN   3392
#define XCD_BAR_WORDS 3456
#define XB_SPIN_CAP (1u << 18)

__device__ __forceinline__ unsigned xb_ld(unsigned* p)              { return __hip_atomic_load(p, __ATOMIC_RELAXED, __HIP_MEMORY_SCOPE_AGENT); }
__device__ __forceinline__ unsigned xb_add(unsigned* p, unsigned v) { return __hip_atomic_fetch_add(p, v, __ATOMIC_RELAXED, __HIP_MEMORY_SCOPE_AGENT); }
__device__ __forceinline__ unsigned xb_xcc_id() { return (unsigned)__builtin_amdgcn_s_getreg((3 << 11) | 20) & 0xFu; }
#define XB_SPIN(cond, bar) do { unsigned _sp = 0; while (cond) { __builtin_amdgcn_s_sleep(1); \
    if ((++_sp & 255u) == 0u) { if (xb_ld(&(bar)[XB_TMO])) break; if (_sp > XB_SPIN_CAP) { atomicAdd(&(bar)[XB_TMO], 1u); break; } } } } while (0)

struct XcdBarrier {
    unsigned* bar; unsigned x;
    volatile LAS unsigned* st;
};

__device__ __forceinline__ XcdBarrier xcd_barrier_post(unsigned* bar, volatile LAS unsigned* st) {
    XcdBarrier b; b.bar = bar; b.x = xb_xcc_id(); b.st = st;
    if (threadIdx.x == 0) (void)xb_add(&bar[XB_XCNT(b.x)], 1u);
    return b;
}
__device__ __forceinline__ void xcd_barrier_complete(unsigned* bar, unsigned x, unsigned& nloc, unsigned& nx) {
    const unsigned G = gridDim.x * gridDim.y * gridDim.z;
    unsigned sum, cnt, mine, sp = 0u;
    for (;;) {
        sum = 0u; cnt = 0u; mine = 0u;
#pragma unroll
        for (unsigned j = 0; j < 16; ++j) { const unsigned c = xb_ld(&bar[XB_XCNT(j)]); sum += c; cnt += (c > 0u) ? 1u : 0u; mine = (j == x) ? c : mine; }
        if (sum == G) break;
        __builtin_amdgcn_s_sleep(1);
        if ((++sp & 255u) == 0u) { if (xb_ld(&bar[XB_TMO])) break; if (sp > XB_SPIN_CAP) { atomicAdd(&bar[XB_TMO], 1u); break; } }
    }
    nloc = mine > 0u ? mine : 1u; nx = cnt > 0u ? cnt : 1u;
}

__device__ __forceinline__ void xcd_barrier(const XcdBarrier& b) {
    asm volatile("s_waitcnt vmcnt(0)" ::: "memory");
    __syncthreads();
    if (threadIdx.x == 0) {
        unsigned* bar = b.bar;
        __builtin_amdgcn_s_waitcnt(0);
        unsigned nloc = b.st[0], nx = b.st[1];
        if (nloc == 0u) { xcd_barrier_complete(bar, b.x, nloc, nx); b.st[0] = nloc; b.st[1] = nx; }
        const unsigned old = xb_add(&bar[XB_XSUB(b.x)], 1u);
        const unsigned gen = old / nloc;
        if (old + 1u == (gen + 1u) * nloc) {
            __builtin_amdgcn_fence(__ATOMIC_RELEASE, "agent");
            asm volatile("s_waitcnt vmcnt(0)" ::: "memory");
            const unsigned og = xb_add(&bar[XB_TOP], 1u);
            const unsigned tg = og / nx;
            if (og + 1u == (tg + 1u) * nx) xb_add(&bar[XB_TOPGEN], 1u);
            else XB_SPIN(xb_ld(&bar[XB_TOPGEN]) == tg, bar);
            __builtin_amdgcn_fence(__ATOMIC_ACQUIRE, "agent");
            xb_add(&bar[XB_XGEN(b.x)], 1u);
            asm volatile("s_waitcnt vmcnt(0)" ::: "memory");
        } else {
            XB_SPIN(xb_ld(&bar[XB_XGEN(b.x)]) == gen, bar);
            __builtin_amdgcn_fence(__ATOMIC_ACQUIRE, "agent");
            asm volatile("s_waitcnt vmcnt(0)" ::: "memory");
        }
    }
    __syncthreads();
}

using pg8::bf16_t; using pg8::bf16x8; using pg8::f32x4; using pg8::u32x4; using pg8::Unit; using pg8::cvt_pk_bf16;

typedef float f32x2 __attribute__((ext_vector_type(2)));
typedef unsigned u32x2 __attribute__((ext_vector_type(2)));

constexpr int MROWS = 16640, MPROMPT = 16384, DM = 1024, FF = 2816, NIN = 3216, NINP = 3328, ACOLS = 1664, BOFF = 1664;
constexpr int NSAMP = 16, SAMP_T = 16;
constexpr size_t O_Y = 0, O_SHIFT_P = 17039360, O_WKV_P = 17041024, O_GLA_P = 17073792, O_SHIFT_S = 17106560, O_WKV_S = 17133184, O_GLA_S = 17657472, O_END = 18181760;
constexpr size_t al256(size_t x) { return (x + 255) & ~(size_t)255; }
constexpr size_t WS_W1GU = 0;
constexpr size_t WS_W1D  = WS_W1GU + (size_t)5632 * 1024 * 2;
constexpr size_t WS_WIN  = WS_W1D + (size_t)1024 * 2816 * 2;
constexpr size_t WS_WOUT = WS_WIN + (size_t)NINP * 1024 * 2;
constexpr size_t WS_W2GU = WS_WOUT + (size_t)1024 * 1024 * 2;
constexpr size_t WS_W2D  = WS_W2GU + (size_t)5632 * 1024 * 2;
constexpr size_t WS_SSQ  = WS_W2D + (size_t)1024 * 2816 * 2;
constexpr size_t SSQ_BYTES = (size_t)16 * MROWS * 4;
constexpr size_t WS_HB   = WS_SSQ + 4 * SSQ_BYTES;
constexpr size_t WS_PACT = WS_HB + (size_t)MROWS * 1024 * 2;
constexpr size_t WS_G    = WS_PACT + (size_t)MROWS * NIN * 2;
constexpr size_t WS_HSR  = WS_G + (size_t)144 * 8 * 8192;
constexpr size_t WS_HSG  = WS_HSR + (size_t)144 * 8 * 16384;
constexpr size_t WS_DECG = WS_HSG + (size_t)272 * 4 * 32768;
constexpr size_t WS_BONUS= WS_DECG + (size_t)272 * 4 * 64 * 4;
constexpr size_t WS_BAR  = WS_BONUS + (size_t)MROWS * 8 * 4;
constexpr size_t WS_DUMMY= WS_BAR + 16384;
constexpr size_t WS_GBS  = WS_DUMMY + ((size_t)1 << 20);
constexpr size_t WS_RSTD = WS_GBS + (size_t)272 * 4 * 4 * 2 * 64 * 4;
constexpr size_t WS_END  = WS_RSTD + (size_t)2 * MROWS * 4;
constexpr size_t WS_Y    = WS_W1GU;
constexpr size_t WS_HB2  = WS_HSG;
static_assert((size_t)MROWS * 512 * 2 <= WS_WOUT, "Y overlay");
static_assert((size_t)MROWS * 1024 * 2 <= (size_t)272 * 4 * 32768, "HB2 overlay");
constexpr int LDS_BYTES = 131072 + 16;

struct Params { const float* in[31]; float* out; unsigned char* ws; };

__device__ __forceinline__ float rstd_of(const float* ssq, int nparts, int row) {
    float s = 0.f;
    for (int p = 0; p < nparts; ++p) s += ssq[(size_t)p * MROWS + row];
    return rsqrtf(s * (1.0f / 1024.0f) + 1e-6f);
}
__device__ __forceinline__ int tid_opaque() { int t = threadIdx.x; asm volatile("" : "+v"(t)); return t; }
__device__ __forceinline__ float sigmoidf_(float x) { return __builtin_amdgcn_rcpf(1.0f + __expf(-x)); }

struct EpiSwiglu {
    static constexpr bool PERM = true, AFTER_DRAIN = false;
    bf16_t* O; const float* rstd; int nparts;
    __device__ __forceinline__ void prefetch(const Unit& u, int wr, int fr, float (&pre)[8]) const {
        if (nparts) {
#pragma unroll
            for (int ai = 0; ai < 2; ++ai)
#pragma unroll
                for (int m = 0; m < 4; ++m) pre[ai * 4 + m] = rstd[u.pm * 256 + wr * 64 + fr + ai * 128 + m * 16];
        }
    }
    __device__ __forceinline__ void operator()(const f32x4 (&acc)[2][2][4][2], const Unit& u, int wr, int wc, int fr, int fq, const float (&pre)[8]) const {
        const int row0 = u.pm * 256 + wr * 64 + fr, col0 = u.pn * 128 + wc * 32 + 8 * fq;
#pragma unroll
        for (int ai = 0; ai < 2; ++ai)
#pragma unroll
            for (int m = 0; m < 4; ++m) {
                const int row = row0 + ai * 128 + m * 16; const float rs = nparts ? pre[ai * 4 + m] : 1.0f;
                float a[8];
#pragma unroll
                for (int n = 0; n < 2; ++n)
#pragma unroll
                    for (int j = 0; j < 4; ++j) { const float g = acc[ai][0][m][n][j] * rs, up = acc[ai][1][m][n][j] * rs; a[n * 4 + j] = g * sigmoidf_(g) * up; }
                u32x4 w; w.x = cvt_pk_bf16(a[0], a[1]); w.y = cvt_pk_bf16(a[2], a[3]); w.z = cvt_pk_bf16(a[4], a[5]); w.w = cvt_pk_bf16(a[6], a[7]);
                *(u32x4*)(O + (size_t)row * FF + col0) = w;
            }
    }
};
struct EpiResid {
    static constexpr bool PERM = true, AFTER_DRAIN = false;
    const float* xoldA; float scale; const float* xoldB; int dry; float* xnew; bf16_t* xb; float* ssq; float* part;
    __device__ __forceinline__ void prefetch(const Unit&, int, int, float (&)[8]) const {}
    __device__ __forceinline__ void operator()(const f32x4 (&acc)[2][2][4][2], const Unit& u, int wr, int wc, int fr, int fq, const float (&)[8]) const {
        const int row0 = u.pm * 256 + wr * 64 + fr, col0 = u.pn * 256 + wc * 32 + 8 * fq;
        float sc_ = scale; asm volatile("" : "+v"(sc_)); const f32x4 sc4 = (f32x4){sc_, sc_, sc_, sc_};
        if (u.part >= 0) {
            float* pb = part + ((size_t)(u.part * 4 + u.pn) * 256 + wr * 64 + fr) * 256 + wc * 32 + 8 * fq;
#pragma unroll
            for (int ai = 0; ai < 2; ++ai)
#pragma unroll
                for (int m = 0; m < 4; ++m)
#pragma unroll
                    for (int bj = 0; bj < 2; ++bj) { float* q = pb + (size_t)(ai * 128 + m * 16) * 256 + bj * 128; *(f32x4*)q = acc[ai][bj][m][0]; *(f32x4*)(q + 4) = acc[ai][bj][m][1]; }
        } else {
#pragma unroll
        for (int ai = 0; ai < 2; ++ai) {
            f32x4 xv[4][2][2];
#pragma unroll
            for (int m = 0; m < 4; ++m) {
                const int row = row0 + ai * 128 + m * 16;
                const float* xo = row < MPROMPT ? xoldA + (size_t)row * DM : xoldB + (size_t)(row - MPROMPT) * DM;
#pragma unroll
                for (int bj = 0; bj < 2; ++bj) { xv[m][bj][0] = *(const f32x4*)(xo + col0 + bj * 128); xv[m][bj][1] = *(const f32x4*)(xo + col0 + bj * 128 + 4); }
            }
            __builtin_amdgcn_sched_barrier(0);
#pragma unroll
            for (int m = 0; m < 4; ++m) {
                const int row = row0 + ai * 128 + m * 16;
                float sq = 0.f;
#pragma unroll
                for (int bj = 0; bj < 2; ++bj) {
                    const int col = col0 + bj * 128;
                    f32x4 v0 = xv[m][bj][0], v1 = xv[m][bj][1];
                    if (!dry) { v0 += acc[ai][bj][m][0] * sc4; v1 += acc[ai][bj][m][1] * sc4; }
                    *(f32x4*)(xnew + (size_t)row * DM + col) = v0; *(f32x4*)(xnew + (size_t)row * DM + col + 4) = v1;
                    if (xb) { u32x4 w; w.x = cvt_pk_bf16(v0[0], v0[1]); w.y = cvt_pk_bf16(v0[2], v0[3]); w.z = cvt_pk_bf16(v1[0], v1[1]); w.w = cvt_pk_bf16(v1[2], v1[3]);
                        *(u32x4*)(xb + (size_t)row * DM + col) = w; }
                    sq += (v0[0] * v0[0] + v0[1] * v0[1]) + (v0[2] * v0[2] + v0[3] * v0[3]) + (v1[0] * v1[0] + v1[1] * v1[1]) + (v1[2] * v1[2] + v1[3] * v1[3]);
                }
                sq += __shfl_xor(sq, 16); sq += __shfl_xor(sq, 32);
                if (fq == 0) ssq[(size_t)(u.pn * 4 + wc) * MROWS + row] = sq;
            }
            __builtin_amdgcn_sched_barrier(0);
        }
        }
    }
};
struct EpiP {
    static constexpr bool PERM = true, AFTER_DRAIN = false;
    bf16_t* P; const float* rstd; float* out;
    __device__ __forceinline__ void prefetch(const Unit& u, int wr, int fr, float (&pre)[8]) const {
#pragma unroll
        for (int ai = 0; ai < 2; ++ai)
#pragma unroll
            for (int m = 0; m < 4; ++m) pre[ai * 4 + m] = rstd[u.pm * 256 + wr * 64 + fr + ai * 128 + m * 16];
    }
    __device__ __forceinline__ void operator()(const f32x4 (&acc)[2][2][4][2], const Unit& u, int wr, int wc, int fr, int fq, const float (&pre)[8]) const {
        const int row0 = u.pm * 256 + wr * 64 + fr, col0 = u.pn * 256 + wc * 32 + 8 * fq;
#pragma unroll
        for (int ai = 0; ai < 2; ++ai)
#pragma unroll
            for (int m = 0; m < 4; ++m) {
                const int row = row0 + ai * 128 + m * 16; const float rs = pre[ai * 4 + m];
                float* dst = nullptr;
                if (row == MPROMPT - 1) dst = out + O_SHIFT_P;
                else if (row >= MPROMPT && ((row - MPROMPT) & 15) == 15) dst = out + O_SHIFT_S + (size_t)((row - MPROMPT) >> 4) * ACOLS;
#pragma unroll
                for (int bj = 0; bj < 2; ++bj) {
                    const int col = col0 + bj * 128;
                    if (col < NIN) {
                        const f32x4 v0 = acc[ai][bj][m][0] * rs, v1 = acc[ai][bj][m][1] * rs;
                        u32x4 w; w.x = cvt_pk_bf16(v0[0], v0[1]); w.y = cvt_pk_bf16(v0[2], v0[3]); w.z = cvt_pk_bf16(v1[0], v1[1]); w.w = cvt_pk_bf16(v1[2], v1[3]);
                        *(u32x4*)(P + (size_t)row * NIN + col) = w;
                        if (dst && col < ACOLS) { *(f32x4*)(dst + col) = v0; *(f32x4*)(dst + col + 4) = v1; }
                    }
                }
            }
    }
};
template <class Epi>
__device__ __forceinline__ void run_gemm(LAS unsigned char* lds, const bf16_t* A, const bf16_t* Bt, int N, int K, const Epi& E) {
    pg8::Gemm g; g.A = A; g.Bt = Bt; g.M = MROWS; g.N = N; g.K = K;
    pg8::StaticOrder S; S.init(MROWS, N, (int)gridDim.x, (int)blockIdx.x, K);
    pg8::gemm_phase<Epi, pg8::StaticOrder, false>(lds, g, S, E, nullptr);
}
struct SplitOrder {
    pg8::StaticOrder S; int nsmall, c;
    __device__ void init(int G, int c_, int K) { S.init(MPROMPT, 1024, G, c_, K); c = c_; nsmall = 4 * (K / 256); }
    __device__ bool next(int i, Unit& u) const {
        if (i == 0) return S.next(0, u);
        if (i == 1 && c < nsmall) { u.pm = MPROMPT / 256; u.pn = c & 3; u.part = c >> 2; u.k0 = u.part * 4; u.nkt = 4; return true; }
        return false;
    }
    __device__ __forceinline__ void a_ready(const Unit&) const {}
    __device__ __forceinline__ void done(const Unit&) const {}
};
template <class Epi>
__device__ __forceinline__ void run_gemm_split(LAS unsigned char* lds, const bf16_t* A, const bf16_t* Bt, int K, const Epi& E) {
    pg8::Gemm g; g.A = A; g.Bt = Bt; g.M = MROWS; g.N = 1024; g.K = K;
    SplitOrder S; S.init((int)gridDim.x, (int)blockIdx.x, K);
    pg8::gemm_phase<Epi, SplitOrder, false>(lds, g, S, E, nullptr);
}
__device__ __forceinline__ void split_fixup(const float* part, int nsplit, const float* xold, float* xnew, bf16_t* xb, float* ssq, float scale, int dry, const float* fin_g, float* rstd_out) {
    const int tid = tid_opaque(), wave = tid >> 6, lane = tid & 63;
    for (int r = blockIdx.x * 8 + wave; r < 256; r += gridDim.x * 8) {
        const int row = MPROMPT + r; float sq = 0.f; f32x4 v[4];
#pragma unroll
        for (int i = 0; i < 4; ++i) {
            const int col = i * 256 + lane * 4;
            f32x4 a = (f32x4){0.f, 0.f, 0.f, 0.f};
            for (int ks = 0; ks < nsplit; ++ks) a += *(const f32x4*)(part + ((size_t)(ks * 4 + i) * 256 + r) * 256 + lane * 4);
            v[i] = *(const f32x4*)(xold + (size_t)r * DM + col);
            if (!dry) v[i] += a * (f32x4){scale, scale, scale, scale};
            sq += (v[i][0] * v[i][0] + v[i][1] * v[i][1]) + (v[i][2] * v[i][2] + v[i][3] * v[i][3]);
        }
#pragma unroll
        for (int o = 32; o > 0; o >>= 1) sq += __shfl_xor(sq, o);
        const float rs = rsqrtf(sq * (1.0f / 1024.0f) + 1e-6f);
#pragma unroll
        for (int i = 0; i < 4; ++i) {
            const int col = i * 256 + lane * 4;
            if (fin_g) v[i] = v[i] * rs * *(const f32x4*)(fin_g + col);
            *(f32x4*)(xnew + (size_t)row * DM + col) = v[i];
            if (xb) { u32x2 w; w.x = cvt_pk_bf16(v[i][0], v[i][1]); w.y = cvt_pk_bf16(v[i][2], v[i][3]); *(u32x2*)(xb + (size_t)row * DM + col) = w; }
        }
        if (lane < 16) ssq[(size_t)lane * MROWS + row] = lane == 0 ? sq : 0.f;
        if (lane == 0 && rstd_out) rstd_out[row] = rs;
    }
    if (rstd_out) for (int row = blockIdx.x * 512 + tid; row < MPROMPT; row += gridDim.x * 512) rstd_out[row] = rstd_of(ssq, 16, row);
}
struct CvtJob { const float* src; const float* gain; bf16_t* dst; int ldsrc, nvalid, k0, ns0, K, nd0; };
__device__ __forceinline__ void cvt_decode(const Params& p, int tidx, CvtJob& J) {
    if (tidx < 2816) {
        const int f = tidx / 1408, r = tidx % 1408, nb = r / 16, kb = r % 16, pn = nb >> 2, bj = (nb >> 1) & 1, h = nb & 1;
        J.src = f == 0 ? (bj ? p.in[7] : p.in[6]) : (bj ? p.in[28] : p.in[27]); J.gain = f == 0 ? nullptr : p.in[26]; J.dst = (bf16_t*)(p.ws + (f == 0 ? WS_W1GU : WS_W2GU));
        J.ldsrc = FF; J.nvalid = FF; J.k0 = kb * 64; J.ns0 = pn * 128 + h * 64; J.K = 1024; J.nd0 = nb * 64;
    } else if (tidx < 4224) {
        const int f = (tidx - 2816) / 704, r = (tidx - 2816) % 704, nb = r / 44, kb = r % 44;
        J.src = f == 0 ? p.in[8] : p.in[29]; J.gain = nullptr; J.dst = (bf16_t*)(p.ws + (f == 0 ? WS_W1D : WS_W2D)); J.ldsrc = 1024; J.nvalid = 1024; J.k0 = kb * 64; J.ns0 = nb * 64; J.K = FF; J.nd0 = nb * 64;
    } else if (tidx < 5056) {
        const int r = tidx - 4224, nb = r / 16, kb = r % 16;
        J.src = p.in[10]; J.gain = p.in[9]; J.dst = (bf16_t*)(p.ws + WS_WIN); J.ldsrc = NIN; J.nvalid = NIN; J.k0 = kb * 64; J.ns0 = nb * 64; J.K = 1024; J.nd0 = nb * 64;
    } else {
        const int r = tidx - 5056, nb = r / 16, kb = r % 16;
        J.src = p.in[25]; J.gain = nullptr; J.dst = (bf16_t*)(p.ws + WS_WOUT); J.ldsrc = 1024; J.nvalid = 1024; J.k0 = kb * 64; J.ns0 = nb * 64; J.K = 1024; J.nd0 = nb * 64;
    }
}
__device__ __forceinline__ int cvt_remap(int i, int late) {
    if (late == 2) return i;
    if (!late) return i < 1408 ? i : (i < 2112 ? i + 1408 : i + 2112);
    return i < 1408 ? i + 1408 : (i < 2112 ? i + 2112 : i + 2944);
}
__device__ __forceinline__ void phase_convert(const Params& p, LAS unsigned char* lds, int late, int wb, int nb) {
    LAS float* tiles = (LAS float*)lds;
    bf16_t* ws16 = (bf16_t*)p.ws;
    const int t = tid_opaque(), ntiles = late == 2 ? 5312 : (late ? 2368 : 2944);
    for (int base = wb; base < ntiles; base += 4 * nb) {
        f32x4 v[4][2]; float gq[4][2];
#pragma unroll
        for (int u = 0; u < 4; ++u) {
            const int tidx = base + u * nb;
            if (tidx < ntiles) { CvtJob J; cvt_decode(p, cvt_remap(tidx, late), J);
#pragma unroll
                for (int h = 0; h < 2; ++h) { const int i = (t >> 4) + h * 32, j4 = (t & 15) * 4;
                    v[u][h] = (f32x4){0.f, 0.f, 0.f, 0.f};
                    if (J.ns0 + j4 < J.nvalid) v[u][h] = *(const f32x4*)(J.src + (size_t)(J.k0 + i) * J.ldsrc + J.ns0 + j4);
                    gq[u][h] = J.gain ? J.gain[J.k0 + i] : 1.0f; } }
        }
#pragma unroll
        for (int u = 0; u < 4; ++u)
            if (base + u * nb < ntiles) {
#pragma unroll
                for (int h = 0; h < 2; ++h) { const int i = (t >> 4) + h * 32, j4 = (t & 15) * 4;
#pragma unroll
                    for (int e = 0; e < 4; ++e) tiles[u * 4160 + i * 65 + j4 + e] = v[u][h][e] * gq[u][h]; } }
        __syncthreads();
#pragma unroll
        for (int u = 0; u < 4; ++u) {
            const int tidx = base + u * nb;
            if (tidx < ntiles) { CvtJob J; cvt_decode(p, cvt_remap(tidx, late), J);
                const int j = t >> 3, ks = (t & 7) * 8; float a[8];
#pragma unroll
                for (int e = 0; e < 8; ++e) a[e] = tiles[u * 4160 + (ks + e) * 65 + j];
                u32x4 w; w.x = cvt_pk_bf16(a[0], a[1]); w.y = cvt_pk_bf16(a[2], a[3]); w.z = cvt_pk_bf16(a[4], a[5]); w.w = cvt_pk_bf16(a[6], a[7]);
                *(u32x4*)(J.dst + (size_t)(J.nd0 + j) * J.K + J.k0 + ks) = w; }
        }
        __syncthreads();
    }
    (void)ws16;
    if (late == 1) return;
    const int tid = tid_opaque(), wave = tid >> 6, lane = tid & 63;
    float* ssq0 = (float*)(p.ws + WS_SSQ);
    bf16_t* hb = (bf16_t*)(p.ws + WS_HB);
    for (int row = blockIdx.x * 8 + wave; row < MROWS; row += gridDim.x * 8) {
        const float* x = row < MPROMPT ? p.in[0] + (size_t)row * DM : p.in[1] + (size_t)(row - MPROMPT) * DM;
        float sq = 0.f; f32x4 v[4];
#pragma unroll
        for (int i = 0; i < 4; ++i) { v[i] = *(const f32x4*)(x + i * 256 + lane * 4); sq += (v[i][0] * v[i][0] + v[i][1] * v[i][1]) + (v[i][2] * v[i][2] + v[i][3] * v[i][3]); }
#pragma unroll
        for (int o = 32; o > 0; o >>= 1) sq += __shfl_xor(sq, o);
        const float rs = rsqrtf(sq * (1.0f / 1024.0f) + 1e-6f);
#pragma unroll
        for (int i = 0; i < 4; ++i) {
            const f32x4 h = v[i] * rs * *(const f32x4*)(p.in[5] + i * 256 + lane * 4);
            u32x2 w; w.x = cvt_pk_bf16(h[0], h[1]); w.y = cvt_pk_bf16(h[2], h[3]);
            *(u32x2*)(hb + (size_t)row * DM + i * 256 + lane * 4) = w;
        }
    }
}
__device__ __forceinline__ void phase_final_norm(const Params& p, int dry) {
    const int tid = tid_opaque(), wave = tid >> 6, lane = tid & 63;
    const float* ssq3 = (const float*)(p.ws + WS_SSQ + 3 * SSQ_BYTES);
    const float* g = p.in[30];
    f32x4 gg[4];
#pragma unroll
    for (int i = 0; i < 4; ++i) gg[i] = *(const f32x4*)(g + i * 256 + lane * 4);
    const int stride = gridDim.x * 8;
    for (int row0 = blockIdx.x * 8 + wave; row0 < MPROMPT; row0 += 4 * stride) {
        f32x4 v[4][4]; float rs[4];
#pragma unroll
        for (int r = 0; r < 4; ++r) { const int row = row0 + r * stride;
            if (row < MPROMPT) { rs[r] = rstd_of(ssq3, 16, row);
#pragma unroll
                for (int i = 0; i < 4; ++i) v[r][i] = *(const f32x4*)(p.out + (size_t)row * DM + i * 256 + lane * 4); } }
        __builtin_amdgcn_sched_barrier(0);
#pragma unroll
        for (int r = 0; r < 4; ++r) { const int row = row0 + r * stride;
            if (row < MPROMPT) {
#pragma unroll
                for (int i = 0; i < 4; ++i) *(f32x4*)(p.out + (size_t)row * DM + i * 256 + lane * 4) = dry ? v[r][i] : v[r][i] * rs[r] * gg[i]; } }
    }
}
__device__ __forceinline__ float bf2f(bf16_t b) { return __uint_as_float(((unsigned)b) << 16); }
__device__ __forceinline__ float quad_sum(float x) {
    x += __int_as_float(__builtin_amdgcn_update_dpp(0, __float_as_int(x), 0xB1, 0xF, 0xF, true));
    x += __int_as_float(__builtin_amdgcn_update_dpp(0, __float_as_int(x), 0x4E, 0xF, 0xF, true));
    return x;
}
__device__ __forceinline__ float wave_sum(float x) {
    x += __int_as_float(__builtin_amdgcn_update_dpp(0, __float_as_int(x), 0xB1, 0xF, 0xF, true));
    x += __int_as_float(__builtin_amdgcn_update_dpp(0, __float_as_int(x), 0x4E, 0xF, 0xF, true));
    x += __int_as_float(__builtin_amdgcn_update_dpp(0, __float_as_int(x), 0x124, 0xF, 0xF, true));
    x += __int_as_float(__builtin_amdgcn_update_dpp(0, __float_as_int(x), 0x128, 0xF, 0xF, true));
    const int xi = __float_as_int(x);
    return (__int_as_float(__builtin_amdgcn_readlane(xi, 0)) + __int_as_float(__builtin_amdgcn_readlane(xi, 16))) + (__int_as_float(__builtin_amdgcn_readlane(xi, 32)) + __int_as_float(__builtin_amdgcn_readlane(xi, 48)));
}
__device__ __forceinline__ float softplusf_(float x) { return fmaxf(x, 0.f) + __logf(1.0f + __expf(-fabsf(x))); }
__device__ __forceinline__ float tanhf_(float x) { return 1.0f - 2.0f * __builtin_amdgcn_rcpf(1.0f + __expf(2.0f * x)); }
__device__ __forceinline__ f32x2 lo2(f32x4 v) { return __builtin_shufflevector(v, v, 0, 1); }
__device__ __forceinline__ f32x2 hi2(f32x4 v) { return __builtin_shufflevector(v, v, 2, 3); }
__device__ __forceinline__ f32x2 bc2(float x) { return (f32x2){x, x}; }

struct Seg { int row0, nsteps, prevkind; const float* prevptr; };
__device__ __forceinline__ float seg_prev0(const bf16_t* P, const Seg& sg, int col) {
    float prev = 0.f;
    if (sg.prevkind == 1) prev = bf2f(P[(size_t)(sg.row0 - 1) * NIN + col]);
    else if (sg.prevkind == 2) prev = sg.prevptr[col];
    return prev;
}
__device__ __forceinline__ float xs_lerp(const bf16_t* P, const Seg& sg, int i, int col, float mu, float prev0) {
    const float cur = bf2f(P[(size_t)(sg.row0 + i) * NIN + col]);
    const float pr = bf2f(P[(size_t)(sg.row0 + (i > 0 ? i - 1 : 0)) * NIN + col]);
    const float prev = i == 0 ? prev0 : pr;
    return cur + (prev - cur) * mu;
}
__device__ __forceinline__ void load16(const LAS float* src, f32x2 (&d)[8]) {
    const LAS f32x4* s4 = (const LAS f32x4*)src;
#pragma unroll
    for (int i = 0; i < 4; ++i) { const f32x4 v = s4[i]; d[2 * i] = lo2(v); d[2 * i + 1] = hi2(v); }
}

constexpr int RST = 384;
__device__ __forceinline__ void rwkv_a_task(const Params& p, LAS unsigned char* lds, int tk, int mode) {
    const int tid = tid_opaque(), wave = tid >> 6, lane = tid & 63;
    const bf16_t* P = (const bf16_t*)(p.ws + WS_PACT);
    Seg sg; int ci, g;
    if (tk < 256) { const int c = tk >> 1; g = tk & 1; sg.row0 = c * 128; sg.nsteps = 128; sg.prevkind = c == 0 ? 0 : 1; sg.prevptr = nullptr; ci = c; }
    else { const int b = (tk - 256) >> 1; g = (tk - 256) & 1; sg.row0 = MPROMPT + b * 16; sg.nsteps = 16; sg.prevkind = 2; sg.prevptr = p.in[2] + (size_t)b * ACOLS; ci = 128 + b; }
    LAS float* stage = (LAS float*)lds;
    LAS float* bcs = (LAS float*)(lds + 98304) + wave * 512;
    const float* mu = p.in[11];
    const int phl = wave & 3, ptb = (wave >> 2) * 8, hd = g * 4 + phl, C = hd * 64 + lane;
    const float mu_r = mu[C], mu_k = mu[512 + C], mu_v = mu[1024 + C], mu_x = mu[1536 + lane];
    const float w0c = p.in[12][C], a0c = p.in[14][C], kkc = p.in[17][C], kac = p.in[18][C], rkc = p.in[19][C];
    const float pv_r = seg_prev0(P, sg, C), pv_k = seg_prev0(P, sg, 512 + C), pv_v = seg_prev0(P, sg, 1024 + C), pv_x = seg_prev0(P, sg, 1536 + lane);
    const float* wup = p.in[13] + C; const float* aup = p.in[15] + C;
    float* bonus = (float*)(p.ws + WS_BONUS);
    const bool isH = wave >= 4; const int rhd = g * 4 + (wave & 3), rg = lane >> 2, ks = lane & 3;
    f32x2 s[4][8];
#pragma unroll
    for (int r = 0; r < 4; ++r)
#pragma unroll
        for (int j = 0; j < 8; ++j) { s[r][j].x = (!isH && (rg * 4 + r == ks * 16 + 2 * j)) ? 1.f : 0.f; s[r][j].y = (!isH && (rg * 4 + r == ks * 16 + 2 * j + 1)) ? 1.f : 0.f; }
    bf16_t* Yb = (bf16_t*)(p.ws + WS_Y); bf16_t* HB = (bf16_t*)(p.ws + WS_HB);
    bf16_t raw[9][4];
#define RW_LOAD(sbn) do { _Pragma("unroll") for (int i = 0; i < 9; ++i) { const int ti_ = (sbn) * 16 + ptb + i - 1; const bf16_t* rp_ = P + (size_t)(sg.row0 + (ti_ < 0 ? 0 : ti_)) * NIN; \
        raw[i][0] = rp_[C]; raw[i][1] = rp_[512 + C]; raw[i][2] = rp_[1024 + C]; raw[i][3] = rp_[1536 + lane]; } } while (0)
    RW_LOAD(0);
    for (int sb = 0; sb < sg.nsteps / 16; ++sb) {
        if (!(mode & 4)) {
#pragma unroll
            for (int i = 0; i < 8; ++i) { const float cur = bf2f(raw[i + 1][3]), prev = (sb * 16 + ptb + i == 0) ? pv_x : bf2f(raw[i][3]); float xv = cur + (prev - cur) * mu_x; if (lane < 32) xv = tanhf_(xv); bcs[i * 64 + lane] = xv; }
            float wl[8], al[8];
#pragma unroll
            for (int i = 0; i < 8; ++i) { wl[i] = w0c; al[i] = a0c; }
#pragma unroll 2
            for (int j4 = 0; j4 < 8; ++j4) {
                float wu[4], au[4];
#pragma unroll
                for (int e = 0; e < 4; ++e) { wu[e] = wup[(size_t)(j4 * 4 + e) * 512]; au[e] = aup[(size_t)(j4 * 4 + e) * 512]; }
#pragma unroll
                for (int i = 0; i < 8; ++i) {
                    const f32x4 t4 = *(const LAS f32x4*)(bcs + i * 64 + j4 * 4), x4 = *(const LAS f32x4*)(bcs + i * 64 + 32 + j4 * 4);
#pragma unroll
                    for (int e = 0; e < 4; ++e) { wl[i] += t4[e] * wu[e]; al[i] += x4[e] * au[e]; }
                }
            }
            float rr[8], kr[8], vr[8];
#pragma unroll
            for (int i = 0; i < 8; ++i) { const bool f0 = (sb * 16 + ptb + i == 0);
                const float cr = bf2f(raw[i + 1][0]), ck = bf2f(raw[i + 1][1]), cv = bf2f(raw[i + 1][2]);
                const float qr = f0 ? pv_r : bf2f(raw[i][0]), qk = f0 ? pv_k : bf2f(raw[i][1]), qv = f0 ? pv_v : bf2f(raw[i][2]);
                rr[i] = cr + (qr - cr) * mu_r; kr[i] = ck + (qk - ck) * mu_k; vr[i] = cv + (qv - cv) * mu_v; }
#pragma unroll
            for (int i = 0; i < 8; ++i) {
                const int ti = sb * 16 + ptb + i, row = sg.row0 + ti;
                const float r = rr[i], k = kr[i], v = vr[i];
                const float wlog = -softplusf_(-wl[i]) - 0.5f, dec = __expf(-__expf(wlog));
                const float a = sigmoidf_(al[i]);
                float kk = k * kkc; const float n2 = wave_sum(kk * kk); kk = kk / fmaxf(sqrtf(n2), 1e-12f);
                const float kmod = k * (1.0f + (a - 1.0f) * kac), kka = kk * a;
                const float bs = wave_sum(r * kmod * rkc);
                if (lane == 0) bonus[(size_t)row * 8 + hd] = bs;
                LAS float* st = stage + ((ptb + i) * 4 + phl) * RST;
                st[lane] = dec; st[64 + lane] = kk; st[128 + lane] = kka; st[192 + lane] = kmod; st[256 + lane] = r; st[320 + lane] = v;
            }
        }
        __syncthreads();
        if (sb + 1 < sg.nsteps / 16) RW_LOAD(sb + 1);
        if (!(mode & 8)) for (int tl = 0; tl < 16; ++tl) {
            const LAS float* st = stage + (tl * 4 + (wave & 3)) * RST;
            const int row = sg.row0 + sb * 16 + tl;
            f32x2 w2[8], kk2[8], ka2[8], r2[8];
            load16(st + ks * 16, w2); load16(st + 64 + ks * 16, kk2); load16(st + 128 + ks * 16, ka2); load16(st + 256 + ks * 16, r2);
            float sa[4];
#pragma unroll
            for (int r = 0; r < 4; ++r) { f32x2 acc = s[r][0] * kk2[0];
#pragma unroll
                for (int j = 1; j < 8; ++j) acc = s[r][j] * kk2[j] + acc;
                sa[r] = quad_sum(acc.x + acc.y); }
            float yo[4];
            if (!isH) {
#pragma unroll
                for (int r = 0; r < 4; ++r) { const f32x2 nsa = bc2(-sa[r]);
#pragma unroll
                    for (int j = 0; j < 8; ++j) s[r][j] = s[r][j] * w2[j] + nsa * ka2[j]; }
            } else {
                f32x2 km2[8]; load16(st + 192 + ks * 16, km2);
                const f32x4 v4 = *(const LAS f32x4*)(st + 320 + rg * 4);
#pragma unroll
                for (int r = 0; r < 4; ++r) { const f32x2 nsa = bc2(-sa[r]), vv = bc2(v4[r]);
#pragma unroll
                    for (int j = 0; j < 8; ++j) s[r][j] = (s[r][j] * w2[j] + nsa * ka2[j]) + vv * km2[j]; }
            }
#pragma unroll
            for (int r = 0; r < 4; ++r) { f32x2 acc = s[r][0] * r2[0];
#pragma unroll
                for (int j = 1; j < 8; ++j) acc = s[r][j] * r2[j] + acc;
                yo[r] = quad_sum(acc.x + acc.y); }
            if (ks == 0) {
                u32x2 w; w.x = cvt_pk_bf16(yo[0], yo[1]); w.y = cvt_pk_bf16(yo[2], yo[3]);
                if (!isH) *(u32x2*)(Yb + (size_t)row * 512 + rhd * 64 + rg * 4) = w;
                else *(u32x2*)(HB + (size_t)row * 1024 + rhd * 64 + rg * 4) = w;
            }
        }
        __syncthreads();
    }
    if (!isH) {
        bf16_t* Gf = (bf16_t*)(p.ws + WS_G) + (size_t)(ci * 8 + rhd) * 4096;
#pragma unroll
        for (int j = 0; j < 8; ++j)
#pragma unroll
            for (int h = 0; h < 2; ++h) {
                const int jj = 2 * j + h;
                u32x2 w; w.x = cvt_pk_bf16(h ? s[0][j].y : s[0][j].x, h ? s[1][j].y : s[1][j].x); w.y = cvt_pk_bf16(h ? s[2][j].y : s[2][j].x, h ? s[3][j].y : s[3][j].x);
                *(u32x2*)(Gf + (size_t)((ks * 2 + (rg >> 3)) * 64 + (rg & 3) * 16 + jj) * 8 + ((rg >> 2) & 1) * 4) = w;
            }
    } else {
        float* Hs = (float*)(p.ws + WS_HSR) + (size_t)(ci * 8 + rhd) * 4096;
#pragma unroll
        for (int r = 0; r < 4; ++r)
#pragma unroll
            for (int q = 0; q < 4; ++q) *(f32x4*)(Hs + (rg * 4 + r) * 64 + ks * 16 + q * 4) = (f32x4){s[r][2 * q].x, s[r][2 * q].y, s[r][2 * q + 1].x, s[r][2 * q + 1].y};
    }
}

constexpr int GST = 320;
__device__ __forceinline__ void gla_a_task(const Params& p, LAS unsigned char* lds, int tk) {
    const int tid = tid_opaque(), wave = tid >> 6, lane = tid & 63;
    const bf16_t* P = (const bf16_t*)(p.ws + WS_PACT) + BOFF;
    int row0, nsteps, ci;
    if (tk < 256) { row0 = tk * 64; nsteps = 64; ci = tk; } else { row0 = MPROMPT + (tk - 256) * 16; nsteps = 16; ci = tk; }
    LAS float* stage = (LAS float*)lds;
    LAS float* red = (LAS float*)(lds + 98304);
    const int hd = wave >> 1, half = wave & 1, rg = lane >> 2, ks = lane & 3;
    const int kc = hd * 64 + lane;
    float gku[16];
#pragma unroll
    for (int j = 0; j < 16; ++j) gku[j] = p.in[22][j * 256 + kc];
    const float gkb = p.in[23][kc];
    float lsum = 0.f;
    f32x2 s[4][8];
#pragma unroll
    for (int r = 0; r < 4; ++r)
#pragma unroll
        for (int j = 0; j < 8; ++j) s[r][j] = (f32x2){0.f, 0.f};
    bf16_t* HB = (bf16_t*)(p.ws + WS_HB);
    unsigned gxw; bf16_t graw[8][4];
#define GL_LOAD(sbn) do { gxw = *(const unsigned*)(P + (size_t)(row0 + (sbn) * 16 + half * 8 + (lane >> 3)) * NIN + 1024 + (lane & 7) * 2); \
        _Pragma("unroll") for (int i = 0; i < 8; ++i) { const bf16_t* pr_ = P + (size_t)(row0 + (sbn) * 16 + half * 8 + i) * NIN; graw[i][0] = pr_[256 + kc]; graw[i][1] = pr_[kc]; graw[i][2] = pr_[512 + hd * 128 + lane]; graw[i][3] = pr_[512 + hd * 128 + 64 + lane]; } } while (0)
    GL_LOAD(0);
    for (int sb = 0; sb < nsteps / 16; ++sb) {
        {
            LAS float* xg = (LAS float*)(lds + 81920) + wave * 128;
            { const int j2 = (lane & 7) * 2; xg[(lane >> 3) * 16 + j2] = __uint_as_float(gxw << 16); xg[(lane >> 3) * 16 + j2 + 1] = __uint_as_float(gxw & 0xffff0000u); }
            float kv[8], qv[8], v0[8], v1[8]; float bsub = 0.f;
#pragma unroll
            for (int i = 0; i < 8; ++i) { kv[i] = bf2f(graw[i][0]); qv[i] = bf2f(graw[i][1]) * 0.125f; v0[i] = bf2f(graw[i][2]); v1[i] = bf2f(graw[i][3]); }
#pragma unroll
            for (int i = 0; i < 8; ++i) {
                const int tl = half * 8 + i;
                float gl = gkb;
#pragma unroll
                for (int j4 = 0; j4 < 4; ++j4) { const f32x4 x4 = *(const LAS f32x4*)(xg + i * 16 + j4 * 4); gl += x4[0] * gku[j4 * 4] + x4[1] * gku[j4 * 4 + 1] + x4[2] * gku[j4 * 4 + 2] + x4[3] * gku[j4 * 4 + 3]; }
                const float la = -softplusf_(-gl) * (1.0f / 16.0f);
                lsum += la; bsub += la;
                LAS float* st = stage + (tl * 4 + hd) * GST;
                st[lane] = __expf(la); st[64 + lane] = kv[i]; st[128 + lane] = qv[i]; st[192 + lane] = v0[i]; st[256 + lane] = v1[i];
            }
            ((float*)(p.ws + WS_GBS))[(size_t)((((ci * 4 + sb) * 4 + hd) * 2 + half)) * 64 + lane] = bsub;
        }
        __syncthreads();
        if (sb + 1 < nsteps / 16) GL_LOAD(sb + 1);
        for (int tl = 0; tl < 16; ++tl) {
            const LAS float* st = stage + (tl * 4 + hd) * GST;
            const int row = row0 + sb * 16 + tl;
            f32x2 a2[8], k2[8], q2[8];
            load16(st + ks * 16, a2); load16(st + 64 + ks * 16, k2); load16(st + 128 + ks * 16, q2);
            const f32x4 v4 = *(const LAS f32x4*)(st + 192 + half * 64 + rg * 4);
            float zo[4];
#pragma unroll
            for (int r = 0; r < 4; ++r) { const f32x2 vv = bc2(v4[r]); f32x2 acc = (f32x2){0.f, 0.f};
#pragma unroll
                for (int j = 0; j < 8; ++j) { s[r][j] = s[r][j] * a2[j] + vv * k2[j]; acc = s[r][j] * q2[j] + acc; }
                zo[r] = quad_sum(acc.x + acc.y); }
            if (ks == 0) { u32x2 w; w.x = cvt_pk_bf16(zo[0], zo[1]); w.y = cvt_pk_bf16(zo[2], zo[3]);
                *(u32x2*)(HB + (size_t)row * 1024 + 512 + hd * 128 + half * 64 + rg * 4) = w; }
        }
        __syncthreads();
    }
    float* Hs = (float*)(p.ws + WS_HSG) + (size_t)(ci * 4 + hd) * 8192;
#pragma unroll
    for (int j = 0; j < 8; ++j) {
        *(f32x4*)(Hs + (ks * 16 + 2 * j) * 128 + half * 64 + rg * 4) = (f32x4){s[0][j].x, s[1][j].x, s[2][j].x, s[3][j].x};
        *(f32x4*)(Hs + (ks * 16 + 2 * j + 1) * 128 + half * 64 + rg * 4) = (f32x4){s[0][j].y, s[1][j].y, s[2][j].y, s[3][j].y};
    }
    red[wave * 64 + lane] = lsum;
    __syncthreads();
    if (half == 0) ((float*)(p.ws + WS_DECG))[(size_t)(ci * 4 + hd) * 64 + lane] = __expf(red[wave * 64 + lane] + red[(wave + 1) * 64 + lane]);
    __syncthreads();
}
__device__ __forceinline__ bf16x8 pack8(const float (&v)[8]);
typedef short bf16x4 __attribute__((ext_vector_type(4)));
typedef __bf16 bf16v2 __attribute__((ext_vector_type(2)));
__device__ __forceinline__ unsigned cvt_pk_native(float a, float b) { const f32x2 v = (f32x2){a, b}; const bf16v2 r = __builtin_convertvector(v, bf16v2); return __builtin_bit_cast(unsigned, r); }
__device__ __forceinline__ bf16x8 pack4z(float a, float b, float c, float d) { u32x4 w; w.x = cvt_pk_bf16(a, b); w.y = cvt_pk_bf16(c, d); w.z = 0u; w.w = 0u; return __builtin_bit_cast(bf16x8, w); }
__device__ __forceinline__ void gla_a_wave_task(const Params& p, LAS unsigned char* wl8, int ci, int row0, int nblk, int hd, int sel) {
    const int lane = tid_opaque() & 63, n = lane & 15, q = lane >> 4, kc = hd * 64 + lane;
    const bf16_t* P = (const bf16_t*)(p.ws + WS_PACT) + BOFF; bf16_t* HB = (bf16_t*)(p.ws + WS_HB);
    LAS float* XG = (LAS float*)wl8; LAS bf16_t* QT = (LAS bf16_t*)(wl8 + 1024); LAS bf16_t* KT = (LAS bf16_t*)(wl8 + 3328); LAS bf16_t* KTt = (LAS bf16_t*)(wl8 + 5632); LAS float* BETA = (LAS float*)(wl8 + 8704);
    float gku[16];
#pragma unroll
    for (int j = 0; j < 16; ++j) gku[j] = p.in[22][j * 256 + kc];
    const float gkb = p.in[23][kc];
    f32x4 H[4][8];
#pragma unroll
    for (int kt = 0; kt < 4; ++kt)
#pragma unroll
        for (int vt = 0; vt < 8; ++vt) H[kt][vt] = (f32x4){0.f, 0.f, 0.f, 0.f};
    float lsum = 0.f;
    for (int blk = 0; blk < nblk; ++blk) {
        const int rowb = row0 + blk * 16;
        { const int idx = lane * 4, tk = idx >> 4, j = idx & 15;
          const u32x2 xw = *(const u32x2*)(P + (size_t)(rowb + tk) * NIN + 1024 + j);
          *(LAS f32x4*)(XG + idx) = (f32x4){__uint_as_float(xw.x << 16), __uint_as_float(xw.x & 0xffff0000u), __uint_as_float(xw.y << 16), __uint_as_float(xw.y & 0xffff0000u)}; }
        unsigned qkr[16];
#pragma unroll
        for (int i = 0; i < 16; ++i) { const bf16_t* pr = P + (size_t)(rowb + i) * NIN; qkr[i] = (unsigned)pr[kc] | ((unsigned)pr[256 + kc] << 16); }
        float bsub = 0.f;
#pragma unroll
        for (int i = 0; i < 16; ++i) {
            float gl = gkb;
#pragma unroll
            for (int j4 = 0; j4 < 4; ++j4) { const f32x4 x4 = *(const LAS f32x4*)(XG + i * 16 + j4 * 4); gl += x4[0] * gku[j4 * 4] + x4[1] * gku[j4 * 4 + 1] + x4[2] * gku[j4 * 4 + 2] + x4[3] * gku[j4 * 4 + 3]; }
            bsub += -softplusf_(-gl) * (1.0f / 16.0f);
            const unsigned qk = cvt_pk_bf16(__uint_as_float(qkr[i] << 16) * 0.125f * __expf(bsub), __uint_as_float(qkr[i] & 0xffff0000u) * __expf(-bsub));
            QT[i * 72 + lane] = (bf16_t)(qk & 0xffffu); KT[i * 72 + lane] = (bf16_t)(qk >> 16); KTt[lane * 24 + i] = (bf16_t)(qk >> 16);
        }
        BETA[lane] = __expf(bsub); lsum += bsub;
        asm volatile("" ::: "memory");
        if (sel & 4) { float* gb = (float*)(p.ws + WS_GBS) + (size_t)(((ci * 4 + blk) * 4 + hd) * 2) * 64 + lane; gb[0] = bsub; gb[64] = 0.f; }
        u32x2 VP[8];
#pragma unroll
        for (int vt = 0; vt < 8; ++vt) { const bf16_t* vp = P + (size_t)(rowb + 4 * q) * NIN + 512 + hd * 128 + vt * 16 + n;
            VP[vt].x = (unsigned)vp[0] | ((unsigned)vp[NIN] << 16); VP[vt].y = (unsigned)vp[2 * NIN] | ((unsigned)vp[3 * NIN] << 16); }
#define VF(vt) __builtin_bit_cast(bf16x8, (u32x4){VP[vt].x, VP[vt].y, 0u, 0u})
        f32x4 sc = (f32x4){0.f, 0.f, 0.f, 0.f};
#pragma unroll
        for (int kh = 0; kh < 2; ++kh) sc = __builtin_amdgcn_mfma_f32_16x16x32_bf16(*(const LAS bf16x8*)(KT + n * 72 + kh * 32 + q * 8), *(const LAS bf16x8*)(QT + n * 72 + kh * 32 + q * 8), sc, 0, 0, 0);
        const bf16x8 SCB = pack4z(4 * q + 0 <= n ? sc[0] : 0.f, 4 * q + 1 <= n ? sc[1] : 0.f, 4 * q + 2 <= n ? sc[2] : 0.f, 4 * q + 3 <= n ? sc[3] : 0.f);
        bf16x8 QB[2];
#pragma unroll
        for (int kh = 0; kh < 2; ++kh) { const u32x2 a = __builtin_bit_cast(u32x2, *(const LAS bf16x4*)(QT + n * 72 + kh * 32 + 4 * q)), b = __builtin_bit_cast(u32x2, *(const LAS bf16x4*)(QT + n * 72 + kh * 32 + 16 + 4 * q));
            u32x4 w; w.x = a.x; w.y = a.y; w.z = b.x; w.w = b.y; QB[kh] = __builtin_bit_cast(bf16x8, w); }
#pragma unroll
        for (int vt = 0; vt < 8; ++vt) {
            f32x4 z = (f32x4){0.f, 0.f, 0.f, 0.f};
#pragma unroll
            for (int kh = 0; kh < 2; ++kh) { const float hv[8] = {H[2 * kh][vt][0], H[2 * kh][vt][1], H[2 * kh][vt][2], H[2 * kh][vt][3], H[2 * kh + 1][vt][0], H[2 * kh + 1][vt][1], H[2 * kh + 1][vt][2], H[2 * kh + 1][vt][3]};
                z = __builtin_amdgcn_mfma_f32_16x16x32_bf16(pack8(hv), QB[kh], z, 0, 0, 0); }
            z = __builtin_amdgcn_mfma_f32_16x16x32_bf16(VF(vt), SCB, z, 0, 0, 0);
            u32x2 w; w.x = cvt_pk_native(z[0], z[1]); w.y = cvt_pk_native(z[2], z[3]);
            if (sel & 1) *(u32x2*)(HB + (size_t)(rowb + n) * 1024 + 512 + hd * 128 + vt * 16 + 4 * q) = w;
        }
#pragma unroll
        for (int kt = 0; kt < 4; ++kt) {
            const u32x2 ka = __builtin_bit_cast(u32x2, *(const LAS bf16x4*)(KTt + (kt * 16 + n) * 24 + 4 * q));
            u32x4 kw; kw.x = ka.x; kw.y = ka.y; kw.z = 0u; kw.w = 0u; const bf16x8 KA = __builtin_bit_cast(bf16x8, kw);
            const f32x4 b4 = *(const LAS f32x4*)(BETA + kt * 16 + 4 * q);
#pragma unroll
            for (int vt = 0; vt < 8; ++vt) H[kt][vt] = __builtin_amdgcn_mfma_f32_16x16x32_bf16(KA, VF(vt), H[kt][vt], 0, 0, 0) * b4;
        }
    }
#undef VF
    float* Hs = (float*)(p.ws + WS_HSG) + (size_t)(ci * 4 + hd) * 8192;
#pragma unroll
    for (int kt = 0; kt < 4; ++kt)
#pragma unroll
        for (int vt = 0; vt < 8; ++vt)
#pragma unroll
            for (int i = 0; i < 4; ++i) if (sel & 2) Hs[(kt * 16 + 4 * q + i) * 128 + vt * 16 + n] = H[kt][vt][i];
    if (sel & 4) ((float*)(p.ws + WS_DECG))[(size_t)(ci * 4 + hd) * 64 + lane] = __expf(lsum);
}
__device__ __forceinline__ void phase_mix_a2(const Params& p, LAS unsigned char* lds, int sel) {
    const int wave = tid_opaque() >> 6, skip = gridDim.x >= 64 ? 32 : 0, ng = (int)gridDim.x - skip, nw = ng * 8;
    if ((int)blockIdx.x >= skip) for (int j = wave * ng + ((int)blockIdx.x - skip); j < 1088; j += nw) {
        int ci, row0, nblk, hd;
        if (j < 1024) { ci = j >> 2; row0 = ci * 64; nblk = 4; hd = j & 3; }
        else { const int r = j - 1024, sb = r >> 2; ci = 256 + sb; row0 = MPROMPT + sb * 16; nblk = 1; hd = r & 3; }
        gla_a_wave_task(p, lds + wave * 16384, ci, row0, nblk, hd, sel);
    }
}
__device__ __forceinline__ void phase_mix_a(const Params& p, LAS unsigned char* lds, int mask) {
    if (mask & 1) for (int t = blockIdx.x; t < 288; t += gridDim.x) rwkv_a_task(p, lds, t, mask);
    if (mask & 2) phase_mix_a2(p, lds, 7);
}

__device__ __forceinline__ void rwkv_scan_job(const Params& p, int head, int vt, int ci0, int nchunks, const float* S0, float* Sout, int dry) {
    const int lane = tid_opaque() & 63, n = lane & 15, q = lane >> 4, v = vt * 16 + n;
    f32x4 D[4];
#pragma unroll
    for (int jt = 0; jt < 4; ++jt) D[jt] = S0 ? *(const f32x4*)(S0 + v * 64 + jt * 16 + q * 4) : (f32x4){0.f, 0.f, 0.f, 0.f};
    for (int c = 0; c < nchunks; ++c) {
        const int ci = ci0 + c;
        float* HS = (float*)(p.ws + WS_HSR) + (size_t)(ci * 8 + head) * 4096;
        const bf16x8* Gf = (const bf16x8*)(p.ws + WS_G + (size_t)(ci * 8 + head) * 8192);
        f32x4 Hc[4]; bf16x8 A[4][2];
#pragma unroll
        for (int jt = 0; jt < 4; ++jt) { Hc[jt] = *(const f32x4*)(HS + v * 64 + jt * 16 + q * 4); A[jt][0] = Gf[(jt * 2 + 0) * 64 + lane]; A[jt][1] = Gf[(jt * 2 + 1) * 64 + lane]; }
#pragma unroll
        for (int jt = 0; jt < 4; ++jt) *(f32x4*)(HS + v * 64 + jt * 16 + q * 4) = dry ? Hc[jt] : D[jt];
        bf16x8 B[2];
#pragma unroll
        for (int kh = 0; kh < 2; ++kh) { u32x4 w; w.x = cvt_pk_native(D[2 * kh][0], D[2 * kh][1]); w.y = cvt_pk_native(D[2 * kh][2], D[2 * kh][3]);
            w.z = cvt_pk_native(D[2 * kh + 1][0], D[2 * kh + 1][1]); w.w = cvt_pk_native(D[2 * kh + 1][2], D[2 * kh + 1][3]); B[kh] = __builtin_bit_cast(bf16x8, w); }
#pragma unroll
        for (int jt = 0; jt < 4; ++jt) { f32x4 d = __builtin_amdgcn_mfma_f32_16x16x32_bf16(A[jt][0], B[0], Hc[jt], 0, 0, 0); D[jt] = __builtin_amdgcn_mfma_f32_16x16x32_bf16(A[jt][1], B[1], d, 0, 0, 0); }
    }
#pragma unroll
    for (int jt = 0; jt < 4; ++jt) *(f32x4*)(Sout + v * 64 + jt * 16 + q * 4) = D[jt];
}
constexpr int SC_SLOT = 12544, SC_NB = 8;
__device__ __forceinline__ void rwkv_scan_prompt(const Params& p, LAS unsigned char* lds, int head, int vt, int dry) {
    const int tid = tid_opaque(), wave = tid >> 6, lane = tid & 63, n = lane & 15, q = lane >> 4, v = vt * 16 + n;
    const unsigned char* Gb = p.ws + WS_G; unsigned char* Hb = p.ws + WS_HSR;
    u32x4 pfA[12], pfB[12];
    unsigned off0[12], hmask = 0u;
#pragma unroll
    for (int i = 0; i < 12; ++i) { const int qd = tid + 512 * i, cl = qd / 768, wi = qd % 768;
        off0[i] = wi < 512 ? (unsigned)(WS_G + (size_t)(cl * 8 + head) * 8192 + wi * 16) : (unsigned)(WS_HSR + ((size_t)(cl * 8 + head) * 4096 + vt * 1024) * 4 + (wi - 512) * 16);
        hmask |= (wi < 512 ? 0u : 1u) << i; }
#define SC_ISSUE(pf, batch) do { _Pragma("unroll") for (int i = 0; i < 12; ++i) { \
        const unsigned o_ = off0[i] + (unsigned)(batch) * ((unsigned)(SC_NB * 8 * 8192) << ((hmask >> i) & 1u)); pf[i] = *(const u32x4*)(p.ws + o_); } } while (0)
#define SC_COMMIT(pf) do { _Pragma("unroll") for (int i = 0; i < 12; ++i) { const int qd = tid + 512 * i, cl = qd / 768, wi = qd % 768; \
        const int dst = cl * SC_SLOT + (wi < 512 ? wi * 16 : 8192 + ((wi - 512) >> 4) * 272 + ((wi - 512) & 15) * 16); *(LAS u32x4*)(lds + dst) = pf[i]; } } while (0)
#define SC_COMPUTE(bb) do { if (wave == 0) { for (int cl = 0; cl < SC_NB; ++cl) { \
                const int ci = (bb) * SC_NB + cl; const LAS unsigned char* sl = lds + cl * SC_SLOT; \
                float* HS = (float*)Hb + (size_t)(ci * 8 + head) * 4096; \
                f32x4 Hc[4]; bf16x8 A[4][2]; \
                _Pragma("unroll") for (int jt = 0; jt < 4; ++jt) { Hc[jt] = *(const LAS f32x4*)(sl + 8192 + n * 272 + (jt * 4 + q) * 16); \
                    A[jt][0] = *(const LAS bf16x8*)(sl + ((jt * 2 + 0) * 64 + lane) * 16); A[jt][1] = *(const LAS bf16x8*)(sl + ((jt * 2 + 1) * 64 + lane) * 16); } \
                _Pragma("unroll") for (int jt = 0; jt < 4; ++jt) *(f32x4*)(HS + v * 64 + jt * 16 + q * 4) = dry ? Hc[jt] : D[jt]; \
                bf16x8 B[2]; \
                _Pragma("unroll") for (int kh = 0; kh < 2; ++kh) { u32x4 w; w.x = cvt_pk_native(D[2 * kh][0], D[2 * kh][1]); w.y = cvt_pk_native(D[2 * kh][2], D[2 * kh][3]); \
                    w.z = cvt_pk_native(D[2 * kh + 1][0], D[2 * kh + 1][1]); w.w = cvt_pk_native(D[2 * kh + 1][2], D[2 * kh + 1][3]); B[kh] = __builtin_bit_cast(bf16x8, w); } \
                _Pragma("unroll") for (int jt = 0; jt < 4; ++jt) { f32x4 d = __builtin_amdgcn_mfma_f32_16x16x32_bf16(A[jt][0], B[0], Hc[jt], 0, 0, 0); D[jt] = __builtin_amdgcn_mfma_f32_16x16x32_bf16(A[jt][1], B[1], d, 0, 0, 0); } \
            } } } while (0)
    f32x4 D[4];
#pragma unroll
    for (int jt = 0; jt < 4; ++jt) D[jt] = (f32x4){0.f, 0.f, 0.f, 0.f};
    constexpr int NBT = 128 / SC_NB;
    SC_ISSUE(pfA, 0); SC_COMMIT(pfA);
    __syncthreads();
    SC_ISSUE(pfA, 1); SC_ISSUE(pfB, 2);
    for (int b = 0; b < NBT; b += 2) {
        SC_COMPUTE(b);
        __syncthreads();
        SC_COMMIT(pfA);
        { const int nb_ = b + 3 < NBT ? b + 3 : NBT - 1; SC_ISSUE(pfA, nb_); }
        __syncthreads();
        SC_COMPUTE(b + 1);
        __syncthreads();
        SC_COMMIT(pfB);
        { const int nb_ = b + 4 < NBT ? b + 4 : NBT - 1; SC_ISSUE(pfB, nb_); }
        __syncthreads();
    }
#undef SC_COMPUTE
    if (wave == 0) {
        float* Sout = p.out + O_WKV_P + (size_t)head * 4096;
#pragma unroll
        for (int jt = 0; jt < 4; ++jt) *(f32x4*)(Sout + v * 64 + jt * 16 + q * 4) = D[jt];
    }
#undef SC_ISSUE
#undef SC_COMMIT
}
__device__ __forceinline__ void phase_scan(const Params& p, LAS unsigned char* lds, int dry) {
    const int tid = tid_opaque(), wave = tid >> 6, b = blockIdx.x;
    float* HSG = (float*)(p.ws + WS_HSG); const float* DEC = (const float*)(p.ws + WS_DECG);
    if (b < 32) rwkv_scan_prompt(p, lds, b >> 2, b & 3, dry);
    else if (b < 96) {
        const int e = (b - 32) * 512 + tid, hd = e >> 13, k = (e >> 7) & 63;
        float S = 0.f;
        float t[32], d[32];
#pragma unroll
        for (int u = 0; u < 32; ++u) { t[u] = HSG[(size_t)u * 32768 + e]; d[u] = DEC[(size_t)(u * 4 + hd) * 64 + k]; }
        for (int c = 0; c < 256; c += 32) {
            float tn[32], dn[32];
            const int cn = c + 32 < 256 ? c + 32 : c;
#pragma unroll
            for (int u = 0; u < 32; ++u) { tn[u] = HSG[(size_t)(cn + u) * 32768 + e]; dn[u] = DEC[(size_t)((cn + u) * 4 + hd) * 64 + k]; }
            __builtin_amdgcn_sched_barrier(0);
#pragma unroll
            for (int u = 0; u < 32; ++u) { HSG[(size_t)(c + u) * 32768 + e] = dry ? t[u] : S; S = S * d[u] + t[u]; }
            __builtin_amdgcn_sched_barrier(0);
#pragma unroll
            for (int u = 0; u < 32; ++u) { t[u] = tn[u]; d[u] = dn[u]; }
        }
        p.out[O_GLA_P + e] = S;
    } else {
        const int nb = gridDim.x - 96, bb = b - 96;
        for (int j = bb * 8 + wave; j < 512; j += nb * 8) { const int sb = j >> 5, hd = (j >> 2) & 7, vt = j & 3;
            rwkv_scan_job(p, hd, vt, 128 + sb, 1, p.in[3] + (size_t)(sb * 8 + hd) * 4096, p.out + O_WKV_S + (size_t)(sb * 8 + hd) * 4096, dry); }
        for (int i = bb * 512 + tid; i < 16 * 8192; i += nb * 512) { const int sb = i >> 13, e = (i & 8191) * 4, hd = e >> 13, k = (e >> 7) & 63;
            const f32x4 S0 = *(const f32x4*)(p.in[4] + (size_t)sb * 32768 + e); float* hp = HSG + (size_t)(256 + sb) * 32768 + e;
            const f32x4 t = *(const f32x4*)hp; const float d = DEC[(size_t)((256 + sb) * 4 + hd) * 64 + k];
            *(f32x4*)hp = dry ? t : S0; *(f32x4*)(p.out + O_GLA_S + (size_t)sb * 32768 + e) = S0 * d + t; }
    }
}

struct RwkvCConst { bf16x8 GB[4][2]; float lw[4], lb[4], muv[4]; float mug[16]; };
__device__ __forceinline__ float row16_sum(float x) {
    x += __int_as_float(__builtin_amdgcn_update_dpp(0, __float_as_int(x), 0xB1, 0xF, 0xF, true));
    x += __int_as_float(__builtin_amdgcn_update_dpp(0, __float_as_int(x), 0x4E, 0xF, 0xF, true));
    x += __int_as_float(__builtin_amdgcn_update_dpp(0, __float_as_int(x), 0x124, 0xF, 0xF, true));
    x += __int_as_float(__builtin_amdgcn_update_dpp(0, __float_as_int(x), 0x128, 0xF, 0xF, true));
    return x;
}
__device__ __forceinline__ bf16x8 pack8(const float (&v)[8]) {
    u32x4 w; w.x = cvt_pk_bf16(v[0], v[1]); w.y = cvt_pk_bf16(v[2], v[3]); w.z = cvt_pk_bf16(v[4], v[5]); w.w = cvt_pk_bf16(v[6], v[7]); return __builtin_bit_cast(bf16x8, w);
}
__device__ __forceinline__ void unpack8(u32x4 w, float (&v)[8]) {
    v[0] = __uint_as_float(w.x << 16); v[1] = __uint_as_float(w.x & 0xffff0000u); v[2] = __uint_as_float(w.y << 16); v[3] = __uint_as_float(w.y & 0xffff0000u);
    v[4] = __uint_as_float(w.z << 16); v[5] = __uint_as_float(w.z & 0xffff0000u); v[6] = __uint_as_float(w.w << 16); v[7] = __uint_as_float(w.w & 0xffff0000u);
}
__device__ __forceinline__ void rwkv_c_const(const Params& p, int hd, RwkvCConst& K) {
    const int lane = tid_opaque() & 63, n = lane & 15, q = lane >> 4;
#pragma unroll
    for (int nt = 0; nt < 4; ++nt) {
        const int C = hd * 64 + nt * 16 + n;
        K.lw[nt] = p.in[20][C]; K.lb[nt] = p.in[21][C]; K.muv[nt] = p.in[11][1024 + C];
#pragma unroll
        for (int kh = 0; kh < 2; ++kh) { float g[8];
#pragma unroll
            for (int e = 0; e < 8; ++e) g[e] = p.in[16][(size_t)(kh * 32 + q * 8 + e) * 512 + C];
            K.GB[nt][kh] = pack8(g); }
    }
#pragma unroll
    for (int kh = 0; kh < 2; ++kh)
#pragma unroll
        for (int e = 0; e < 8; ++e) K.mug[kh * 8 + e] = p.in[11][1600 + kh * 32 + q * 8 + e];
}
__device__ __forceinline__ void rwkv_c_task(const Params& p, const RwkvCConst& K, int ci, int tok0, int hd, const Seg& sg, int dry) {
    const int lane = tid_opaque() & 63, n = lane & 15, q = lane >> 4;
    const bf16_t* P = (const bf16_t*)(p.ws + WS_PACT);
    const bf16_t* Yb = (const bf16_t*)(p.ws + WS_Y); bf16_t* HB = (bf16_t*)(p.ws + WS_HB);
    const float* Ss = (const float*)(p.ws + WS_HSR) + (size_t)(ci * 8 + hd) * 4096;
    const float* bonus = (const float*)(p.ws + WS_BONUS);
    const int rowb = sg.row0 + tok0;
    bf16x8 SB[4][2]; float bo[4]; bf16_t zr[4][4], cr_[4][4]; float pv0[4];
#pragma unroll
    for (int nt = 0; nt < 4; ++nt)
#pragma unroll
        for (int kh = 0; kh < 2; ++kh) {
            const float* sp = Ss + (nt * 16 + n) * 64 + kh * 32 + q * 8;
            const f32x4 s0 = *(const f32x4*)sp, s1 = *(const f32x4*)(sp + 4);
            const float sv[8] = {s0[0], s0[1], s0[2], s0[3], s1[0], s1[1], s1[2], s1[3]};
            SB[nt][kh] = pack8(sv);
        }
#pragma unroll
    for (int i = 0; i < 4; ++i) bo[i] = bonus[(size_t)(rowb + q * 4 + i) * 8 + hd];
#pragma unroll
    for (int nt = 0; nt < 4; ++nt) {
        const int C = hd * 64 + nt * 16 + n;
        const bool first = (tok0 + q * 4 == 0) && sg.prevkind != 1;
        pv0[nt] = bf2f(P[(size_t)(rowb + q * 4 - (first ? 0 : 1)) * NIN + 1024 + C]);
        if (first) pv0[nt] = sg.prevkind == 2 ? sg.prevptr[1024 + C] : 0.f;
#pragma unroll
        for (int i = 0; i < 4; ++i) { const int row = rowb + q * 4 + i; zr[nt][i] = HB[(size_t)row * 1024 + C]; cr_[nt][i] = P[(size_t)row * NIN + 1024 + C]; }
    }
    bf16x8 AY[2], AG[2];
    {
        const bool first = (tok0 + n == 0) && sg.prevkind != 1;
        const bf16_t* cr = P + (size_t)(rowb + n) * NIN + 1600 + q * 8;
        const bf16_t* pr = P + (size_t)(rowb + n - (first ? 0 : 1)) * NIN + 1600 + q * 8;
#pragma unroll
        for (int kh = 0; kh < 2; ++kh) {
            AY[kh] = *(const bf16x8*)(Yb + (size_t)(rowb + n) * 512 + hd * 64 + kh * 32 + q * 8);
            float c8[8], p8[8];
            unpack8(*(const u32x4*)(cr + kh * 32), c8); unpack8(*(const u32x4*)(pr + kh * 32), p8);
            if (first) {
#pragma unroll
                for (int e = 0; e < 8; ++e) p8[e] = sg.prevkind == 2 ? sg.prevptr[1600 + kh * 32 + q * 8 + e] : 0.f;
            }
#pragma unroll
            for (int e = 0; e < 8; ++e) c8[e] = sigmoidf_(c8[e] + (p8[e] - c8[e]) * K.mug[kh * 8 + e]);
            AG[kh] = pack8(c8);
        }
    }
    f32x4 D[4], G[4];
#pragma unroll
    for (int nt = 0; nt < 4; ++nt) {
        f32x4 d = (f32x4){0.f, 0.f, 0.f, 0.f}, g = (f32x4){0.f, 0.f, 0.f, 0.f};
#pragma unroll
        for (int kh = 0; kh < 2; ++kh) {
            d = __builtin_amdgcn_mfma_f32_16x16x32_bf16(AY[kh], SB[nt][kh], d, 0, 0, 0);
            g = __builtin_amdgcn_mfma_f32_16x16x32_bf16(AG[kh], K.GB[nt][kh], g, 0, 0, 0);
        }
        D[nt] = d; G[nt] = g;
    }
    float o[4][4], vv[4][4];
#pragma unroll
    for (int nt = 0; nt < 4; ++nt) {
        float pv = pv0[nt];
#pragma unroll
        for (int i = 0; i < 4; ++i) {
            o[nt][i] = D[nt][i] + bf2f(zr[nt][i]);
            const float cv = bf2f(cr_[nt][i]);
            vv[nt][i] = cv + (pv - cv) * K.muv[nt]; pv = cv;
        }
    }
#pragma unroll
    for (int i = 0; i < 4; ++i) {
        const float mean = row16_sum((o[0][i] + o[1][i]) + (o[2][i] + o[3][i])) * (1.0f / 64.0f);
        float d2 = 0.f;
#pragma unroll
        for (int nt = 0; nt < 4; ++nt) { o[nt][i] -= mean; d2 += o[nt][i] * o[nt][i]; }
        const float rs = rsqrtf(row16_sum(d2) * (1.0f / 64.0f) + 64e-5f);
#pragma unroll
        for (int nt = 0; nt < 4; ++nt) {
            const int C = hd * 64 + nt * 16 + n;
            const float res = (o[nt][i] * rs * K.lw[nt] + K.lb[nt] + bo[i] * vv[nt][i]) * G[nt][i];
            const unsigned rb = cvt_pk_bf16(res, 0.f);
            bf16_t* dp = dry ? (bf16_t*)(p.ws + WS_DUMMY) + (size_t)blockIdx.x * 512 + threadIdx.x : HB + (size_t)(rowb + q * 4 + i) * 1024 + C;
            *dp = (bf16_t)(rb & 0xffffu);
        }
    }
}
__device__ __forceinline__ void gla_c_task(const Params& p, LAS float* wl, int ci, int row0, int rd, int hd, int dry) {
    const int lane = tid_opaque() & 63, n = lane & 15, q = lane >> 4, kc = hd * 64 + lane;
    const bf16_t* P = (const bf16_t*)(p.ws + WS_PACT) + BOFF; bf16_t* HB = (bf16_t*)(p.ws + WS_HB);
    const float* Ss = (const float*)(p.ws + WS_HSG) + (size_t)(ci * 4 + hd) * 8192;
    LAS float* XG = wl; LAS bf16_t* QT = (LAS bf16_t*)(wl + 256);
    const int rowb = row0 + rd * 16;
    float gku[16];
#pragma unroll
    for (int j = 0; j < 16; ++j) gku[j] = p.in[22][j * 256 + kc];
    const float gkb = p.in[23][kc];
    float bsum = 0.f;
    for (int sb = 0; sb < rd; ++sb) { const float* g = (const float*)(p.ws + WS_GBS) + (size_t)(((ci * 4 + sb) * 4 + hd) * 2) * 64 + lane; bsum += g[0]; bsum += g[64]; }
    { const int idx = lane * 4, tk = idx >> 4, j = idx & 15;
      const u32x2 xw = *(const u32x2*)(P + (size_t)(rowb + tk) * NIN + 1024 + j);
      *(LAS f32x4*)(XG + idx) = (f32x4){__uint_as_float(xw.x << 16), __uint_as_float(xw.x & 0xffff0000u), __uint_as_float(xw.y << 16), __uint_as_float(xw.y & 0xffff0000u)}; }
    float qv[16];
#pragma unroll
    for (int i = 0; i < 16; ++i) qv[i] = bf2f(P[(size_t)(rowb + i) * NIN + kc]) * 0.125f;
    bf16x8 B[8][2];
#pragma unroll
    for (int nt = 0; nt < 8; ++nt)
#pragma unroll
        for (int kh = 0; kh < 2; ++kh) { float sv[8];
#pragma unroll
            for (int e = 0; e < 8; ++e) sv[e] = Ss[(size_t)(kh * 32 + q * 8 + e) * 128 + nt * 16 + n];
            B[nt][kh] = pack8(sv); }
    bf16_t zr[4][8], gr[4][8]; float ng[8];
#pragma unroll
    for (int nt = 0; nt < 8; ++nt) ng[nt] = p.in[24][nt * 16 + n];
#pragma unroll
    for (int i = 0; i < 4; ++i) {
        const int row = rowb + q * 4 + i;
#pragma unroll
        for (int nt = 0; nt < 8; ++nt) { zr[i][nt] = HB[(size_t)row * 1024 + 512 + hd * 128 + nt * 16 + n]; gr[i][nt] = P[(size_t)row * NIN + 1040 + hd * 128 + nt * 16 + n]; }
    }
    __builtin_amdgcn_sched_barrier(0);
#pragma unroll
    for (int i = 0; i < 16; ++i) {
        float gl = gkb;
#pragma unroll
        for (int j4 = 0; j4 < 4; ++j4) { const f32x4 x4 = *(const LAS f32x4*)(XG + i * 16 + j4 * 4); gl += x4[0] * gku[j4 * 4] + x4[1] * gku[j4 * 4 + 1] + x4[2] * gku[j4 * 4 + 2] + x4[3] * gku[j4 * 4 + 3]; }
        bsum += -softplusf_(-gl) * (1.0f / 16.0f);
        QT[i * 72 + lane] = (bf16_t)(cvt_pk_bf16(qv[i] * __expf(bsum), 0.f) & 0xffffu);
    }
    bf16x8 A[2];
#pragma unroll
    for (int kh = 0; kh < 2; ++kh) A[kh] = *(const LAS bf16x8*)(QT + n * 72 + kh * 32 + q * 8);
    f32x4 D[8];
#pragma unroll
    for (int nt = 0; nt < 8; ++nt) {
        f32x4 d = (f32x4){0.f, 0.f, 0.f, 0.f};
#pragma unroll
        for (int kh = 0; kh < 2; ++kh) d = __builtin_amdgcn_mfma_f32_16x16x32_bf16(A[kh], B[nt][kh], d, 0, 0, 0);
        D[nt] = d;
    }
#pragma unroll
    for (int i = 0; i < 4; ++i) {
        const int row = rowb + q * 4 + i;
        bf16_t* ob = HB + (size_t)row * 1024 + 512 + hd * 128 + n;
        float o[8], ss = 0.f;
#pragma unroll
        for (int nt = 0; nt < 8; ++nt) { o[nt] = D[nt][i] + bf2f(zr[i][nt]); ss += o[nt] * o[nt]; }
        const float rs = rsqrtf(row16_sum(ss) * (1.0f / 128.0f) + 1e-6f);
#pragma unroll
        for (int nt = 0; nt < 8; ++nt) {
            const float g = bf2f(gr[i][nt]);
            const unsigned rb = cvt_pk_bf16(o[nt] * rs * ng[nt] * g * sigmoidf_(g), 0.f);
            bf16_t* dp = dry ? (bf16_t*)(p.ws + WS_DUMMY) + (size_t)blockIdx.x * 512 + threadIdx.x : ob + nt * 16;
            *dp = (bf16_t)(rb & 0xffffu);
        }
    }
}
__device__ __forceinline__ void phase_mix_c(const Params& p, LAS unsigned char* lds, int dry, int mask) {
    const int wave = tid_opaque() >> 6, widx = wave * (int)gridDim.x + (int)blockIdx.x, nw = gridDim.x * 8;
    LAS float* wl = (LAS float*)(lds + wave * 16384);
    if (mask & 1) for (int j = widx; j < 4160; j += nw) {
        int ci, row0, rd, hd;
        if (j < 4096) { ci = j >> 4; row0 = ci * 64; rd = (j >> 2) & 3; hd = j & 3; }
        else { const int r = j - 4096, sb = r >> 2; ci = 256 + sb; row0 = MPROMPT + sb * 16; rd = 0; hd = r & 3; }
        gla_c_task(p, wl, ci, row0, rd, hd, dry);
    }
    const int jb = (widx + 4160) % nw, js = nw, je = 8320;
    RwkvCConst KC; rwkv_c_const(p, jb & 7, KC);
    if (mask & 2) for (int j = jb; j < je; j += js) {
        Seg sg; int ci, tok0, hd;
        if (j < 8192) { const int c = j >> 6; ci = c; tok0 = ((j >> 3) & 7) * 16; hd = j & 7; sg.row0 = c * 128; sg.nsteps = 128; sg.prevkind = c == 0 ? 0 : 1; sg.prevptr = nullptr; }
        else { const int r = j - 8192, sb = r >> 3; ci = 128 + sb; tok0 = 0; hd = r & 7; sg.row0 = MPROMPT + sb * 16; sg.nsteps = 16; sg.prevkind = 2; sg.prevptr = p.in[2] + (size_t)sb * ACOLS; }
        rwkv_c_task(p, KC, ci, tok0, hd, sg, dry);
    }
}
__global__ void __launch_bounds__(512, 2) fwd_megakernel(Params p) {
    extern __shared__ __attribute__((aligned(16))) unsigned char shm[];
    LAS unsigned char* lds = (LAS unsigned char*)shm;
    cg::grid_group grid = cg::this_grid();
    float* ssq = (float*)(p.ws + WS_SSQ);
    bf16_t* HB = (bf16_t*)(p.ws + WS_HB); bf16_t* HB2 = (bf16_t*)(p.ws + WS_HB2); bf16_t* PACT = (bf16_t*)(p.ws + WS_PACT);
    float* XRES = p.out;
    float* RSTD = (float*)(p.ws + WS_RSTD);
    float* PART = (float*)(p.ws + WS_HSR);
#if BARRIER_KIND == 0
#define GSYNC() grid.sync()
#elif BARRIER_KIND == 1
#define GSYNC() xcd_barrier(xb)
#else
    unsigned bar_round = 0;
    const unsigned bar_g = blockIdx.x & 7u, bar_gsize = (gridDim.x + 7u - bar_g) >> 3, bar_ngrp = gridDim.x < 8u ? gridDim.x : 8u;
#define GSYNC() do { asm volatile("s_waitcnt vmcnt(0)" ::: "memory"); __syncthreads(); if (threadIdx.x == 0) { size_t off_ = WS_BAR + 3520 * 4; asm volatile("" : "+s"(off_)); unsigned* cnt_ = (unsigned*)(p.ws + off_); ++bar_round; \
        __builtin_amdgcn_fence(__ATOMIC_RELEASE, "agent"); \
        const unsigned old_ = __hip_atomic_fetch_add(cnt_ + 64 * (1 + bar_g), 1u, __ATOMIC_RELAXED, __HIP_MEMORY_SCOPE_AGENT); \
        if (old_ + 1u == bar_gsize * bar_round) __hip_atomic_fetch_add(cnt_, 1u, __ATOMIC_RELAXED, __HIP_MEMORY_SCOPE_AGENT); \
        while (__hip_atomic_load(cnt_, __ATOMIC_RELAXED, __HIP_MEMORY_SCOPE_AGENT) < bar_round * bar_ngrp) __builtin_amdgcn_s_sleep(2); \
        __builtin_amdgcn_fence(__ATOMIC_ACQUIRE, "agent"); asm volatile("s_waitcnt vmcnt(0)" ::: "memory"); } __syncthreads(); } while (0)
#endif
#define REPS(k) (1 + (DUP_PHASE == (k) ? DUP_N : 0))
#define PHASE(k, ...) for (int rep_ = 0; rep_ < REPS(k); ++rep_) { int dry = rep_ < REPS(k) - 1; asm volatile("" : "+s"(dry)); __VA_ARGS__ GSYNC(); }
    if (p.ws == nullptr) grid.sync();
    for (int rep_ = 0; rep_ < REPS(0); ++rep_) { phase_convert(p, lds, 2, (int)blockIdx.x, (int)gridDim.x); GSYNC(); }
    if (threadIdx.x == 0) *(LAS u32x4*)(lds + 131072) = (u32x4){0u, 0u, 0u, 0u};
    __syncthreads();
#if BARRIER_KIND == 1
    const XcdBarrier xb = xcd_barrier_post((unsigned*)(p.ws + WS_BAR), (volatile LAS unsigned*)(lds + 131072));
#endif
    PHASE(1, { EpiSwiglu E; E.O = PACT; E.rstd = nullptr; E.nparts = 0; run_gemm(lds, HB, (const bf16_t*)(p.ws + WS_W1GU), 5632, 1024, E); })
    PHASE(2, { const EpiResid E{p.in[0], 0.5f, p.in[1], 0, XRES, HB, ssq + 16 * MROWS, PART}; run_gemm_split(lds, PACT, (const bf16_t*)(p.ws + WS_W1D), FF, E); })
    split_fixup(PART, 11, p.in[1], XRES, HB, ssq + 16 * MROWS, 0.5f, 0, nullptr, RSTD); GSYNC();
    PHASE(3, { EpiP E; E.P = PACT; E.rstd = RSTD; E.out = p.out; run_gemm(lds, HB, (const bf16_t*)(p.ws + WS_WIN), NINP, 1024, E); })
    PHASE(4, { int mask = dry ? DUP_MASK : 3; asm volatile("" : "+s"(mask)); phase_mix_a(p, lds, mask); })
#if GLA2_SEL >= 0
    { int sel = GLA2_SEL; asm volatile("" : "+s"(sel)); phase_mix_a2(p, lds, sel); GSYNC(); }
#endif
    PHASE(5, phase_scan(p, lds, dry);)
    PHASE(6, { int mask = dry ? DUP_MASK : 3; asm volatile("" : "+s"(mask)); phase_mix_c(p, lds, dry, mask); })
    PHASE(7, { const EpiResid E{XRES, 1.0f, XRES + (size_t)MPROMPT * DM, dry, XRES, HB2, ssq + 32 * MROWS, PART}; run_gemm_split(lds, HB, (const bf16_t*)(p.ws + WS_WOUT), 1024, E); })
    split_fixup(PART, 4, XRES + (size_t)MPROMPT * DM, XRES, HB2, ssq + 32 * MROWS, 1.0f, 0, nullptr, RSTD + MROWS); GSYNC();
    PHASE(8, { EpiSwiglu E; E.O = PACT; E.rstd = RSTD + MROWS; E.nparts = 1; run_gemm(lds, HB2, (const bf16_t*)(p.ws + WS_W2GU), 5632, 1024, E); })
    PHASE(9, { const EpiResid E{XRES, 0.5f, XRES + (size_t)MPROMPT * DM, dry, XRES, nullptr, ssq + 48 * MROWS, PART}; run_gemm_split(lds, PACT, (const bf16_t*)(p.ws + WS_W2D), FF, E); })
    split_fixup(PART, 11, XRES + (size_t)MPROMPT * DM, XRES, nullptr, ssq + 48 * MROWS, 0.5f, 0, p.in[30], nullptr);
#if DUP_PHASE == 11
    for (int rep_ = 0; rep_ < 10 * DUP_N; ++rep_) GSYNC();
#endif
    for (int rep_ = 0; rep_ < REPS(10); ++rep_) { int dry = rep_ < REPS(10) - 1; asm volatile("" : "+s"(dry)); phase_final_norm(p, dry); if (dry) GSYNC(); }
}

extern "C" void kernel_launch(void* const* d_in, const int* in_sizes, int n_in, void* d_out, int out_size, void* d_ws, size_t ws_size, hipStream_t stream) {
    static int grid = 0;
    if (grid == 0) {
        if (n_in != 31 || (size_t)out_size != O_END || ws_size < WS_END) { fprintf(stderr, "kernel_launch: unexpected sizes n_in %d out %d ws %zu (need %zu)\n", n_in, out_size, ws_size, (size_t)WS_END); grid = -1; return; }
        int dev = 0, cus = 0, per_cu = 0;
        hipGetDevice(&dev); hipDeviceGetAttribute(&cus, hipDeviceAttributeMultiprocessorCount, dev);
        if (hipFuncSetAttribute((const void*)fwd_megakernel, hipFuncAttributeMaxDynamicSharedMemorySize, LDS_BYTES) != hipSuccess) { fprintf(stderr, "kernel_launch: hipFuncSetAttribute failed\n"); grid = -1; return; }
        if (hipOccupancyMaxActiveBlocksPerMultiprocessor(&per_cu, (const void*)fwd_megakernel, 512, LDS_BYTES) != hipSuccess || per_cu < 1) { fprintf(stderr, "kernel_launch: occupancy query says %d\n", per_cu); per_cu = 1; }
        (void)hipGetLastError();
        grid = cus;
    }
    if (grid < 0) return;
    if (hipMemsetAsync((unsigned char*)d_ws + WS_BAR, 0, 16384, stream) != hipSuccess) { fprintf(stderr, "kernel_launch: memset failed\n"); return; }
    Params p{};
    for (int i = 0; i < 31; ++i) p.in[i] = (const float*)d_in[i];
    p.out = (float*)d_out; p.ws = (unsigned char*)d_ws;
    void* args[] = {&p};
    hipError_t e = hipLaunchCooperativeKernel((const void*)fwd_megakernel, dim3(grid), dim3(512), args, LDS_BYTES, stream);
    if (e != hipSuccess) fprintf(stderr, "cooperative launch failed: %s (grid %d)\n", hipGetErrorString(e), grid);
}
```

```cpp
#include <hip/hip_runtime.h>
#include <hip/hip_cooperative_groups.h>
#include <cstdio>
namespace cg = cooperative_groups;
#define BARRIER_KIND 2
#define GLA2_SEL -1
#ifndef DUP_PHASE
#define DUP_PHASE -1
#define DUP_N 1
#define DUP_MASK 3
#endif
namespace pg8 {
#define PG8_LAS __attribute__((address_space(3)))
typedef unsigned short bf16_t;
typedef short bf16x8 __attribute__((ext_vector_type(8)));
typedef float f32x4 __attribute__((ext_vector_type(4)));
typedef unsigned u32x4 __attribute__((ext_vector_type(4)));
constexpr int BM = 256, BK = 64, HALF = 128, HTB = HALF * BK * 2  , STAGE_BYTES = 8 * HTB, NXCD = 8, WGM = 4;

__host__ __device__ __forceinline__ int lds_byte(int r, int c) { const int st = (r >> 4) * 2 + (c >> 5), rr = r & 15, cc = c & 31, ob = rr * 64 + cc * 2; return st * 1024 + (ob ^ (((ob >> 9) & 1) << 5)); }
__host__ __device__ __forceinline__ void stage_rc(int b, int& R, int& C) { const int st = b / 1024, sb = b % 1024, swz = sb ^ (((sb >> 9) & 1) << 5); R = (st >> 1) * 16 + swz / 64; C = (st & 1) * 32 + (swz % 64) / 2; }
__host__ __device__ __forceinline__ int perm32(int rho) { const int n = rho >> 4, i = rho & 15; return 8 * (i >> 2) + 4 * n + (i & 3); }

struct Unit { int pm, pn, k0, nkt, part; };
struct Gemm { const bf16_t* A; const bf16_t* Bt; int M, N, K; };

struct StaticOrder {
    int nM, nN, nwg, G, c, nkt;
    __host__ __device__ void init(int M, int N, int G_, int c_, int K_ = 0) { nM = M / BM; nN = N / BM; nwg = nM * nN; G = G_; c = c_; nkt = K_ / BK; }
    __host__ __device__ bool next(int i, Unit& u) const {
        const long L = (long)i * G + c; if (L >= nwg) return false;
        int wgid = (int)L; { const int q = nwg / NXCD, r = nwg % NXCD, xcd = wgid % NXCD, off = wgid / NXCD; wgid = (xcd < r ? xcd * (q + 1) : r * (q + 1) + (xcd - r) * q) + off; }
        const int nig = WGM * nN, gid = wgid / nig, fm = gid * WGM, gsz = (nM - fm) < WGM ? (nM - fm) : WGM;
        u.pm = fm + ((wgid % nig) % gsz); u.pn = (wgid % nig) / gsz; u.k0 = 0; u.nkt = nkt; u.part = -1; return true;
    }
    __device__ __forceinline__ void a_ready(const Unit&) const {}
    __device__ __forceinline__ void done(const Unit&) const {}
};
__device__ __forceinline__ unsigned cvt_pk_bf16(float lo, float hi) { unsigned r; asm volatile("v_cvt_pk_bf16_f32 %0, %1, %2" : "=v"(r) : "v"(lo), "v"(hi)); return r; }

template <class Epi, class Sched, bool STAMP = false>
__device__ __forceinline__ void gemm_phase(PG8_LAS unsigned char* lds, const Gemm g, const Sched& S, const Epi& E, unsigned long long* stamps) {
    int tid_ = threadIdx.x; asm volatile("" : "+v"(tid_)); const int tid = tid_, wid = __builtin_amdgcn_readfirstlane(tid >> 6), lane = tid & 63, wr = wid >> 2, wc = wid & 3, fr = lane & 15, fq = lane >> 4;
    const int K = g.K;
    int ts_lo = 0, ts_hi = 0, nts = 0; const unsigned long long rt_entry = STAMP ? (unsigned long long)wall_clock64() : 0ull;
#define PG8_STAMP() do { if (STAMP && wid == 0 && nts < 64) { const unsigned long long _c = (unsigned long long)clock64(); \
        ts_lo = (lane == nts) ? (int)(unsigned)_c : ts_lo; ts_hi = (lane == nts) ? (int)(unsigned)(_c >> 32) : ts_hi; ++nts; } } while (0)
    PG8_STAMP();
    unsigned voffA[2], voffB[2];
#pragma unroll
    for (int i = 0; i < 2; ++i) { int R, C; stage_rc(tid * 16 + i * 8192, R, C); const int Rb = Epi::PERM ? ((R & ~31) + perm32(R & 31)) : R;
        voffA[i] = (unsigned)(R * K + C) * 2u; voffB[i] = (unsigned)(Rb * K + C) * 2u; }
    const size_t kstep = (size_t)(BK * 2);
    const size_t hstep = (size_t)HALF * K * 2;
    const size_t tstep = 2 * hstep;
    const unsigned ldsw = (unsigned)wid * 1024u;
    const int aoff = lds_byte(wr * 64 + fr, fq * 8), boff = lds_byte(wc * 32 + fr, fq * 8);
#define PG8_SA(b, h) (((b) * 2 + (h)) * HTB)
#define PG8_SB(b, h) ((4 + (b) * 2 + (h)) * HTB)
#define PG8_STAGE(bufoff, gbase, voff) do { _Pragma("unroll") for (int _i = 0; _i < 2; ++_i) \
        __builtin_amdgcn_global_load_lds((const unsigned*)((const char*)(gbase) + (voff)[_i]), (PG8_LAS unsigned*)(lds + (bufoff) + ldsw + _i * 8192), 16, 0, 0); } while (0)
#define PG8_LDA(dst, b, h) do { _Pragma("unroll") for (int m = 0; m < 4; ++m) _Pragma("unroll") for (int k = 0; k < 2; ++k) dst[m][k] = *(const PG8_LAS bf16x8*)(lds + PG8_SA(b, h) + aoff + m * 2048 + k * 1024); } while (0)
#define PG8_LDB(dst, b, h) do { _Pragma("unroll") for (int n = 0; n < 2; ++n) _Pragma("unroll") for (int k = 0; k < 2; ++k) dst[n][k] = *(const PG8_LAS bf16x8*)(lds + PG8_SB(b, h) + boff + n * 2048 + k * 1024); } while (0)
#define PG8_MMA(ai, bj, At, Bt) do { __builtin_amdgcn_s_setprio(1); _Pragma("unroll") for (int m = 0; m < 4; ++m) _Pragma("unroll") for (int n = 0; n < 2; ++n) _Pragma("unroll") for (int k = 0; k < 2; ++k) \
        acc[ai][bj][m][n] = __builtin_amdgcn_mfma_f32_16x16x32_bf16(Bt[n][k], At[m][k], acc[ai][bj][m][n], 0, 0, 0); __builtin_amdgcn_s_setprio(0); } while (0)
#define PG8_WAIT_V(n) asm volatile("s_waitcnt vmcnt(" #n ")" ::: "memory")
#define PG8_WAIT_L(n) asm volatile("s_waitcnt lgkmcnt(" #n ")" ::: "memory")
#define PG8_BAR __builtin_amdgcn_s_barrier()
#define PG8_SCHED __builtin_amdgcn_sched_barrier(0)
    Unit cur, nxt; int ui = 0;
    if (!S.next(0, cur)) return;
    f32x4 acc[2][2][4][2];
#pragma unroll
    for (int a = 0; a < 2; ++a)
#pragma unroll
        for (int b = 0; b < 2; ++b)
#pragma unroll
            for (int m = 0; m < 4; ++m)
#pragma unroll
                for (int n = 0; n < 2; ++n) acc[a][b][m][n] = (f32x4){0.f, 0.f, 0.f, 0.f};
    bf16x8 At[4][2], B0[2][2], B1[2][2];
    const char* cA = (const char*)g.A + (size_t)cur.pm * tstep + (size_t)cur.k0 * kstep; const char* cB = (const char*)g.Bt + (size_t)cur.pn * tstep + (size_t)cur.k0 * kstep;
    S.a_ready(cur);
    float pre[8]; E.prefetch(cur, wr, fr, pre);
    PG8_STAGE(PG8_SB(0, 0), cB, voffB); PG8_STAGE(PG8_SA(0, 0), cA, voffA); PG8_STAGE(PG8_SB(0, 1), cB + hstep, voffB); PG8_STAGE(PG8_SA(0, 1), cA + hstep, voffA);
    if (wr == 1) PG8_BAR;
    PG8_WAIT_V(4); PG8_BAR;
    PG8_STAGE(PG8_SB(1, 0), cB + kstep, voffB); PG8_STAGE(PG8_SA(1, 0), cA + kstep, voffA); PG8_STAGE(PG8_SB(1, 1), cB + hstep + kstep, voffB);
    PG8_WAIT_V(6); PG8_BAR;
    PG8_STAMP();
    for (;;) {
        const bool has_next = S.next(ui + 1, nxt);
        const char* nA = has_next ? (const char*)g.A + (size_t)nxt.pm * tstep + (size_t)nxt.k0 * kstep : cA; const char* nB = has_next ? (const char*)g.Bt + (size_t)nxt.pn * tstep + (size_t)nxt.k0 * kstep : cB;
        const int nt = cur.nkt;
        for (int t = 0; t < nt; t += 2) {
            const bool last = (t == nt - 2);
            const char* a1 = cA + (size_t)(t + 1) * kstep;
            const char* a2 = last ? nA : cA + (size_t)(t + 2) * kstep; const char* b2 = last ? nB : cB + (size_t)(t + 2) * kstep;
            const char* a3 = a2 + kstep; const char* b3 = b2 + kstep;
            if (last && has_next) S.a_ready(nxt);
            PG8_LDB(B0, 0, 0); PG8_SCHED; PG8_LDA(At, 0, 0); PG8_STAGE(PG8_SA(1, 1), a1 + hstep, voffA);
            PG8_WAIT_L(8); PG8_BAR; PG8_WAIT_L(0); PG8_MMA(0, 0, At, B0); PG8_BAR; PG8_SCHED;
            PG8_LDB(B1, 0, 1); PG8_STAGE(PG8_SB(0, 0), b2, voffB);
            PG8_BAR; PG8_WAIT_L(0); PG8_MMA(0, 1, At, B1); PG8_BAR;
            PG8_LDA(At, 0, 1); PG8_STAGE(PG8_SA(0, 0), a2, voffA);
            PG8_BAR; PG8_WAIT_L(0); PG8_MMA(1, 0, At, B0); PG8_BAR; PG8_SCHED;
            PG8_STAGE(PG8_SB(0, 1), b2 + hstep, voffB);
            PG8_WAIT_V(6); PG8_BAR; PG8_MMA(1, 1, At, B1); PG8_BAR;
            PG8_LDB(B0, 1, 0); PG8_SCHED; PG8_LDA(At, 1, 0); PG8_STAGE(PG8_SA(0, 1), a2 + hstep, voffA);
            PG8_WAIT_L(8); PG8_BAR; PG8_WAIT_L(0); PG8_MMA(0, 0, At, B0); PG8_BAR; PG8_SCHED;
            PG8_LDB(B1, 1, 1); PG8_STAGE(PG8_SB(1, 0), b3, voffB);
            PG8_BAR; PG8_WAIT_L(0); PG8_MMA(0, 1, At, B1); PG8_BAR;
            PG8_LDA(At, 1, 1); PG8_STAGE(PG8_SA(1, 0), a3, voffA);
            PG8_BAR; PG8_WAIT_L(0); PG8_MMA(1, 0, At, B0); PG8_BAR; PG8_SCHED;
            PG8_STAGE(PG8_SB(1, 1), b3 + hstep, voffB);
            PG8_WAIT_V(6); PG8_BAR; PG8_MMA(1, 1, At, B1); PG8_BAR;
        }
        PG8_STAMP();
        if constexpr (!Epi::AFTER_DRAIN) { E(acc, cur, wr, wc, fr, fq, pre); S.done(cur); }
        PG8_STAMP();
        if (!has_next) break;
#pragma unroll
        for (int a = 0; a < 2; ++a)
#pragma unroll
            for (int b = 0; b < 2; ++b)
#pragma unroll
                for (int m = 0; m < 4; ++m)
#pragma unroll
                    for (int n = 0; n < 2; ++n) acc[a][b][m][n] = (f32x4){0.f, 0.f, 0.f, 0.f};
        cur = nxt; cA = nA; cB = nB; ++ui; E.prefetch(cur, wr, fr, pre);
    }
    PG8_WAIT_V(0);
    if (wr == 0) PG8_BAR;
    PG8_BAR;
    if constexpr (Epi::AFTER_DRAIN) { E.fused(acc, cur, wr, wc, fr, fq, lds, wid, lane); S.done(cur); }
    PG8_STAMP();
    if (STAMP && wid == 0) { stamps[lane] = lane < nts ? (((unsigned long long)(unsigned)ts_hi << 32) | (unsigned)ts_lo) : 0ull;
        if (lane == 62) stamps[62] = rt_entry; if (lane == 63) stamps[63] = (unsigned long long)wall_clock64(); }
#undef PG8_STAMP
#undef PG8_SA
#undef PG8_SB
#undef PG8_STAGE
#undef PG8_LDA
#undef PG8_LDB
#undef PG8_MMA
#undef PG8_WAIT_V
#undef PG8_WAIT_L
#undef PG8_BAR
#undef PG8_SCHED
}
}
#define LAS PG8_LAS
#define XB_TMO      128
#define XB_XCNT(j)  (256  + 64 * (j))
#define XB_XSUB(j)  (1280 + 64 * (j))
#define XB_XGEN(j)  (2304 + 64 * (j))
#define XB_TOP      3328
#define XB_TOPGEN   3392
#define XCD_BAR_WORDS 3456
#define XB_SPIN_CAP (1u << 18)

__device__ __forceinline__ unsigned xb_ld(unsigned* p)              { return __hip_atomic_load(p, __ATOMIC_RELAXED, __HIP_MEMORY_SCOPE_AGENT); }
__device__ __forceinline__ unsigned xb_add(unsigned* p, unsigned v) { return __hip_atomic_fetch_add(p, v, __ATOMIC_RELAXED, __HIP_MEMORY_SCOPE_AGENT); }
__device__ __forceinline__ unsigned xb_xcc_id() { return (unsigned)__builtin_amdgcn_s_getreg((3 << 11) | 20) & 0xFu; }
#define XB_SPIN(cond, bar) do { unsigned _sp = 0; while (cond) { __builtin_amdgcn_s_sleep(1); \
    if ((++_sp & 255u) == 0u) { if (xb_ld(&(bar)[XB_TMO])) break; if (_sp > XB_SPIN_CAP) { atomicAdd(&(bar)[XB_TMO], 1u); break; } } } } while (0)

struct XcdBarrier {
    unsigned* bar; unsigned x;
    volatile LAS unsigned* st;
};

__device__ __forceinline__ XcdBarrier xcd_barrier_post(unsigned* bar, volatile LAS unsigned* st) {
    XcdBarrier b; b.bar = bar; b.x = xb_xcc_id(); b.st = st;
    if (threadIdx.x == 0) (void)xb_add(&bar[XB_XCNT(b.x)], 1u);
    return b;
}
__device__ __forceinline__ void xcd_barrier_complete(unsigned* bar, unsigned x, unsigned& nloc, unsigned& nx) {
    const unsigned G = gridDim.x * gridDim.y * gridDim.z;
    unsigned sum, cnt, mine, sp = 0u;
    for (;;) {
        sum = 0u; cnt = 0u; mine = 0u;
#pragma unroll
        for (unsigned j = 0; j < 16; ++j) { const unsigned c = xb_ld(&bar[XB_XCNT(j)]); sum += c; cnt += (c > 0u) ? 1u : 0u; mine = (j == x) ? c : mine; }
        if (sum == G) break;
        __builtin_amdgcn_s_sleep(1);
        if ((++sp & 255u) == 0u) { if (xb_ld(&bar[XB_TMO])) break; if (sp > XB_SPIN_CAP) { atomicAdd(&bar[XB_TMO], 1u); break; } }
    }
    nloc = mine > 0u ? mine : 1u; nx = cnt > 0u ? cnt : 1u;
}

__device__ __forceinline__ void xcd_barrier(const XcdBarrier& b) {
    asm volatile("s_waitcnt vmcnt(0)" ::: "memory");
    __syncthreads();
    if (threadIdx.x == 0) {
        unsigned* bar = b.bar;
        __builtin_amdgcn_s_waitcnt(0);
        unsigned nloc = b.st[0], nx = b.st[1];
        if (nloc == 0u) { xcd_barrier_complete(bar, b.x, nloc, nx); b.st[0] = nloc; b.st[1] = nx; }
        const unsigned old = xb_add(&bar[XB_XSUB(b.x)], 1u);
        const unsigned gen = old / nloc;
        if (old + 1u == (gen + 1u) * nloc) {
            __builtin_amdgcn_fence(__ATOMIC_RELEASE, "agent");
            asm volatile("s_waitcnt vmcnt(0)" ::: "memory");
            const unsigned og = xb_add(&bar[XB_TOP], 1u);
            const unsigned tg = og / nx;
            if (og + 1u == (tg + 1u) * nx) xb_add(&bar[XB_TOPGEN], 1u);
            else XB_SPIN(xb_ld(&bar[XB_TOPGEN]) == tg, bar);
            __builtin_amdgcn_fence(__ATOMIC_ACQUIRE, "agent");
            xb_add(&bar[XB_XGEN(b.x)], 1u);
            asm volatile("s_waitcnt vmcnt(0)" ::: "memory");
        } else {
            XB_SPIN(xb_ld(&bar[XB_XGEN(b.x)]) == gen, bar);
            __builtin_amdgcn_fence(__ATOMIC_ACQUIRE, "agent");
            asm volatile("s_waitcnt vmcnt(0)" ::: "memory");
        }
    }
    __syncthreads();
}

using pg8::bf16_t; using pg8::bf16x8; using pg8::f32x4; using pg8::u32x4; using pg8::Unit; using pg8::cvt_pk_bf16;

typedef float f32x2 __attribute__((ext_vector_type(2)));
typedef unsigned u32x2 __attribute__((ext_vector_type(2)));

constexpr int MROWS = 16640, MPROMPT = 16384, DM = 1024, FF = 2816, NIN = 3216, NINP = 3328, ACOLS = 1664, BOFF = 1664;
constexpr int NSAMP = 16, SAMP_T = 16;
constexpr size_t O_Y = 0, O_SHIFT_P = 17039360, O_WKV_P = 17041024, O_GLA_P = 17073792, O_SHIFT_S = 17106560, O_WKV_S = 17133184, O_GLA_S = 17657472, O_END = 18181760;
constexpr size_t al256(size_t x) { return (x + 255) & ~(size_t)255; }
constexpr size_t WS_W1GU = 0;
constexpr size_t WS_W1D  = WS_W1GU + (size_t)5632 * 1024 * 2;
constexpr size_t WS_WIN  = WS_W1D + (size_t)1024 * 2816 * 2;
constexpr size_t WS_WOUT = WS_WIN + (size_t)NINP * 1024 * 2;
constexpr size_t WS_W2GU = WS_WOUT + (size_t)1024 * 1024 * 2;
constexpr size_t WS_W2D  = WS_W2GU + (size_t)5632 * 1024 * 2;
constexpr size_t WS_SSQ  = WS_W2D + (size_t)1024 * 2816 * 2;
constexpr size_t SSQ_BYTES = (size_t)16 * MROWS * 4;
constexpr size_t WS_HB   = WS_SSQ + 4 * SSQ_BYTES;
constexpr size_t WS_PACT = WS_HB + (size_t)MROWS * 1024 * 2;
constexpr size_t WS_G    = WS_PACT + (size_t)MROWS * NIN * 2;
constexpr size_t WS_HSR  = WS_G + (size_t)144 * 8 * 8192;
constexpr size_t WS_HSG  = WS_HSR + (size_t)144 * 8 * 16384;
constexpr size_t WS_DECG = WS_HSG + (size_t)272 * 4 * 32768;
constexpr size_t WS_BONUS= WS_DECG + (size_t)272 * 4 * 64 * 4;
constexpr size_t WS_BAR  = WS_BONUS + (size_t)MROWS * 8 * 4;
constexpr size_t WS_DUMMY= WS_BAR + 16384;
constexpr size_t WS_GBS  = WS_DUMMY + ((size_t)1 << 20);
constexpr size_t WS_RSTD = WS_GBS + (size_t)272 * 4 * 4 * 2 * 64 * 4;
constexpr size_t WS_END  = WS_RSTD + (size_t)2 * MROWS * 4;
constexpr size_t WS_Y    = WS_W1GU;
constexpr size_t WS_HB2  = WS_HSG;
static_assert((size_t)MROWS * 512 * 2 <= WS_WOUT, "Y overlay");
static_assert((size_t)MROWS * 1024 * 2 <= (size_t)272 * 4 * 32768, "HB2 overlay");
constexpr int LDS_BYTES = 131072 + 16;

struct Params { const float* in[31]; float* out; unsigned char* ws; };

__device__ __forceinline__ float rstd_of(const float* ssq, int nparts, int row) {
    float s = 0.f;
    for (int p = 0; p < nparts; ++p) s += ssq[(size_t)p * MROWS + row];
    return rsqrtf(s * (1.0f / 1024.0f) + 1e-6f);
}
__device__ __forceinline__ int tid_opaque() { int t = threadIdx.x; asm volatile("" : "+v"(t)); return t; }
__device__ __forceinline__ float sigmoidf_(float x) { return __builtin_amdgcn_rcpf(1.0f + __expf(-x)); }

struct EpiSwiglu {
    static constexpr bool PERM = true, AFTER_DRAIN = false;
    bf16_t* O; const float* rstd; int nparts;
    __device__ __forceinline__ void prefetch(const Unit& u, int wr, int fr, float (&pre)[8]) const {
        if (nparts) {
#pragma unroll
            for (int ai = 0; ai < 2; ++ai)
#pragma unroll
                for (int m = 0; m < 4; ++m) pre[ai * 4 + m] = rstd[u.pm * 256 + wr * 64 + fr + ai * 128 + m * 16];
        }
    }
    __device__ __forceinline__ void operator()(const f32x4 (&acc)[2][2][4][2], const Unit& u, int wr, int wc, int fr, int fq, const float (&pre)[8]) const {
        const int row0 = u.pm * 256 + wr * 64 + fr, col0 = u.pn * 128 + wc * 32 + 8 * fq;
#pragma unroll
        for (int ai = 0; ai < 2; ++ai)
#pragma unroll
            for (int m = 0; m < 4; ++m) {
                const int row = row0 + ai * 128 + m * 16; const float rs = nparts ? pre[ai * 4 + m] : 1.0f;
                float a[8];
#pragma unroll
                for (int n = 0; n < 2; ++n)
#pragma unroll
                    for (int j = 0; j < 4; ++j) { const float g = acc[ai][0][m][n][j] * rs, up = acc[ai][1][m][n][j] * rs; a[n * 4 + j] = g * sigmoidf_(g) * up; }
                u32x4 w; w.x = cvt_pk_bf16(a[0], a[1]); w.y = cvt_pk_bf16(a[2], a[3]); w.z = cvt_pk_bf16(a[4], a[5]); w.w = cvt_pk_bf16(a[6], a[7]);
                *(u32x4*)(O + (size_t)row * FF + col0) = w;
            }
    }
};
struct EpiResid {
    static constexpr bool PERM = true, AFTER_DRAIN = false;
    const float* xoldA; float scale; const float* xoldB; int dry; float* xnew; bf16_t* xb; float* ssq; float* part;
    __device__ __forceinline__ void prefetch(const Unit&, int, int, float (&)[8]) const {}
    __device__ __forceinline__ void operator()(const f32x4 (&acc)[2][2][4][2], const Unit& u, int wr, int wc, int fr, int fq, const float (&)[8]) const {
        const int row0 = u.pm * 256 + wr * 64 + fr, col0 = u.pn * 256 + wc * 32 + 8 * fq;
        float sc_ = scale; asm volatile("" : "+v"(sc_)); const f32x4 sc4 = (f32x4){sc_, sc_, sc_, sc_};
        if (u.part >= 0) {
            float* pb = part + ((size_t)(u.part * 4 + u.pn) * 256 + wr * 64 + fr) * 256 + wc * 32 + 8 * fq;
#pragma unroll
            for (int ai = 0; ai < 2; ++ai)
#pragma unroll
                for (int m = 0; m < 4; ++m)
#pragma unroll
                    for (int bj = 0; bj < 2; ++bj) { float* q = pb + (size_t)(ai * 128 + m * 16) * 256 + bj * 128; *(f32x4*)q = acc[ai][bj][m][0]; *(f32x4*)(q + 4) = acc[ai][bj][m][1]; }
        } else {
#pragma unroll
        for (int ai = 0; ai < 2; ++ai) {
            f32x4 xv[4][2][2];
#pragma unroll
            for (int m = 0; m < 4; ++m) {
                const int row = row0 + ai * 128 + m * 16;
                const float* xo = row < MPROMPT ? xoldA + (size_t)row * DM : xoldB + (size_t)(row - MPROMPT) * DM;
#pragma unroll
                for (int bj = 0; bj < 2; ++bj) { xv[m][bj][0] = *(const f32x4*)(xo + col0 + bj * 128); xv[m][bj][1] = *(const f32x4*)(xo + col0 + bj * 128 + 4); }
            }
            __builtin_amdgcn_sched_barrier(0);
#pragma unroll
            for (int m = 0; m < 4; ++m) {
                const int row = row0 + ai * 128 + m * 16;
                float sq = 0.f;
#pragma unroll
                for (int bj = 0; bj < 2; ++bj) {
                    const int col = col0 + bj * 128;
                    f32x4 v0 = xv[m][bj][0], v1 = xv[m][bj][1];
                    if (!dry) { v0 += acc[ai][bj][m][0] * sc4; v1 += acc[ai][bj][m][1] * sc4; }
                    *(f32x4*)(xnew + (size_t)row * DM + col) = v0; *(f32x4*)(xnew + (size_t)row * DM + col + 4) = v1;
                    if (xb) { u32x4 w; w.x = cvt_pk_bf16(v0[0], v0[1]); w.y = cvt_pk_bf16(v0[2], v0[3]); w.z = cvt_pk_bf16(v1[0], v1[1]); w.w = cvt_pk_bf16(v1[2], v1[3]);
                        *(u32x4*)(xb + (size_t)row * DM + col) = w; }
                    sq += (v0[0] * v0[0] + v0[1] * v0[1]) + (v0[2] * v0[2] + v0[3] * v0[3]) + (v1[0] * v1[0] + v1[1] * v1[1]) + (v1[2] * v1[2] + v1[3] * v1[3]);
                }
                sq += __shfl_xor(sq, 16); sq += __shfl_xor(sq, 32);
                if (fq == 0) ssq[(size_t)(u.pn * 4 + wc) * MROWS + row] = sq;
            }
            __builtin_amdgcn_sched_barrier(0);
        }
        }
    }
};
struct EpiP {
    static constexpr bool PERM = true, AFTER_DRAIN = false;
    bf16_t* P; const float* rstd; float* out;
    __device__ __forceinline__ void prefetch(const Unit& u, int wr, int fr, float (&pre)[8]) const {
#pragma unroll
        for (int ai = 0; ai < 2; ++ai)
#pragma unroll
            for (int m = 0; m < 4; ++m) pre[ai * 4 + m] = rstd[u.pm * 256 + wr * 64 + fr + ai * 128 + m * 16];
    }
    __device__ __forceinline__ void operator()(const f32x4 (&acc)[2][2][4][2], const Unit& u, int wr, int wc, int fr, int fq, const float (&pre)[8]) const {
        const int row0 = u.pm * 256 + wr * 64 + fr, col0 = u.pn * 256 + wc * 32 + 8 * fq;
#pragma unroll
        for (int ai = 0; ai < 2; ++ai)
#pragma unroll
            for (int m = 0; m < 4; ++m) {
                const int row = row0 + ai * 128 + m * 16; const float rs = pre[ai * 4 + m];
                float* dst = nullptr;
                if (row == MPROMPT - 1) dst = out + O_SHIFT_P;
                else if (row >= MPROMPT && ((row - MPROMPT) & 15) == 15) dst = out + O_SHIFT_S + (size_t)((row - MPROMPT) >> 4) * ACOLS;
#pragma unroll
                for (int bj = 0; bj < 2; ++bj) {
                    const int col = col0 + bj * 128;
                    if (col < NIN) {
                        const f32x4 v0 = acc[ai][bj][m][0] * rs, v1 = acc[ai][bj][m][1] * rs;
                        u32x4 w; w.x = cvt_pk_bf16(v0[0], v0[1]); w.y = cvt_pk_bf16(v0[2], v0[3]); w.z = cvt_pk_bf16(v1[0], v1[1]); w.w = cvt_pk_bf16(v1[2], v1[3]);
                        *(u32x4*)(P + (size_t)row * NIN + col) = w;
                        if (dst && col < ACOLS) { *(f32x4*)(dst + col) = v0; *(f32x4*)(dst + col + 4) = v1; }
                    }
                }
            }
    }
};
template <class Epi>
__device__ __forceinline__ void run_gemm(LAS unsigned char* lds, const bf16_t* A, const bf16_t* Bt, int N, int K, const Epi& E) {
    pg8::Gemm g; g.A = A; g.Bt = Bt; g.M = MROWS; g.N = N; g.K = K;
    pg8::StaticOrder S; S.init(MROWS, N, (int)gridDim.x, (int)blockIdx.x, K);
    pg8::gemm_phase<Epi, pg8::StaticOrder, false>(lds, g, S, E, nullptr);
}
struct SplitOrder {
    pg8::StaticOrder S; int nsmall, c;
    __device__ void init(int G, int c_, int K) { S.init(MPROMPT, 1024, G, c_, K); c = c_; nsmall = 4 * (K / 256); }
    __device__ bool next(int i, Unit& u) const {
        if (i == 0) return S.next(0, u);
        if (i == 1 && c < nsmall) { u.pm = MPROMPT / 256; u.pn = c & 3; u.part = c >> 2; u.k0 = u.part * 4; u.nkt = 4; return true; }
        return false;
    }
    __device__ __forceinline__ void a_ready(const Unit&) const {}
    __device__ __forceinline__ void done(const Unit&) const {}
};
template <class Epi>
__device__ __forceinline__ void run_gemm_split(LAS unsigned char* lds, const bf16_t* A, const bf16_t* Bt, int K, const Epi& E) {
    pg8::Gemm g; g.A = A; g.Bt = Bt; g.M = MROWS; g.N = 1024; g.K = K;
    SplitOrder S; S.init((int)gridDim.x, (int)blockIdx.x, K);
    pg8::gemm_phase<Epi, SplitOrder, false>(lds, g, S, E, nullptr);
}
__device__ __forceinline__ void split_fixup(const float* part, int nsplit, const float* xold, float* xnew, bf16_t* xb, float* ssq, float scale, int dry, const float* fin_g, float* rstd_out) {
    const int tid = tid_opaque(), wave = tid >> 6, lane = tid & 63;
    for (int r = blockIdx.x * 8 + wave; r < 256; r += gridDim.x * 8) {
        const int row = MPROMPT + r; float sq = 0.f; f32x4 v[4];
#pragma unroll
        for (int i = 0; i < 4; ++i) {
            const int col = i * 256 + lane * 4;
            f32x4 a = (f32x4){0.f, 0.f, 0.f, 0.f};
            for (int ks = 0; ks < nsplit; ++ks) a += *(const f32x4*)(part + ((size_t)(ks * 4 + i) * 256 + r) * 256 + lane * 4);
            v[i] = *(const f32x4*)(xold + (size_t)r * DM + col);
            if (!dry) v[i] += a * (f32x4){scale, scale, scale, scale};
            sq += (v[i][0] * v[i][0] + v[i][1] * v[i][1]) + (v[i][2] * v[i][2] + v[i][3] * v[i][3]);
        }
#pragma unroll
        for (int o = 32; o > 0; o >>= 1) sq += __shfl_xor(sq, o);
        const float rs = rsqrtf(sq * (1.0f / 1024.0f) + 1e-6f);
#pragma unroll
        for (int i = 0; i < 4; ++i) {
            const int col = i * 256 + lane * 4;
            if (fin_g) v[i] = v[i] * rs * *(const f32x4*)(fin_g + col);
            *(f32x4*)(xnew + (size_t)row * DM + col) = v[i];
            if (xb) { u32x2 w; w.x = cvt_pk_bf16(v[i][0], v[i][1]); w.y = cvt_pk_bf16(v[i][2], v[i][3]); *(u32x2*)(xb + (size_t)row * DM + col) = w; }
        }
        if (lane < 16) ssq[(size_t)lane * MROWS + row] = lane == 0 ? sq : 0.f;
        if (lane == 0 && rstd_out) rstd_out[row] = rs;
    }
    if (rstd_out) for (int row = blockIdx.x * 512 + tid; row < MPROMPT; row += gridDim.x * 512) rstd_out[row] = rstd_of(ssq, 16, row);
}
struct CvtJob { const float* src; const float* gain; bf16_t* dst; int ldsrc, nvalid, k0, ns0, K, nd0; };
__device__ __forceinline__ void cvt_decode(const Params& p, int tidx, CvtJob& J) {
    if (tidx < 2816) {
        const int f = tidx / 1408, r = tidx % 1408, nb = r / 16, kb = r % 16, pn = nb >> 2, bj = (nb >> 1) & 1, h = nb & 1;
        J.src = f == 0 ? (bj ? p.in[7] : p.in[6]) : (bj ? p.in[28] : p.in[27]); J.gain = f == 0 ? nullptr : p.in[26]; J.dst = (bf16_t*)(p.ws + (f == 0 ? WS_W1GU : WS_W2GU));
        J.ldsrc = FF; J.nvalid = FF; J.k0 = kb * 64; J.ns0 = pn * 128 + h * 64; J.K = 1024; J.nd0 = nb * 64;
    } else if (tidx < 4224) {
        const int f = (tidx - 2816) / 704, r = (tidx - 2816) % 704, nb = r / 44, kb = r % 44;
        J.src = f == 0 ? p.in[8] : p.in[29]; J.gain = nullptr; J.dst = (bf16_t*)(p.ws + (f == 0 ? WS_W1D : WS_W2D)); J.ldsrc = 1024; J.nvalid = 1024; J.k0 = kb * 64; J.ns0 = nb * 64; J.K = FF; J.nd0 = nb * 64;
    } else if (tidx < 5056) {
        const int r = tidx - 4224, nb = r / 16, kb = r % 16;
        J.src = p.in[10]; J.gain = p.in[9]; J.dst = (bf16_t*)(p.ws + WS_WIN); J.ldsrc = NIN; J.nvalid = NIN; J.k0 = kb * 64; J.ns0 = nb * 64; J.K = 1024; J.nd0 = nb * 64;
    } else {
        const int r = tidx - 5056, nb = r / 16, kb = r % 16;
        J.src = p.in[25]; J.gain = nullptr; J.dst = (bf16_t*)(p.ws + WS_WOUT); J.ldsrc = 1024; J.nvalid = 1024; J.k0 = kb * 64; J.ns0 = nb * 64; J.K = 1024; J.nd0 = nb * 64;
    }
}
__device__ __forceinline__ int cvt_remap(int i, int late) {
    if (late == 2) return i;
    if (!late) return i < 1408 ? i : (i < 2112 ? i + 1408 : i + 2112);
    return i < 1408 ? i + 1408 : (i < 2112 ? i + 2112 : i + 2944);
}
__device__ __forceinline__ void phase_convert(const Params& p, LAS unsigned char* lds, int late, int wb, int nb) {
    LAS float* tiles = (LAS float*)lds;
    bf16_t* ws16 = (bf16_t*)p.ws;
    const int t = tid_opaque(), ntiles = late == 2 ? 5312 : (late ? 2368 : 2944);
    for (int base = wb; base < ntiles; base += 4 * nb) {
        f32x4 v[4][2]; float gq[4][2];
#pragma unroll
        for (int u = 0; u < 4; ++u) {
            const int tidx = base + u * nb;
            if (tidx < ntiles) { CvtJob J; cvt_decode(p, cvt_remap(tidx, late), J);
#pragma unroll
                for (int h = 0; h < 2; ++h) { const int i = (t >> 4) + h * 32, j4 = (t & 15) * 4;
                    v[u][h] = (f32x4){0.f, 0.f, 0.f, 0.f};
                    if (J.ns0 + j4 < J.nvalid) v[u][h] = *(const f32x4*)(J.src + (size_t)(J.k0 + i) * J.ldsrc + J.ns0 + j4);
                    gq[u][h] = J.gain ? J.gain[J.k0 + i] : 1.0f; } }
        }
#pragma unroll
        for (int u = 0; u < 4; ++u)
            if (base + u * nb < ntiles) {
#pragma unroll
                for (int h = 0; h < 2; ++h) { const int i = (t >> 4) + h * 32, j4 = (t & 15) * 4;
#pragma unroll
                    for (int e = 0; e < 4; ++e) tiles[u * 4160 + i * 65 + j4 + e] = v[u][h][e] * gq[u][h]; } }
        __syncthreads();
#pragma unroll
        for (int u = 0; u < 4; ++u) {
            const int tidx = base + u * nb;
            if (tidx < ntiles) { CvtJob J; cvt_decode(p, cvt_remap(tidx, late), J);
                const int j = t >> 3, ks = (t & 7) * 8; float a[8];
#pragma unroll
                for (int e = 0; e < 8; ++e) a[e] = tiles[u * 4160 + (ks + e) * 65 + j];
                u32x4 w; w.x = cvt_pk_bf16(a[0], a[1]); w.y = cvt_pk_bf16(a[2], a[3]); w.z = cvt_pk_bf16(a[4], a[5]); w.w = cvt_pk_bf16(a[6], a[7]);
                *(u32x4*)(J.dst + (size_t)(J.nd0 + j) * J.K + J.k0 + ks) = w; }
        }
        __syncthreads();
    }
    (void)ws16;
    if (late == 1) return;
    const int tid = tid_opaque(), wave = tid >> 6, lane = tid & 63;
    float* ssq0 = (float*)(p.ws + WS_SSQ);
    bf16_t* hb = (bf16_t*)(p.ws + WS_HB);
    for (int row = blockIdx.x * 8 + wave; row < MROWS; row += gridDim.x * 8) {
        const float* x = row < MPROMPT ? p.in[0] + (size_t)row * DM : p.in[1] + (size_t)(row - MPROMPT) * DM;
        float sq = 0.f; f32x4 v[4];
#pragma unroll
        for (int i = 0; i < 4; ++i) { v[i] = *(const f32x4*)(x + i * 256 + lane * 4); sq += (v[i][0] * v[i][0] + v[i][1] * v[i][1]) + (v[i][2] * v[i][2] + v[i][3] * v[i][3]); }
#pragma unroll
        for (int o = 32; o > 0; o >>= 1) sq += __shfl_xor(sq, o);
        const float rs = rsqrtf(sq * (1.0f / 1024.0f) + 1e-6f);
#pragma unroll
        for (int i = 0; i < 4; ++i) {
            const f32x4 h = v[i] * rs * *(const f32x4*)(p.in[5] + i * 256 + lane * 4);
            u32x2 w; w.x = cvt_pk_bf16(h[0], h[1]); w.y = cvt_pk_bf16(h[2], h[3]);
            *(u32x2*)(hb + (size_t)row * DM + i * 256 + lane * 4) = w;
        }
    }
}
__device__ __forceinline__ void phase_final_norm(const Params& p, int dry) {
    const int tid = tid_opaque(), wave = tid >> 6, lane = tid & 63;
    const float* ssq3 = (const float*)(p.ws + WS_SSQ + 3 * SSQ_BYTES);
    const float* g = p.in[30];
    f32x4 gg[4];
#pragma unroll
    for (int i = 0; i < 4; ++i) gg[i] = *(const f32x4*)(g + i * 256 + lane * 4);
    const int stride = gridDim.x * 8;
    for (int row0 = blockIdx.x * 8 + wave; row0 < MPROMPT; row0 += 4 * stride) {
        f32x4 v[4][4]; float rs[4];
#pragma unroll
        for (int r = 0; r < 4; ++r) { const int row = row0 + r * stride;
            if (row < MPROMPT) { rs[r] = rstd_of(ssq3, 16, row);
#pragma unroll
                for (int i = 0; i < 4; ++i) v[r][i] = *(const f32x4*)(p.out + (size_t)row * DM + i * 256 + lane * 4); } }
        __builtin_amdgcn_sched_barrier(0);
#pragma unroll
        for (int r = 0; r < 4; ++r) { const int row = row0 + r * stride;
            if (row < MPROMPT) {
#pragma unroll
                for (int i = 0; i < 4; ++i) *(f32x4*)(p.out + (size_t)row * DM + i * 256 + lane * 4) = dry ? v[r][i] : v[r][i] * rs[r] * gg[i]; } }
    }
}
__device__ __forceinline__ float bf2f(bf16_t b) { return __uint_as_float(((unsigned)b) << 16); }
__device__ __forceinline__ float quad_sum(float x) {
    x += __int_as_float(__builtin_amdgcn_update_dpp(0, __float_as_int(x), 0xB1, 0xF, 0xF, true));
    x += __int_as_float(__builtin_amdgcn_update_dpp(0, __float_as_int(x), 0x4E, 0xF, 0xF, true));
    return x;
}
__device__ __forceinline__ float wave_sum(float x) {
    x += __int_as_float(__builtin_amdgcn_update_dpp(0, __float_as_int(x), 0xB1, 0xF, 0xF, true));
    x += __int_as_float(__builtin_amdgcn_update_dpp(0, __float_as_int(x), 0x4E, 0xF, 0xF, true));
    x += __int_as_float(__builtin_amdgcn_update_dpp(0, __float_as_int(x), 0x124, 0xF, 0xF, true));
    x += __int_as_float(__builtin_amdgcn_update_dpp(0, __float_as_int(x), 0x128, 0xF, 0xF, true));
    const int xi = __float_as_int(x);
    return (__int_as_float(__builtin_amdgcn_readlane(xi, 0)) + __int_as_float(__builtin_amdgcn_readlane(xi, 16))) + (__int_as_float(__builtin_amdgcn_readlane(xi, 32)) + __int_as_float(__builtin_amdgcn_readlane(xi, 48)));
}
__device__ __forceinline__ float softplusf_(float x) { return fmaxf(x, 0.f) + __logf(1.0f + __expf(-fabsf(x))); }
__device__ __forceinline__ float tanhf_(float x) { return 1.0f - 2.0f * __builtin_amdgcn_rcpf(1.0f + __expf(2.0f * x)); }
__device__ __forceinline__ f32x2 lo2(f32x4 v) { return __builtin_shufflevector(v, v, 0, 1); }
__device__ __forceinline__ f32x2 hi2(f32x4 v) { return __builtin_shufflevector(v, v, 2, 3); }
__device__ __forceinline__ f32x2 bc2(float x) { return (f32x2){x, x}; }

struct Seg { int row0, nsteps, prevkind; const float* prevptr; };
__device__ __forceinline__ float seg_prev0(const bf16_t* P, const Seg& sg, int col) {
    float prev = 0.f;
    if (sg.prevkind == 1) prev = bf2f(P[(size_t)(sg.row0 - 1) * NIN + col]);
    else if (sg.prevkind == 2) prev = sg.prevptr[col];
    return prev;
}
__device__ __forceinline__ float xs_lerp(const bf16_t* P, const Seg& sg, int i, int col, float mu, float prev0) {
    const float cur = bf2f(P[(size_t)(sg.row0 + i) * NIN + col]);
    const float pr = bf2f(P[(size_t)(sg.row0 + (i > 0 ? i - 1 : 0)) * NIN + col]);
    const float prev = i == 0 ? prev0 : pr;
    return cur + (prev - cur) * mu;
}
__device__ __forceinline__ void load16(const LAS float* src, f32x2 (&d)[8]) {
    const LAS f32x4* s4 = (const LAS f32x4*)src;
#pragma unroll
    for (int i = 0; i < 4; ++i) { const f32x4 v = s4[i]; d[2 * i] = lo2(v); d[2 * i + 1] = hi2(v); }
}

constexpr int RST = 384;
__device__ __forceinline__ void rwkv_a_task(const Params& p, LAS unsigned char* lds, int tk, int mode) {
    const int tid = tid_opaque(), wave = tid >> 6, lane = tid & 63;
    const bf16_t* P = (const bf16_t*)(p.ws + WS_PACT);
    Seg sg; int ci, g;
    if (tk < 256) { const int c = tk >> 1; g = tk & 1; sg.row0 = c * 128; sg.nsteps = 128; sg.prevkind = c == 0 ? 0 : 1; sg.prevptr = nullptr; ci = c; }
    else { const int b = (tk - 256) >> 1; g = (tk - 256) & 1; sg.row0 = MPROMPT + b * 16; sg.nsteps = 16; sg.prevkind = 2; sg.prevptr = p.in[2] + (size_t)b * ACOLS; ci = 128 + b; }
    LAS float* stage = (LAS float*)lds;
    LAS float* bcs = (LAS float*)(lds + 98304) + wave * 512;
    const float* mu = p.in[11];
    const int phl = wave & 3, ptb = (wave >> 2) * 8, hd = g * 4 + phl, C = hd * 64 + lane;
    const float mu_r = mu[C], mu_k = mu[512 + C], mu_v = mu[1024 + C], mu_x = mu[1536 + lane];
    const float w0c = p.in[12][C], a0c = p.in[14][C], kkc = p.in[17][C], kac = p.in[18][C], rkc = p.in[19][C];
    const float pv_r = seg_prev0(P, sg, C), pv_k = seg_prev0(P, sg, 512 + C), pv_v = seg_prev0(P, sg, 1024 + C), pv_x = seg_prev0(P, sg, 1536 + lane);
    const float* wup = p.in[13] + C; const float* aup = p.in[15] + C;
    float* bonus = (float*)(p.ws + WS_BONUS);
    const bool isH = wave >= 4; const int rhd = g * 4 + (wave & 3), rg = lane >> 2, ks = lane & 3;
    f32x2 s[4][8];
#pragma unroll
    for (int r = 0; r < 4; ++r)
#pragma unroll
        for (int j = 0; j < 8; ++j) { s[r][j].x = (!isH && (rg * 4 + r == ks * 16 + 2 * j)) ? 1.f : 0.f; s[r][j].y = (!isH && (rg * 4 + r == ks * 16 + 2 * j + 1)) ? 1.f : 0.f; }
    bf16_t* Yb = (bf16_t*)(p.ws + WS_Y); bf16_t* HB = (bf16_t*)(p.ws + WS_HB);
    bf16_t raw[9][4];
#define RW_LOAD(sbn) do { _Pragma("unroll") for (int i = 0; i < 9; ++i) { const int ti_ = (sbn) * 16 + ptb + i - 1; const bf16_t* rp_ = P + (size_t)(sg.row0 + (ti_ < 0 ? 0 : ti_)) * NIN; \
        raw[i][0] = rp_[C]; raw[i][1] = rp_[512 + C]; raw[i][2] = rp_[1024 + C]; raw[i][3] = rp_[1536 + lane]; } } while (0)
    RW_LOAD(0);
    for (int sb = 0; sb < sg.nsteps / 16; ++sb) {
        if (!(mode & 4)) {
#pragma unroll
            for (int i = 0; i < 8; ++i) { const float cur = bf2f(raw[i + 1][3]), prev = (sb * 16 + ptb + i == 0) ? pv_x : bf2f(raw[i][3]); float xv = cur + (prev - cur) * mu_x; if (lane < 32) xv = tanhf_(xv); bcs[i * 64 + lane] = xv; }
            float wl[8], al[8];
#pragma unroll
            for (int i = 0; i < 8; ++i) { wl[i] = w0c; al[i] = a0c; }
#pragma unroll 2
            for (int j4 = 0; j4 < 8; ++j4) {
                float wu[4], au[4];
#pragma unroll
                for (int e = 0; e < 4; ++e) { wu[e] = wup[(size_t)(j4 * 4 + e) * 512]; au[e] = aup[(size_t)(j4 * 4 + e) * 512]; }
#pragma unroll
                for (int i = 0; i < 8; ++i) {
                    const f32x4 t4 = *(const LAS f32x4*)(bcs + i * 64 + j4 * 4), x4 = *(const LAS f32x4*)(bcs + i * 64 + 32 + j4 * 4);
#pragma unroll
                    for (int e = 0; e < 4; ++e) { wl[i] += t4[e] * wu[e]; al[i] += x4[e] * au[e]; }
                }
            }
            float rr[8], kr[8], vr[8];
#pragma unroll
            for (int i = 0; i < 8; ++i) { const bool f0 = (sb * 16 + ptb + i == 0);
                const float cr = bf2f(raw[i + 1][0]), ck = bf2f(raw[i + 1][1]), cv = bf2f(raw[i + 1][2]);
                const float qr = f0 ? pv_r : bf2f(raw[i][0]), qk = f0 ? pv_k : bf2f(raw[i][1]), qv = f0 ? pv_v : bf2f(raw[i][2]);
                rr[i] = cr + (qr - cr) * mu_r; kr[i] = ck + (qk - ck) * mu_k; vr[i] = cv + (qv - cv) * mu_v; }
#pragma unroll
            for (int i = 0; i < 8; ++i) {
                const int ti = sb * 16 + ptb + i, row = sg.row0 + ti;
                const float r = rr[i], k = kr[i], v = vr[i];
                const float wlog = -softplusf_(-wl[i]) - 0.5f, dec = __expf(-__expf(wlog));
                const float a = sigmoidf_(al[i]);
                float kk = k * kkc; const float n2 = wave_sum(kk * kk); kk = kk / fmaxf(sqrtf(n2), 1e-12f);
                const float kmod = k * (1.0f + (a - 1.0f) * kac), kka = kk * a;
                const float bs = wave_sum(r * kmod * rkc);
                if (lane == 0) bonus[(size_t)row * 8 + hd] = bs;
                LAS float* st = stage + ((ptb + i) * 4 + phl) * RST;
                st[lane] = dec; st[64 + lane] = kk; st[128 + lane] = kka; st[192 + lane] = kmod; st[256 + lane] = r; st[320 + lane] = v;
            }
        }
        __syncthreads();
        if (sb + 1 < sg.nsteps / 16) RW_LOAD(sb + 1);
        if (!(mode & 8)) for (int tl = 0; tl < 16; ++tl) {
            const LAS float* st = stage + (tl * 4 + (wave & 3)) * RST;
            const int row = sg.row0 + sb * 16 + tl;
            f32x2 w2[8], kk2[8], ka2[8], r2[8];
            load16(st + ks * 16, w2); load16(st + 64 + ks * 16, kk2); load16(st + 128 + ks * 16, ka2); load16(st + 256 + ks * 16, r2);
            float sa[4];
#pragma unroll
            for (int r = 0; r < 4; ++r) { f32x2 acc = s[r][0] * kk2[0];
#pragma unroll
                for (int j = 1; j < 8; ++j) acc = s[r][j] * kk2[j] + acc;
                sa[r] = quad_sum(acc.x + acc.y); }
            float yo[4];
            if (!isH) {
#pragma unroll
                for (int r = 0; r < 4; ++r) { const f32x2 nsa = bc2(-sa[r]);
#pragma unroll
                    for (int j = 0; j < 8; ++j) s[r][j] = s[r][j] * w2[j] + nsa * ka2[j]; }
            } else {
                f32x2 km2[8]; load16(st + 192 + ks * 16, km2);
                const f32x4 v4 = *(const LAS f32x4*)(st + 320 + rg * 4);
#pragma unroll
                for (int r = 0; r < 4; ++r) { const f32x2 nsa = bc2(-sa[r]), vv = bc2(v4[r]);
#pragma unroll
                    for (int j = 0; j < 8; ++j) s[r][j] = (s[r][j] * w2[j] + nsa * ka2[j]) + vv * km2[j]; }
            }
#pragma unroll
            for (int r = 0; r < 4; ++r) { f32x2 acc = s[r][0] * r2[0];
#pragma unroll
                for (int j = 1; j < 8; ++j) acc = s[r][j] * r2[j] + acc;
                yo[r] = quad_sum(acc.x + acc.y); }
            if (ks == 0) {
                u32x2 w; w.x = cvt_pk_bf16(yo[0], yo[1]); w.y = cvt_pk_bf16(yo[2], yo[3]);
                if (!isH) *(u32x2*)(Yb + (size_t)row * 512 + rhd * 64 + rg * 4) = w;
                else *(u32x2*)(HB + (size_t)row * 1024 + rhd * 64 + rg * 4) = w;
            }
        }
        __syncthreads();
    }
    if (!isH) {
        bf16_t* Gf = (bf16_t*)(p.ws + WS_G) + (size_t)(ci * 8 + rhd) * 4096;
#pragma unroll
        for (int j = 0; j < 8; ++j)
#pragma unroll
            for (int h = 0; h < 2; ++h) {
                const int jj = 2 * j + h;
                u32x2 w; w.x = cvt_pk_bf16(h ? s[0][j].y : s[0][j].x, h ? s[1][j].y : s[1][j].x); w.y = cvt_pk_bf16(h ? s[2][j].y : s[2][j].x, h ? s[3][j].y : s[3][j].x);
                *(u32x2*)(Gf + (size_t)((ks * 2 + (rg >> 3)) * 64 + (rg & 3) * 16 + jj) * 8 + ((rg >> 2) & 1) * 4) = w;
            }
    } else {
        float* Hs = (float*)(p.ws + WS_HSR) + (size_t)(ci * 8 + rhd) * 4096;
#pragma unroll
        for (int r = 0; r < 4; ++r)
#pragma unroll
            for (int q = 0; q < 4; ++q) *(f32x4*)(Hs + (rg * 4 + r) * 64 + ks * 16 + q * 4) = (f32x4){s[r][2 * q].x, s[r][2 * q].y, s[r][2 * q + 1].x, s[r][2 * q + 1].y};
    }
}

constexpr int GST = 320;
__device__ __forceinline__ void gla_a_task(const Params& p, LAS unsigned char* lds, int tk) {
    const int tid = tid_opaque(), wave = tid >> 6, lane = tid & 63;
    const bf16_t* P = (const bf16_t*)(p.ws + WS_PACT) + BOFF;
    int row0, nsteps, ci;
    if (tk < 256) { row0 = tk * 64; nsteps = 64; ci = tk; } else { row0 = MPROMPT + (tk - 256) * 16; nsteps = 16; ci = tk; }
    LAS float* stage = (LAS float*)lds;
    LAS float* red = (LAS float*)(lds + 98304);
    const int hd = wave >> 1, half = wave & 1, rg = lane >> 2, ks = lane & 3;
    const int kc = hd * 64 + lane;
    float gku[16];
#pragma unroll
    for (int j = 0; j < 16; ++j) gku[j] = p.in[22][j * 256 + kc];
    const float gkb = p.in[23][kc];
    float lsum = 0.f;
    f32x2 s[4][8];
#pragma unroll
    for (int r = 0; r < 4; ++r)
#pragma unroll
        for (int j = 0; j < 8; ++j) s[r][j] = (f32x2){0.f, 0.f};
    bf16_t* HB = (bf16_t*)(p.ws + WS_HB);
    unsigned gxw; bf16_t graw[8][4];
#define GL_LOAD(sbn) do { gxw = *(const unsigned*)(P + (size_t)(row0 + (sbn) * 16 + half * 8 + (lane >> 3)) * NIN + 1024 + (lane & 7) * 2); \
        _Pragma("unroll") for (int i = 0; i < 8; ++i) { const bf16_t* pr_ = P + (size_t)(row0 + (sbn) * 16 + half * 8 + i) * NIN; graw[i][0] = pr_[256 + kc]; graw[i][1] = pr_[kc]; graw[i][2] = pr_[512 + hd * 128 + lane]; graw[i][3] = pr_[512 + hd * 128 + 64 + lane]; } } while (0)
    GL_LOAD(0);
    for (int sb = 0; sb < nsteps / 16; ++sb) {
        {
            LAS float* xg = (LAS float*)(lds + 81920) + wave * 128;
            { const int j2 = (lane & 7) * 2; xg[(lane >> 3) * 16 + j2] = __uint_as_float(gxw << 16); xg[(lane >> 3) * 16 + j2 + 1] = __uint_as_float(gxw & 0xffff0000u); }
            float kv[8], qv[8], v0[8], v1[8]; float bsub = 0.f;
#pragma unroll
            for (int i = 0; i < 8; ++i) { kv[i] = bf2f(graw[i][0]); qv[i] = bf2f(graw[i][1]) * 0.125f; v0[i] = bf2f(graw[i][2]); v1[i] = bf2f(graw[i][3]); }
#pragma unroll
            for (int i = 0; i < 8; ++i) {
                const int tl = half * 8 + i;
                float gl = gkb;
#pragma unroll
                for (int j4 = 0; j4 < 4; ++j4) { const f32x4 x4 = *(const LAS f32x4*)(xg + i * 16 + j4 * 4); gl += x4[0] * gku[j4 * 4] + x4[1] * gku[j4 * 4 + 1] + x4[2] * gku[j4 * 4 + 2] + x4[3] * gku[j4 * 4 + 3]; }
                const float la = -softplusf_(-gl) * (1.0f / 16.0f);
                lsum += la; bsub += la;
                LAS float* st = stage + (tl * 4 + hd) * GST;
                st[lane] = __expf(la); st[64 + lane] = kv[i]; st[128 + lane] = qv[i]; st[192 + lane] = v0[i]; st[256 + lane] = v1[i];
            }
            ((float*)(p.ws + WS_GBS))[(size_t)((((ci * 4 + sb) * 4 + hd) * 2 + half)) * 64 + lane] = bsub;
        }
        __syncthreads();
        if (sb + 1 < nsteps / 16) GL_LOAD(sb + 1);
        for (int tl = 0; tl < 16; ++tl) {
            const LAS float* st = stage + (tl * 4 + hd) * GST;
            const int row = row0 + sb * 16 + tl;
            f32x2 a2[8], k2[8], q2[8];
            load16(st + ks * 16, a2); load16(st + 64 + ks * 16, k2); load16(st + 128 + ks * 16, q2);
            const f32x4 v4 = *(const LAS f32x4*)(st + 192 + half * 64 + rg * 4);
            float zo[4];
#pragma unroll
            for (int r = 0; r < 4; ++r) { const f32x2 vv = bc2(v4[r]); f32x2 acc = (f32x2){0.f, 0.f};
#pragma unroll
                for (int j = 0; j < 8; ++j) { s[r][j] = s[r][j] * a2[j] + vv * k2[j]; acc = s[r][j] * q2[j] + acc; }
                zo[r] = quad_sum(acc.x + acc.y); }
            if (ks == 0) { u32x2 w; w.x = cvt_pk_bf16(zo[0], zo[1]); w.y = cvt_pk_bf16(zo[2], zo[3]);
                *(u32x2*)(HB + (size_t)row * 1024 + 512 + hd * 128 + half * 64 + rg * 4) = w; }
        }
        __syncthreads();
    }
    float* Hs = (float*)(p.ws + WS_HSG) + (size_t)(ci * 4 + hd) * 8192;
#pragma unroll
    for (int j = 0; j < 8; ++j) {
        *(f32x4*)(Hs + (ks * 16 + 2 * j) * 128 + half * 64 + rg * 4) = (f32x4){s[0][j].x, s[1][j].x, s[2][j].x, s[3][j].x};
        *(f32x4*)(Hs + (ks * 16 + 2 * j + 1) * 128 + half * 64 + rg * 4) = (f32x4){s[0][j].y, s[1][j].y, s[2][j].y, s[3][j].y};
    }
    red[wave * 64 + lane] = lsum;
    __syncthreads();
    if (half == 0) ((float*)(p.ws + WS_DECG))[(size_t)(ci * 4 + hd) * 64 + lane] = __expf(red[wave * 64 + lane] + red[(wave + 1) * 64 + lane]);
    __syncthreads();
}
__device__ __forceinline__ bf16x8 pack8(const float (&v)[8]);
typedef short bf16x4 __attribute__((ext_vector_type(4)));
typedef __bf16 bf16v2 __attribute__((ext_vector_type(2)));
__device__ __forceinline__ unsigned cvt_pk_native(float a, float b) { const f32x2 v = (f32x2){a, b}; const bf16v2 r = __builtin_convertvector(v, bf16v2); return __builtin_bit_cast(unsigned, r); }
__device__ __forceinline__ bf16x8 pack4z(float a, float b, float c, float d) { u32x4 w; w.x = cvt_pk_bf16(a, b); w.y = cvt_pk_bf16(c, d); w.z = 0u; w.w = 0u; return __builtin_bit_cast(bf16x8, w); }
__device__ __forceinline__ void gla_a_wave_task(const Params& p, LAS unsigned char* wl8, int ci, int row0, int nblk, int hd, int sel) {
    const int lane = tid_opaque() & 63, n = lane & 15, q = lane >> 4, kc = hd * 64 + lane;
    const bf16_t* P = (const bf16_t*)(p.ws + WS_PACT) + BOFF; bf16_t* HB = (bf16_t*)(p.ws + WS_HB);
    LAS float* XG = (LAS float*)wl8; LAS bf16_t* QT = (LAS bf16_t*)(wl8 + 1024); LAS bf16_t* KT = (LAS bf16_t*)(wl8 + 3328); LAS bf16_t* KTt = (LAS bf16_t*)(wl8 + 5632); LAS float* BETA = (LAS float*)(wl8 + 8704);
    float gku[16];
#pragma unroll
    for (int j = 0; j < 16; ++j) gku[j] = p.in[22][j * 256 + kc];
    const float gkb = p.in[23][kc];
    f32x4 H[4][8];
#pragma unroll
    for (int kt = 0; kt < 4; ++kt)
#pragma unroll
        for (int vt = 0; vt < 8; ++vt) H[kt][vt] = (f32x4){0.f, 0.f, 0.f, 0.f};
    float lsum = 0.f;
    for (int blk = 0; blk < nblk; ++blk) {
        const int rowb = row0 + blk * 16;
        { const int idx = lane * 4, tk = idx >> 4, j = idx & 15;
          const u32x2 xw = *(const u32x2*)(P + (size_t)(rowb + tk) * NIN + 1024 + j);
          *(LAS f32x4*)(XG + idx) = (f32x4){__uint_as_float(xw.x << 16), __uint_as_float(xw.x & 0xffff0000u), __uint_as_float(xw.y << 16), __uint_as_float(xw.y & 0xffff0000u)}; }
        unsigned qkr[16];
#pragma unroll
        for (int i = 0; i < 16; ++i) { const bf16_t* pr = P + (size_t)(rowb + i) * NIN; qkr[i] = (unsigned)pr[kc] | ((unsigned)pr[256 + kc] << 16); }
        float bsub = 0.f;
#pragma unroll
        for (int i = 0; i < 16; ++i) {
            float gl = gkb;
#pragma unroll
            for (int j4 = 0; j4 < 4; ++j4) { const f32x4 x4 = *(const LAS f32x4*)(XG + i * 16 + j4 * 4); gl += x4[0] * gku[j4 * 4] + x4[1] * gku[j4 * 4 + 1] + x4[2] * gku[j4 * 4 + 2] + x4[3] * gku[j4 * 4 + 3]; }
            bsub += -softplusf_(-gl) * (1.0f / 16.0f);
            const unsigned qk = cvt_pk_bf16(__uint_as_float(qkr[i] << 16) * 0.125f * __expf(bsub), __uint_as_float(qkr[i] & 0xffff0000u) * __expf(-bsub));
            QT[i * 72 + lane] = (bf16_t)(qk & 0xffffu); KT[i * 72 + lane] = (bf16_t)(qk >> 16); KTt[lane * 24 + i] = (bf16_t)(qk >> 16);
        }
        BETA[lane] = __expf(bsub); lsum += bsub;
        asm volatile("" ::: "memory");
        if (sel & 4) { float* gb = (float*)(p.ws + WS_GBS) + (size_t)(((ci * 4 + blk) * 4 + hd) * 2) * 64 + lane; gb[0] = bsub; gb[64] = 0.f; }
        u32x2 VP[8];
#pragma unroll
        for (int vt = 0; vt < 8; ++vt) { const bf16_t* vp = P + (size_t)(rowb + 4 * q) * NIN + 512 + hd * 128 + vt * 16 + n;
            VP[vt].x = (unsigned)vp[0] | ((unsigned)vp[NIN] << 16); VP[vt].y = (unsigned)vp[2 * NIN] | ((unsigned)vp[3 * NIN] << 16); }
#define VF(vt) __builtin_bit_cast(bf16x8, (u32x4){VP[vt].x, VP[vt].y, 0u, 0u})
        f32x4 sc = (f32x4){0.f, 0.f, 0.f, 0.f};
#pragma unroll
        for (int kh = 0; kh < 2; ++kh) sc = __builtin_amdgcn_mfma_f32_16x16x32_bf16(*(const LAS bf16x8*)(KT + n * 72 + kh * 32 + q * 8), *(const LAS bf16x8*)(QT + n * 72 + kh * 32 + q * 8), sc, 0, 0, 0);
        const bf16x8 SCB = pack4z(4 * q + 0 <= n ? sc[0] : 0.f, 4 * q + 1 <= n ? sc[1] : 0.f, 4 * q + 2 <= n ? sc[2] : 0.f, 4 * q + 3 <= n ? sc[3] : 0.f);
        bf16x8 QB[2];
#pragma unroll
        for (int kh = 0; kh < 2; ++kh) { const u32x2 a = __builtin_bit_cast(u32x2, *(const LAS bf16x4*)(QT + n * 72 + kh * 32 + 4 * q)), b = __builtin_bit_cast(u32x2, *(const LAS bf16x4*)(QT + n * 72 + kh * 32 + 16 + 4 * q));
            u32x4 w; w.x = a.x; w.y = a.y; w.z = b.x; w.w = b.y; QB[kh] = __builtin_bit_cast(bf16x8, w); }
#pragma unroll
        for (int vt = 0; vt < 8; ++vt) {
            f32x4 z = (f32x4){0.f, 0.f, 0.f, 0.f};
#pragma unroll
            for (int kh = 0; kh < 2; ++kh) { const float hv[8] = {H[2 * kh][vt][0], H[2 * kh][vt][1], H[2 * kh][vt][2], H[2 * kh][vt][3], H[2 * kh + 1][vt][0], H[2 * kh + 1][vt][1], H[2 * kh + 1][vt][2], H[2 * kh + 1][vt][3]};
                z = __builtin_amdgcn_mfma_f32_16x16x32_bf16(pack8(hv), QB[kh], z, 0, 0, 0); }
            z = __builtin_amdgcn_mfma_f32_16x16x32_bf16(VF(vt), SCB, z, 0, 0, 0);
            u32x2 w; w.x = cvt_pk_native(z[0], z[1]); w.y = cvt_pk_native(z[2], z[3]);
            if (sel & 1) *(u32x2*)(HB + (size_t)(rowb + n) * 1024 + 512 + hd * 128 + vt * 16 + 4 * q) = w;
        }
#pragma unroll
        for (int kt = 0; kt < 4; ++kt) {
            const u32x2 ka = __builtin_bit_cast(u32x2, *(const LAS bf16x4*)(KTt + (kt * 16 + n) * 24 + 4 * q));
            u32x4 kw; kw.x = ka.x; kw.y = ka.y; kw.z = 0u; kw.w = 0u; const bf16x8 KA = __builtin_bit_cast(bf16x8, kw);
            const f32x4 b4 = *(const LAS f32x4*)(BETA + kt * 16 + 4 * q);
#pragma unroll
            for (int vt = 0; vt < 8; ++vt) H[kt][vt] = __builtin_amdgcn_mfma_f32_16x16x32_bf16(KA, VF(vt), H[kt][vt], 0, 0, 0) * b4;
        }
    }
#undef VF
    float* Hs = (float*)(p.ws + WS_HSG) + (size_t)(ci * 4 + hd) * 8192;
#pragma unroll
    for (int kt = 0; kt < 4; ++kt)
#pragma unroll
        for (int vt = 0; vt < 8; ++vt)
#pragma unroll
            for (int i = 0; i < 4; ++i) if (sel & 2) Hs[(kt * 16 + 4 * q + i) * 128 + vt * 16 + n] = H[kt][vt][i];
    if (sel & 4) ((float*)(p.ws + WS_DECG))[(size_t)(ci * 4 + hd) * 64 + lane] = __expf(lsum);
}
__device__ __forceinline__ void phase_mix_a2(const Params& p, LAS unsigned char* lds, int sel) {
    const int wave = tid_opaque() >> 6, skip = gridDim.x >= 64 ? 32 : 0, ng = (int)gridDim.x - skip, nw = ng * 8;
    if ((int)blockIdx.x >= skip) for (int j = wave * ng + ((int)blockIdx.x - skip); j < 1088; j += nw) {
        int ci, row0, nblk, hd;
        if (j < 1024) { ci = j >> 2; row0 = ci * 64; nblk = 4; hd = j & 3; }
        else { const int r = j - 1024, sb = r >> 2; ci = 256 + sb; row0 = MPROMPT + sb * 16; nblk = 1; hd = r & 3; }
        gla_a_wave_task(p, lds + wave * 16384, ci, row0, nblk, hd, sel);
    }
}
__device__ __forceinline__ void phase_mix_a(const Params& p, LAS unsigned char* lds, int mask) {
    if (mask & 1) for (int t = blockIdx.x; t < 288; t += gridDim.x) rwkv_a_task(p, lds, t, mask);
    if (mask & 2) phase_mix_a2(p, lds, 7);
}

__device__ __forceinline__ void rwkv_scan_job(const Params& p, int head, int vt, int ci0, int nchunks, const float* S0, float* Sout, int dry) {
    const int lane = tid_opaque() & 63, n = lane & 15, q = lane >> 4, v = vt * 16 + n;
    f32x4 D[4];
#pragma unroll
    for (int jt = 0; jt < 4; ++jt) D[jt] = S0 ? *(const f32x4*)(S0 + v * 64 + jt * 16 + q * 4) : (f32x4){0.f, 0.f, 0.f, 0.f};
    for (int c = 0; c < nchunks; ++c) {
        const int ci = ci0 + c;
        float* HS = (float*)(p.ws + WS_HSR) + (size_t)(ci * 8 + head) * 4096;
        const bf16x8* Gf = (const bf16x8*)(p.ws + WS_G + (size_t)(ci * 8 + head) * 8192);
        f32x4 Hc[4]; bf16x8 A[4][2];
#pragma unroll
        for (int jt = 0; jt < 4; ++jt) { Hc[jt] = *(const f32x4*)(HS + v * 64 + jt * 16 + q * 4); A[jt][0] = Gf[(jt * 2 + 0) * 64 + lane]; A[jt][1] = Gf[(jt * 2 + 1) * 64 + lane]; }
#pragma unroll
        for (int jt = 0; jt < 4; ++jt) *(f32x4*)(HS + v * 64 + jt * 16 + q * 4) = dry ? Hc[jt] : D[jt];
        bf16x8 B[2];
#pragma unroll
        for (int kh = 0; kh < 2; ++kh) { u32x4 w; w.x = cvt_pk_native(D[2 * kh][0], D[2 * kh][1]); w.y = cvt_pk_native(D[2 * kh][2], D[2 * kh][3]);
            w.z = cvt_pk_native(D[2 * kh + 1][0], D[2 * kh + 1][1]); w.w = cvt_pk_native(D[2 * kh + 1][2], D[2 * kh + 1][3]); B[kh] = __builtin_bit_cast(bf16x8, w); }
#pragma unroll
        for (int jt = 0; jt < 4; ++jt) { f32x4 d = __builtin_amdgcn_mfma_f32_16x16x32_bf16(A[jt][0], B[0], Hc[jt], 0, 0, 0); D[jt] = __builtin_amdgcn_mfma_f32_16x16x32_bf16(A[jt][1], B[1], d, 0, 0, 0); }
    }
#pragma unroll
    for (int jt = 0; jt < 4; ++jt) *(f32x4*)(Sout + v * 64 + jt * 16 + q * 4) = D[jt];
}
constexpr int SC_SLOT = 12544, SC_NB = 8;
__device__ __forceinline__ void rwkv_scan_prompt(const Params& p, LAS unsigned char* lds, int head, int vt, int dry) {
    const int tid = tid_opaque(), wave = tid >> 6, lane = tid & 63, n = lane & 15, q = lane >> 4, v = vt * 16 + n;
    const unsigned char* Gb = p.ws + WS_G; unsigned char* Hb = p.ws + WS_HSR;
    u32x4 pfA[12], pfB[12];
    unsigned off0[12], hmask = 0u;
#pragma unroll
    for (int i = 0; i < 12; ++i) { const int qd = tid + 512 * i, cl = qd / 768, wi = qd % 768;
        off0[i] = wi < 512 ? (unsigned)(WS_G + (size_t)(cl * 8 + head) * 8192 + wi * 16) : (unsigned)(WS_HSR + ((size_t)(cl * 8 + head) * 4096 + vt * 1024) * 4 + (wi - 512) * 16);
        hmask |= (wi < 512 ? 0u : 1u) << i; }
#define SC_ISSUE(pf, batch) do { _Pragma("unroll") for (int i = 0; i < 12; ++i) { \
        const unsigned o_ = off0[i] + (unsigned)(batch) * ((unsigned)(SC_NB * 8 * 8192) << ((hmask >> i) & 1u)); pf[i] = *(const u32x4*)(p.ws + o_); } } while (0)
#define SC_COMMIT(pf) do { _Pragma("unroll") for (int i = 0; i < 12; ++i) { const int qd = tid + 512 * i, cl = qd / 768, wi = qd % 768; \
        const int dst = cl * SC_SLOT + (wi < 512 ? wi * 16 : 8192 + ((wi - 512) >> 4) * 272 + ((wi - 512) & 15) * 16); *(LAS u32x4*)(lds + dst) = pf[i]; } } while (0)
#define SC_COMPUTE(bb) do { if (wave == 0) { for (int cl = 0; cl < SC_NB; ++cl) { \
                const int ci = (bb) * SC_NB + cl; const LAS unsigned char* sl = lds + cl * SC_SLOT; \
                float* HS = (float*)Hb + (size_t)(ci * 8 + head) * 4096; \
                f32x4 Hc[4]; bf16x8 A[4][2]; \
                _Pragma("unroll") for (int jt = 0; jt < 4; ++jt) { Hc[jt] = *(const LAS f32x4*)(sl + 8192 + n * 272 + (jt * 4 + q) * 16); \
                    A[jt][0] = *(const LAS bf16x8*)(sl + ((jt * 2 + 0) * 64 + lane) * 16); A[jt][1] = *(const LAS bf16x8*)(sl + ((jt * 2 + 1) * 64 + lane) * 16); } \
                _Pragma("unroll") for (int jt = 0; jt < 4; ++jt) *(f32x4*)(HS + v * 64 + jt * 16 + q * 4) = dry ? Hc[jt] : D[jt]; \
                bf16x8 B[2]; \
                _Pragma("unroll") for (int kh = 0; kh < 2; ++kh) { u32x4 w; w.x = cvt_pk_native(D[2 * kh][0], D[2 * kh][1]); w.y = cvt_pk_native(D[2 * kh][2], D[2 * kh][3]); \
                    w.z = cvt_pk_native(D[2 * kh + 1][0], D[2 * kh + 1][1]); w.w = cvt_pk_native(D[2 * kh + 1][2], D[2 * kh + 1][3]); B[kh] = __builtin_bit_cast(bf16x8, w); } \
                _Pragma("unroll") for (int jt = 0; jt < 4; ++jt) { f32x4 d = __builtin_amdgcn_mfma_f32_16x16x32_bf16(A[jt][0], B[0], Hc[jt], 0, 0, 0); D[jt] = __builtin_amdgcn_mfma_f32_16x16x32_bf16(A[jt][1], B[1], d, 0, 0, 0); } \
            } } } while (0)
    f32x4 D[4];
#pragma unroll
    for (int jt = 0; jt < 4; ++jt) D[jt] = (f32x4){0.f, 0.f, 0.f, 0.f};
    constexpr int NBT = 128 / SC_NB;
    SC_ISSUE(pfA, 0); SC_COMMIT(pfA);
    __syncthreads();
    SC_ISSUE(pfA, 1); SC_ISSUE(pfB, 2);
    for (int b = 0; b < NBT; b += 2) {
        SC_COMPUTE(b);
        __syncthreads();
        SC_COMMIT(pfA);
        { const int nb_ = b + 3 < NBT ? b + 3 : NBT - 1; SC_ISSUE(pfA, nb_); }
        __syncthreads();
        SC_COMPUTE(b + 1);
        __syncthreads();
        SC_COMMIT(pfB);
        { const int nb_ = b + 4 < NBT ? b + 4 : NBT - 1; SC_ISSUE(pfB, nb_); }
        __syncthreads();
    }
#undef SC_COMPUTE
    if (wave == 0) {
        float* Sout = p.out + O_WKV_P + (size_t)head * 4096;
#pragma unroll
        for (int jt = 0; jt < 4; ++jt) *(f32x4*)(Sout + v * 64 + jt * 16 + q * 4) = D[jt];
    }
#undef SC_ISSUE
#undef SC_COMMIT
}
__device__ __forceinline__ void phase_scan(const Params& p, LAS unsigned char* lds, int dry) {
    const int tid = tid_opaque(), wave = tid >> 6, b = blockIdx.x;
    float* HSG = (float*)(p.ws + WS_HSG); const float* DEC = (const float*)(p.ws + WS_DECG);
    if (b < 32) rwkv_scan_prompt(p, lds, b >> 2, b & 3, dry);
    else if (b < 96) {
        const int e = (b - 32) * 512 + tid, hd = e >> 13, k = (e >> 7) & 63;
        float S = 0.f;
        float t[32], d[32];
#pragma unroll
        for (int u = 0; u < 32; ++u) { t[u] = HSG[(size_t)u * 32768 + e]; d[u] = DEC[(size_t)(u * 4 + hd) * 64 + k]; }
        for (int c = 0; c < 256; c += 32) {
            float tn[32], dn[32];
            const int cn = c + 32 < 256 ? c + 32 : c;
#pragma unroll
            for (int u = 0; u < 32; ++u) { tn[u] = HSG[(size_t)(cn + u) * 32768 + e]; dn[u] = DEC[(size_t)((cn + u) * 4 + hd) * 64 + k]; }
            __builtin_amdgcn_sched_barrier(0);
#pragma unroll
            for (int u = 0; u < 32; ++u) { HSG[(size_t)(c + u) * 32768 + e] = dry ? t[u] : S; S = S * d[u] + t[u]; }
            __builtin_amdgcn_sched_barrier(0);
#pragma unroll
            for (int u = 0; u < 32; ++u) { t[u] = tn[u]; d[u] = dn[u]; }
        }
        p.out[O_GLA_P + e] = S;
    } else {
        const int nb = gridDim.x - 96, bb = b - 96;
        for (int j = bb * 8 + wave; j < 512; j += nb * 8) { const int sb = j >> 5, hd = (j >> 2) & 7, vt = j & 3;
            rwkv_scan_job(p, hd, vt, 128 + sb, 1, p.in[3] + (size_t)(sb * 8 + hd) * 4096, p.out + O_WKV_S + (size_t)(sb * 8 + hd) * 4096, dry); }
        for (int i = bb * 512 + tid; i < 16 * 8192; i += nb * 512) { const int sb = i >> 13, e = (i & 8191) * 4, hd = e >> 13, k = (e >> 7) & 63;
            const f32x4 S0 = *(const f32x4*)(p.in[4] + (size_t)sb * 32768 + e); float* hp = HSG + (size_t)(256 + sb) * 32768 + e;
            const f32x4 t = *(const f32x4*)hp; const float d = DEC[(size_t)((256 + sb) * 4 + hd) * 64 + k];
            *(f32x4*)hp = dry ? t : S0; *(f32x4*)(p.out + O_GLA_S + (size_t)sb * 32768 + e) = S0 * d + t; }
    }
}

struct RwkvCConst { bf16x8 GB[4][2]; float lw[4], lb[4], muv[4]; float mug[16]; };
__device__ __forceinline__ float row16_sum(float x) {
    x += __int_as_float(__builtin_amdgcn_update_dpp(0, __float_as_int(x), 0xB1, 0xF, 0xF, true));
    x += __int_as_float(__builtin_amdgcn_update_dpp(0, __float_as_int(x), 0x4E, 0xF, 0xF, true));
    x += __int_as_float(__builtin_amdgcn_update_dpp(0, __float_as_int(x), 0x124, 0xF, 0xF, true));
    x += __int_as_float(__builtin_amdgcn_update_dpp(0, __float_as_int(x), 0x128, 0xF, 0xF, true));
    return x;
}
__device__ __forceinline__ bf16x8 pack8(const float (&v)[8]) {
    u32x4 w; w.x = cvt_pk_bf16(v[0], v[1]); w.y = cvt_pk_bf16(v[2], v[3]); w.z = cvt_pk_bf16(v[4], v[5]); w.w = cvt_pk_bf16(v[6], v[7]); return __builtin_bit_cast(bf16x8, w);
}
__device__ __forceinline__ void unpack8(u32x4 w, float (&v)[8]) {
    v[0] = __uint_as_float(w.x << 16); v[1] = __uint_as_float(w.x & 0xffff0000u); v[2] = __uint_as_float(w.y << 16); v[3] = __uint_as_float(w.y & 0xffff0000u);
    v[4] = __uint_as_float(w.z << 16); v[5] = __uint_as_float(w.z & 0xffff0000u); v[6] = __uint_as_float(w.w << 16); v[7] = __uint_as_float(w.w & 0xffff0000u);
}
__device__ __forceinline__ void rwkv_c_const(const Params& p, int hd, RwkvCConst& K) {
    const int lane = tid_opaque() & 63, n = lane & 15, q = lane >> 4;
#pragma unroll
    for (int nt = 0; nt < 4; ++nt) {
        const int C = hd * 64 + nt * 16 + n;
        K.lw[nt] = p.in[20][C]; K.lb[nt] = p.in[21][C]; K.muv[nt] = p.in[11][1024 + C];
#pragma unroll
        for (int kh = 0; kh < 2; ++kh) { float g[8];
#pragma unroll
            for (int e = 0; e < 8; ++e) g[e] = p.in[16][(size_t)(kh * 32 + q * 8 + e) * 512 + C];
            K.GB[nt][kh] = pack8(g); }
    }
#pragma unroll
    for (int kh = 0; kh < 2; ++kh)
#pragma unroll
        for (int e = 0; e < 8; ++e) K.mug[kh * 8 + e] = p.in[11][1600 + kh * 32 + q * 8 + e];
}
__device__ __forceinline__ void rwkv_c_task(const Params& p, const RwkvCConst& K, int ci, int tok0, int hd, const Seg& sg, int dry) {
    const int lane = tid_opaque() & 63, n = lane & 15, q = lane >> 4;
    const bf16_t* P = (const bf16_t*)(p.ws + WS_PACT);
    const bf16_t* Yb = (const bf16_t*)(p.ws + WS_Y); bf16_t* HB = (bf16_t*)(p.ws + WS_HB);
    const float* Ss = (const float*)(p.ws + WS_HSR) + (size_t)(ci * 8 + hd) * 4096;
    const float* bonus = (const float*)(p.ws + WS_BONUS);
    const int rowb = sg.row0 + tok0;
    bf16x8 SB[4][2]; float bo[4]; bf16_t zr[4][4], cr_[4][4]; float pv0[4];
#pragma unroll
    for (int nt = 0; nt < 4; ++nt)
#pragma unroll
        for (int kh = 0; kh < 2; ++kh) {
            const float* sp = Ss + (nt * 16 + n) * 64 + kh * 32 + q * 8;
            const f32x4 s0 = *(const f32x4*)sp, s1 = *(const f32x4*)(sp + 4);
            const float sv[8] = {s0[0], s0[1], s0[2], s0[3], s1[0], s1[1], s1[2], s1[3]};
            SB[nt][kh] = pack8(sv);
        }
#pragma unroll
    for (int i = 0; i < 4; ++i) bo[i] = bonus[(size_t)(rowb + q * 4 + i) * 8 + hd];
#pragma unroll
    for (int nt = 0; nt < 4; ++nt) {
        const int C = hd * 64 + nt * 16 + n;
        const bool first = (tok0 + q * 4 == 0) && sg.prevkind != 1;
        pv0[nt] = bf2f(P[(size_t)(rowb + q * 4 - (first ? 0 : 1)) * NIN + 1024 + C]);
        if (first) pv0[nt] = sg.prevkind == 2 ? sg.prevptr[1024 + C] : 0.f;
#pragma unroll
        for (int i = 0; i < 4; ++i) { const int row = rowb + q * 4 + i; zr[nt][i] = HB[(size_t)row * 1024 + C]; cr_[nt][i] = P[(size_t)row * NIN + 1024 + C]; }
    }
    bf16x8 AY[2], AG[2];
    {
        const bool first = (tok0 + n == 0) && sg.prevkind != 1;
        const bf16_t* cr = P + (size_t)(rowb + n) * NIN + 1600 + q * 8;
        const bf16_t* pr = P + (size_t)(rowb + n - (first ? 0 : 1)) * NIN + 1600 + q * 8;
#pragma unroll
        for (int kh = 0; kh < 2; ++kh) {
            AY[kh] = *(const bf16x8*)(Yb + (size_t)(rowb + n) * 512 + hd * 64 + kh * 32 + q * 8);
            float c8[8], p8[8];
            unpack8(*(const u32x4*)(cr + kh * 32), c8); unpack8(*(const u32x4*)(pr + kh * 32), p8);
            if (first) {
#pragma unroll
                for (int e = 0; e < 8; ++e) p8[e] = sg.prevkind == 2 ? sg.prevptr[1600 + kh * 32 + q * 8 + e] : 0.f;
            }
#pragma unroll
            for (int e = 0; e < 8; ++e) c8[e] = sigmoidf_(c8[e] + (p8[e] - c8[e]) * K.mug[kh * 8 + e]);
            AG[kh] = pack8(c8);
        }
    }
    f32x4 D[4], G[4];
#pragma unroll
    for (int nt = 0; nt < 4; ++nt) {
        f32x4 d = (f32x4){0.f, 0.f, 0.f, 0.f}, g = (f32x4){0.f, 0.f, 0.f, 0.f};
#pragma unroll
        for (int kh = 0; kh < 2; ++kh) {
            d = __builtin_amdgcn_mfma_f32_16x16x32_bf16(AY[kh], SB[nt][kh], d, 0, 0, 0);
            g = __builtin_amdgcn_mfma_f32_16x16x32_bf16(AG[kh], K.GB[nt][kh], g, 0, 0, 0);
        }
        D[nt] = d; G[nt] = g;
    }
    float o[4][4], vv[4][4];
#pragma unroll
    for (int nt = 0; nt < 4; ++nt) {
        float pv = pv0[nt];
#pragma unroll
        for (int i = 0; i < 4; ++i) {
            o[nt][i] = D[nt][i] + bf2f(zr[nt][i]);
            const float cv = bf2f(cr_[nt][i]);
            vv[nt][i] = cv + (pv - cv) * K.muv[nt]; pv = cv;
        }
    }
#pragma unroll
    for (int i = 0; i < 4; ++i) {
        const float mean = row16_sum((o[0][i] + o[1][i]) + (o[2][i] + o[3][i])) * (1.0f / 64.0f);
        float d2 = 0.f;
#pragma unroll
        for (int nt = 0; nt < 4; ++nt) { o[nt][i] -= mean; d2 += o[nt][i] * o[nt][i]; }
        const float rs = rsqrtf(row16_sum(d2) * (1.0f / 64.0f) + 64e-5f);
#pragma unroll
        for (int nt = 0; nt < 4; ++nt) {
            const int C = hd * 64 + nt * 16 + n;
            const float res = (o[nt][i] * rs * K.lw[nt] + K.lb[nt] + bo[i] * vv[nt][i]) * G[nt][i];
            const unsigned rb = cvt_pk_bf16(res, 0.f);
            bf16_t* dp = dry ? (bf16_t*)(p.ws + WS_DUMMY) + (size_t)blockIdx.x * 512 + threadIdx.x : HB + (size_t)(rowb + q * 4 + i) * 1024 + C;
            *dp = (bf16_t)(rb & 0xffffu);
        }
    }
}
__device__ __forceinline__ void gla_c_task(const Params& p, LAS float* wl, int ci, int row0, int rd, int hd, int dry) {
    const int lane = tid_opaque() & 63, n = lane & 15, q = lane >> 4, kc = hd * 64 + lane;
    const bf16_t* P = (const bf16_t*)(p.ws + WS_PACT) + BOFF; bf16_t* HB = (bf16_t*)(p.ws + WS_HB);
    const float* Ss = (const float*)(p.ws + WS_HSG) + (size_t)(ci * 4 + hd) * 8192;
    LAS float* XG = wl; LAS bf16_t* QT = (LAS bf16_t*)(wl + 256);
    const int rowb = row0 + rd * 16;
    float gku[16];
#pragma unroll
    for (int j = 0; j < 16; ++j) gku[j] = p.in[22][j * 256 + kc];
    const float gkb = p.in[23][kc];
    float bsum = 0.f;
    for (int sb = 0; sb < rd; ++sb) { const float* g = (const float*)(p.ws + WS_GBS) + (size_t)(((ci * 4 + sb) * 4 + hd) * 2) * 64 + lane; bsum += g[0]; bsum += g[64]; }
    { const int idx = lane * 4, tk = idx >> 4, j = idx & 15;
      const u32x2 xw = *(const u32x2*)(P + (size_t)(rowb + tk) * NIN + 1024 + j);
      *(LAS f32x4*)(XG + idx) = (f32x4){__uint_as_float(xw.x << 16), __uint_as_float(xw.x & 0xffff0000u), __uint_as_float(xw.y << 16), __uint_as_float(xw.y & 0xffff0000u)}; }
    float qv[16];
#pragma unroll
    for (int i = 0; i < 16; ++i) qv[i] = bf2f(P[(size_t)(rowb + i) * NIN + kc]) * 0.125f;
    bf16x8 B[8][2];
#pragma unroll
    for (int nt = 0; nt < 8; ++nt)
#pragma unroll
        for (int kh = 0; kh < 2; ++kh) { float sv[8];
#pragma unroll
            for (int e = 0; e < 8; ++e) sv[e] = Ss[(size_t)(kh * 32 + q * 8 + e) * 128 + nt * 16 + n];
            B[nt][kh] = pack8(sv); }
    bf16_t zr[4][8], gr[4][8]; float ng[8];
#pragma unroll
    for (int nt = 0; nt < 8; ++nt) ng[nt] = p.in[24][nt * 16 + n];
#pragma unroll
    for (int i = 0; i < 4; ++i) {
        const int row = rowb + q * 4 + i;
#pragma unroll
        for (int nt = 0; nt < 8; ++nt) { zr[i][nt] = HB[(size_t)row * 1024 + 512 + hd * 128 + nt * 16 + n]; gr[i][nt] = P[(size_t)row * NIN + 1040 + hd * 128 + nt * 16 + n]; }
    }
    __builtin_amdgcn_sched_barrier(0);
#pragma unroll
    for (int i = 0; i < 16; ++i) {
        float gl = gkb;
#pragma unroll
        for (int j4 = 0; j4 < 4; ++j4) { const f32x4 x4 = *(const LAS f32x4*)(XG + i * 16 + j4 * 4); gl += x4[0] * gku[j4 * 4] + x4[1] * gku[j4 * 4 + 1] + x4[2] * gku[j4 * 4 + 2] + x4[3] * gku[j4 * 4 + 3]; }
        bsum += -softplusf_(-gl) * (1.0f / 16.0f);
        QT[i * 72 + lane] = (bf16_t)(cvt_pk_bf16(qv[i] * __expf(bsum), 0.f) & 0xffffu);
    }
    bf16x8 A[2];
#pragma unroll
    for (int kh = 0; kh < 2; ++kh) A[kh] = *(const LAS bf16x8*)(QT + n * 72 + kh * 32 + q * 8);
    f32x4 D[8];
#pragma unroll
    for (int nt = 0; nt < 8; ++nt) {
        f32x4 d = (f32x4){0.f, 0.f, 0.f, 0.f};
#pragma unroll
        for (int kh = 0; kh < 2; ++kh) d = __builtin_amdgcn_mfma_f32_16x16x32_bf16(A[kh], B[nt][kh], d, 0, 0, 0);
        D[nt] = d;
    }
#pragma unroll
    for (int i = 0; i < 4; ++i) {
        const int row = rowb + q * 4 + i;
        bf16_t* ob = HB + (size_t)row * 1024 + 512 + hd * 128 + n;
        float o[8], ss = 0.f;
#pragma unroll
        for (int nt = 0; nt < 8; ++nt) { o[nt] = D[nt][i] + bf2f(zr[i][nt]); ss += o[nt] * o[nt]; }
        const float rs = rsqrtf(row16_sum(ss) * (1.0f / 128.0f) + 1e-6f);
#pragma unroll
        for (int nt = 0; nt < 8; ++nt) {
            const float g = bf2f(gr[i][nt]);
            const unsigned rb = cvt_pk_bf16(o[nt] * rs * ng[nt] * g * sigmoidf_(g), 0.f);
            bf16_t* dp = dry ? (bf16_t*)(p.ws + WS_DUMMY) + (size_t)blockIdx.x * 512 + threadIdx.x : ob + nt * 16;
            *dp = (bf16_t)(rb & 0xffffu);
        }
    }
}
__device__ __forceinline__ void phase_mix_c(const Params& p, LAS unsigned char* lds, int dry, int mask) {
    const int wave = tid_opaque() >> 6, widx = wave * (int)gridDim.x + (int)blockIdx.x, nw = gridDim.x * 8;
    LAS float* wl = (LAS float*)(lds + wave * 16384);
    if (mask & 1) for (int j = widx; j < 4160; j += nw) {
        int ci, row0, rd, hd;
        if (j < 4096) { ci = j >> 4; row0 = ci * 64; rd = (j >> 2) & 3; hd = j & 3; }
        else { const int r = j - 4096, sb = r >> 2; ci = 256 + sb; row0 = MPROMPT + sb * 16; rd = 0; hd = r & 3; }
        gla_c_task(p, wl, ci, row0, rd, hd, dry);
    }
    const int jb = (widx + 4160) % nw, js = nw, je = 8320;
    RwkvCConst KC; rwkv_c_const(p, jb & 7, KC);
    if (mask & 2) for (int j = jb; j < je; j += js) {
        Seg sg; int ci, tok0, hd;
        if (j < 8192) { const int c = j >> 6; ci = c; tok0 = ((j >> 3) & 7) * 16; hd = j & 7; sg.row0 = c * 128; sg.nsteps = 128; sg.prevkind = c == 0 ? 0 : 1; sg.prevptr = nullptr; }
        else { const int r = j - 8192, sb = r >> 3; ci = 128 + sb; tok0 = 0; hd = r & 7; sg.row0 = MPROMPT + sb * 16; sg.nsteps = 16; sg.prevkind = 2; sg.prevptr = p.in[2] + (size_t)sb * ACOLS; }
        rwkv_c_task(p, KC, ci, tok0, hd, sg, dry);
    }
}
__global__ void __launch_bounds__(512, 2) fwd_megakernel(Params p) {
    extern __shared__ __attribute__((aligned(16))) unsigned char shm[];
    LAS unsigned char* lds = (LAS unsigned char*)shm;
    cg::grid_group grid = cg::this_grid();
    float* ssq = (float*)(p.ws + WS_SSQ);
    bf16_t* HB = (bf16_t*)(p.ws + WS_HB); bf16_t* HB2 = (bf16_t*)(p.ws + WS_HB2); bf16_t* PACT = (bf16_t*)(p.ws + WS_PACT);
    float* XRES = p.out;
    float* RSTD = (float*)(p.ws + WS_RSTD);
    float* PART = (float*)(p.ws + WS_HSR);
#if BARRIER_KIND == 0
#define GSYNC() grid.sync()
#elif BARRIER_KIND == 1
#define GSYNC() xcd_barrier(xb)
#else
    unsigned bar_round = 0;
    const unsigned bar_g = blockIdx.x & 7u, bar_gsize = (gridDim.x + 7u - bar_g) >> 3, bar_ngrp = gridDim.x < 8u ? gridDim.x : 8u;
#define GSYNC() do { asm volatile("s_waitcnt vmcnt(0)" ::: "memory"); __syncthreads(); if (threadIdx.x == 0) { size_t off_ = WS_BAR + 3520 * 4; asm volatile("" : "+s"(off_)); unsigned* cnt_ = (unsigned*)(p.ws + off_); ++bar_round; \
        __builtin_amdgcn_fence(__ATOMIC_RELEASE, "agent"); \
        const unsigned old_ = __hip_atomic_fetch_add(cnt_ + 64 * (1 + bar_g), 1u, __ATOMIC_RELAXED, __HIP_MEMORY_SCOPE_AGENT); \
        if (old_ + 1u == bar_gsize * bar_round) __hip_atomic_fetch_add(cnt_, 1u, __ATOMIC_RELAXED, __HIP_MEMORY_SCOPE_AGENT); \
        while (__hip_atomic_load(cnt_, __ATOMIC_RELAXED, __HIP_MEMORY_SCOPE_AGENT) < bar_round * bar_ngrp) __builtin_amdgcn_s_sleep(2); \
        __builtin_amdgcn_fence(__ATOMIC_ACQUIRE, "agent"); asm volatile("s_waitcnt vmcnt(0)" ::: "memory"); } __syncthreads(); } while (0)
#endif
#define REPS(k) (1 + (DUP_PHASE == (k) ? DUP_N : 0))
#define PHASE(k, ...) for (int rep_ = 0; rep_ < REPS(k); ++rep_) { int dry = rep_ < REPS(k) - 1; asm volatile("" : "+s"(dry)); __VA_ARGS__ GSYNC(); }
    if (p.ws == nullptr) grid.sync();
    for (int rep_ = 0; rep_ < REPS(0); ++rep_) { phase_convert(p, lds, 2, (int)blockIdx.x, (int)gridDim.x); GSYNC(); }
    if (threadIdx.x == 0) *(LAS u32x4*)(lds + 131072) = (u32x4){0u, 0u, 0u, 0u};
    __syncthreads();
#if BARRIER_KIND == 1
    const XcdBarrier xb = xcd_barrier_post((unsigned*)(p.ws + WS_BAR), (volatile LAS unsigned*)(lds + 131072));
#endif
    PHASE(1, { EpiSwiglu E; E.O = PACT; E.rstd = nullptr; E.nparts = 0; run_gemm(lds, HB, (const bf16_t*)(p.ws + WS_W1GU), 5632, 1024, E); })
    PHASE(2, { const EpiResid E{p.in[0], 0.5f, p.in[1], 0, XRES, HB, ssq + 16 * MROWS, PART}; run_gemm_split(lds, PACT, (const bf16_t*)(p.ws + WS_W1D), FF, E); })
    split_fixup(PART, 11, p.in[1], XRES, HB, ssq + 16 * MROWS, 0.5f, 0, nullptr, RSTD); GSYNC();
    PHASE(3, { EpiP E; E.P = PACT; E.rstd = RSTD; E.out = p.out; run_gemm(lds, HB, (const bf16_t*)(p.ws + WS_WIN), NINP, 1024, E); })
    PHASE(4, { int mask = dry ? DUP_MASK : 3; asm volatile("" : "+s"(mask)); phase_mix_a(p, lds, mask); })
#if GLA2_SEL >= 0
    { int sel = GLA2_SEL; asm volatile("" : "+s"(sel)); phase_mix_a2(p, lds, sel); GSYNC(); }
#endif
    PHASE(5, phase_scan(p, lds, dry);)
    PHASE(6, { int mask = dry ? DUP_MASK : 3; asm volatile("" : "+s"(mask)); phase_mix_c(p, lds, dry, mask); })
    PHASE(7, { const EpiResid E{XRES, 1.0f, XRES + (size_t)MPROMPT * DM, dry, XRES, HB2, ssq + 32 * MROWS, PART}; run_gemm_split(lds, HB, (const bf16_t*)(p.ws + WS_WOUT), 1024, E); })
    split_fixup(PART, 4, XRES + (size_t)MPROMPT * DM, XRES, HB2, ssq + 32 * MROWS, 1.0f, 0, nullptr, RSTD + MROWS); GSYNC();
    PHASE(8, { EpiSwiglu E; E.O = PACT; E.rstd = RSTD + MROWS; E.nparts = 1; run_gemm(lds, HB2, (const bf16_t*)(p.ws + WS_W2GU), 5632, 1024, E); })
    PHASE(9, { const EpiResid E{XRES, 0.5f, XRES + (size_t)MPROMPT * DM, dry, XRES, nullptr, ssq + 48 * MROWS, PART}; run_gemm_split(lds, PACT, (const bf16_t*)(p.ws + WS_W2D), FF, E); })
    split_fixup(PART, 11, XRES + (size_t)MPROMPT * DM, XRES, nullptr, ssq + 48 * MROWS, 0.5f, 0, p.in[30], nullptr);
#if DUP_PHASE == 11
    for (int rep_ = 0; rep_ < 10 * DUP_N; ++rep_) GSYNC();
#endif
    for (int rep_ = 0; rep_ < REPS(10); ++rep_) { int dry = rep_ < REPS(10) - 1; asm volatile("" : "+s"(dry)); phase_final_norm(p, dry); if (dry) GSYNC(); }
}

extern "C" void kernel_launch(void* const* d_in, const int* in_sizes, int n_in, void* d_out, int out_size, void* d_ws, size_t ws_size, hipStream_t stream) {
    static int grid = 0;
    if (grid == 0) {
        if (n_in != 31 || (size_t)out_size != O_END || ws_size < WS_END) { fprintf(stderr, "kernel_launch: unexpected sizes n_in %d out %d ws %zu (need %zu)\n", n_in, out_size, ws_size, (size_t)WS_END); grid = -1; return; }
        int dev = 0, cus = 0, per_cu = 0;
        hipGetDevice(&dev); hipDeviceGetAttribute(&cus, hipDeviceAttributeMultiprocessorCount, dev);
        if (hipFuncSetAttribute((const void*)fwd_megakernel, hipFuncAttributeMaxDynamicSharedMemorySize, LDS_BYTES) != hipSuccess) { fprintf(stderr, "kernel_launch: hipFuncSetAttribute failed\n"); grid = -1; return; }
        if (hipOccupancyMaxActiveBlocksPerMultiprocessor(&per_cu, (const void*)fwd_megakernel, 512, LDS_BYTES) != hipSuccess || per_cu < 1) { fprintf(stderr, "kernel_launch: occupancy query says %d\n", per_cu); per_cu = 1; }
        (void)hipGetLastError();
        grid = cus;
    }
    if (grid < 0) return;
    if (hipMemsetAsync((unsigned char*)d_ws + WS_BAR, 0, 16384, stream) != hipSuccess) { fprintf(stderr, "kernel_launch: memset failed\n"); return; }
    Params p{};
    for (int i = 0; i < 31; ++i) p.in[i] = (const float*)d_in[i];
    p.out = (float*)d_out; p.ws = (unsigned char*)d_ws;
    void* args[] = {&p};
    hipError_t e = hipLaunchCooperativeKernel((const void*)fwd_megakernel, dim3(grid), dim3(512), args, LDS_BYTES, stream);
    if (e != hipSuccess) fprintf(stderr, "cooperative launch failed: %s (grid %d)\n", hipGetErrorString(e), grid);
}
```
